# Optimizing an MI355X kernel written in HIP

```python
import math, functools
import jax, jax.numpy as jnp
from jax import lax
import numpy as np

D_MODEL = 2048
BATCH = 1
SEQ = 8192
DEPTH = 4

GRID_W = 64
CTX_LEN = 256
N_MIXERS = 2
S5_GROUP = 16
S5_GROUPS = D_MODEL // S5_GROUP
S5_STATE = 64
S5_DT_MIN = 0.001
S5_DT_MAX = 0.1
HG_HEADS = 16
HG_DK = D_MODEL // HG_HEADS
HG_DV = D_MODEL // HG_HEADS
HG_CHUNK = 32
MLP_HIDDEN = 4 * D_MODEL
NORM_EPS = 1e-6

kernel_name = "hybrid_s5_hgrn2_prefix_dit"


def rmsnorm(x, g):
    xf = x.astype(jnp.float32)
    y = xf * lax.rsqrt(jnp.mean(xf * xf, axis=-1, keepdims=True) + NORM_EPS)
    return (y * g.astype(jnp.float32)).astype(x.dtype)


def adaln(cond, w, b):
    return jnp.split(jax.nn.silu(cond) @ w + b, 6, axis=-1)


def modulate(h, shift, scale):
    return h * (1 + scale) + shift


def raster_to_colmajor(h):
    b, n, d = h.shape
    rows = n // GRID_W
    return h.reshape(b, rows, GRID_W, d).transpose(0, 2, 1, 3).reshape(b, n, d)


def colmajor_to_raster(h):
    b, n, d = h.shape
    rows = n // GRID_W
    return h.reshape(b, GRID_W, rows, d).transpose(0, 2, 1, 3).reshape(b, n, d)


def sq_relu_mlp(h, w1, w2):
    return jnp.square(jax.nn.relu(h @ w1)) @ w2


def s5_discretise(a_re, a_im, log_dt, b_re, b_im):
    lam = lax.complex(a_re.astype(jnp.float32), a_im.astype(jnp.float32))
    dt = jnp.exp(log_dt.astype(jnp.float32))[:, None]
    lam_bar = jnp.exp(lam * dt)
    b = lax.complex(b_re.astype(jnp.float32), b_im.astype(jnp.float32))
    b_bar = ((lam_bar - 1) / lam)[..., None] * b
    return lam_bar, b_bar


def _lin_rec_combine(e1, e2):
    a1, b1 = e1
    a2, b2 = e2
    return a1 * a2, a2 * b1 + b2


def s5_scan(u, lam_bar, b_bar, s0, reverse):
    bu = jnp.einsum('btgh,gph->btgp', u, b_bar)
    first = -1 if reverse else 0
    bu = bu.at[:, first].add(lam_bar * s0)
    a = jnp.broadcast_to(lam_bar, bu.shape)
    _, states = lax.associative_scan(_lin_rec_combine, (a, bu), axis=1, reverse=reverse)
    return states


def s5_mixer(h_ctx, h_lat, a_re, a_im, log_dt, b_re, b_im, c_re, c_im, d_skip, w_glu, ctx_out):
    def to_groups(h):
        return h.astype(jnp.float32).reshape(h.shape[0], h.shape[1], S5_GROUPS, S5_GROUP)

    u_ctx, u_lat = to_groups(h_ctx), to_groups(h_lat)
    uc_ctx, uc_lat = u_ctx.astype(jnp.complex64), u_lat.astype(jnp.complex64)
    d = d_skip.astype(jnp.float32).reshape(S5_GROUPS, S5_GROUP)
    y_lat = u_lat * d
    y_ctx = u_ctx * d if ctx_out else None
    s0 = jnp.zeros((h_lat.shape[0], S5_GROUPS, S5_STATE), jnp.complex64)
    for direction in range(2):
        reverse = direction == 1
        lam_bar, b_bar = s5_discretise(a_re[direction], a_im[direction], log_dt[direction],
                                       b_re[direction], b_im[direction])
        c_mat = lax.complex(c_re[direction].astype(jnp.float32), c_im[direction].astype(jnp.float32))
        st_ctx = s5_scan(uc_ctx, lam_bar, b_bar, s0, reverse)
        s_ctx_final = st_ctx[:, 0] if reverse else st_ctx[:, -1]
        st_lat = s5_scan(uc_lat, lam_bar, b_bar, s_ctx_final, reverse)
        y_lat = y_lat + jnp.einsum('btgp,ghp->btgh', st_lat, c_mat).real
        if ctx_out:
            y_ctx = y_ctx + jnp.einsum('btgp,ghp->btgh', st_ctx, c_mat).real

    def glu_out(y, h):
        z = jax.nn.gelu(y.reshape(h.shape).astype(h.dtype))
        a, g = jnp.split(z @ w_glu, 2, axis=-1)
        return a * jax.nn.sigmoid(g)

    return (glu_out(y_ctx, h_ctx) if ctx_out else None), glu_out(y_lat, h_lat)


def hgrn_project(h, w_in, with_query):
    def heads(t):
        return t.astype(jnp.float32).reshape(t.shape[0], t.shape[1], HG_HEADS, -1)
    if with_query:
        q, i, zf, zb, g = jnp.split(h @ w_in, 5, axis=-1)
        return heads(jax.nn.silu(q)), heads(i), heads(zf), heads(zb), g
    i, zf, zb = jnp.split(h @ w_in[:, D_MODEL:4 * D_MODEL], 3, axis=-1)
    return None, heads(i), heads(zf), heads(zb), None


def forget_gate(logit, lb):
    lb = lb.astype(jnp.float32).reshape(HG_HEADS, HG_DK)
    log_f = jnp.logaddexp(jax.nn.log_sigmoid(logit), jnp.log(lb) + jax.nn.log_sigmoid(-logit))
    k = (1 - lb) * jax.nn.sigmoid(-logit)
    return log_f, k


def chunked_gated_recurrence(q, k, v, logf, s0):
    b_, t, h, kd = k.shape
    n = t // HG_CHUNK

    def chunks(z):
        return z.reshape(b_, n, HG_CHUNK, h, z.shape[-1])

    k, v, logf = chunks(k), chunks(v), chunks(logf)
    cum = jnp.cumsum(logf, axis=2)
    cum_last = cum[:, :, -1]
    k_end = k * jnp.exp(cum_last[:, :, None] - cum)
    u = jnp.einsum('bnchk,bnchv->bnhkv', k_end, v)

    def step(s, inp):
        decay, inc = inp
        return decay[..., None] * s + inc, s

    s_fin, s_in = lax.scan(step, s0, (jnp.moveaxis(jnp.exp(cum_last), 1, 0), jnp.moveaxis(u, 1, 0)))
    if q is None:
        return None, s_fin
    s_in = jnp.moveaxis(s_in, 0, 1)
    q = chunks(q)
    qb = q * jnp.exp(cum)
    kb = k * jnp.exp(-cum)
    scores = jnp.einsum('bnchk,bnshk->bnhcs', qb, kb)
    mask = jnp.tril(jnp.ones((HG_CHUNK, HG_CHUNK), dtype=bool))
    scores = jnp.where(mask, scores, 0.0)
    o = jnp.einsum('bnhcs,bnshv->bnchv', scores, v) + jnp.einsum('bnchk,bnhkv->bnchv', qb, s_in)
    return o.reshape(b_, t, h, v.shape[-1]), s_fin


def hgrn_readout(o, g, o_norm, w_out):
    b_, t, h, dv = o.shape
    o = o * lax.rsqrt(jnp.mean(o * o, axis=-1, keepdims=True) + NORM_EPS)
    o = o.reshape(b_, t, h * dv) * o_norm.astype(jnp.float32)
    return (o.astype(g.dtype) * jax.nn.silu(g)) @ w_out


def hgrn_mixer(h_ctx, h_lat, w_in, lb_fwd, lb_bwd, o_norm, w_out, ctx_out):
    q_l, v_l, zf_l, zb_l, g_l = hgrn_project(h_lat, w_in, True)
    q_c, v_c, zf_c, zb_c, g_c = hgrn_project(h_ctx, w_in, ctx_out)
    s0 = jnp.zeros((h_lat.shape[0], HG_HEADS, HG_DK, HG_DV), jnp.float32)
    flip = functools.partial(jnp.flip, axis=1)
    o_lat, o_ctx = [], []
    for z_c, z_l, lb, reverse in ((zf_c, zf_l, lb_fwd, False), (zb_c, zb_l, lb_bwd, True)):
        orient = flip if reverse else (lambda z: z)
        logf_c, k_c = forget_gate(z_c, lb)
        logf_l, k_l = forget_gate(z_l, lb)
        oc, s_ctx = chunked_gated_recurrence(orient(q_c) if ctx_out else None, orient(k_c), orient(v_c),
                                             orient(logf_c), s0)
        ol, _ = chunked_gated_recurrence(orient(q_l), orient(k_l), orient(v_l), orient(logf_l), s_ctx)
        o_lat.append(orient(ol))
        if ctx_out:
            o_ctx.append(orient(oc))
    y_lat = hgrn_readout(o_lat[0] + o_lat[1], g_l, o_norm, w_out)
    y_ctx = hgrn_readout(o_ctx[0] + o_ctx[1], g_c, o_norm, w_out) if ctx_out else None
    return y_ctx, y_lat


def setup_inputs(seed: int = 0) -> dict:
    key = jax.random.key(seed)
    ks = iter(jax.random.split(key, 32))
    d = D_MODEL
    n_s5 = (DEPTH + N_MIXERS - 1) // N_MIXERS
    n_hg = DEPTH // N_MIXERS
    f32 = jnp.float32

    def nrm(shape, scale):
        return scale * jax.random.normal(next(ks), shape, f32)

    def gain(shape):
        return 1.0 + 0.05 * jax.random.normal(next(ks), shape, f32)

    return {
        "x": nrm((BATCH, SEQ, d), 1.0),
        "c": nrm((BATCH, d), 1.0),
        "ctx": nrm((BATCH, CTX_LEN, d), 1.0),
        "c_ctx": nrm((d,), 1.0),
        "w_mod": nrm((DEPTH, d, 6 * d), 0.5 * d ** -0.5),
        "b_mod": nrm((DEPTH, 6 * d), 0.02),
        "norm_mix_pre": gain((DEPTH, d)),
        "norm_mix_post": gain((DEPTH, d)),
        "norm_mlp_pre": gain((DEPTH, d)),
        "norm_mlp_post": gain((DEPTH, d)),
        "w_mlp_in": nrm((DEPTH, d, MLP_HIDDEN), d ** -0.5),
        "w_mlp_out": nrm((DEPTH, MLP_HIDDEN, d), MLP_HIDDEN ** -0.5),
        "s5_a_re": -0.5 + nrm((n_s5, 2, S5_GROUPS, S5_STATE), 0.01),
        "s5_a_im": math.pi * jnp.arange(S5_STATE, dtype=f32) + nrm((n_s5, 2, S5_GROUPS, S5_STATE), 0.01),
        "s5_log_dt": jax.random.uniform(next(ks), (n_s5, 2, S5_GROUPS), f32,
                                        math.log(S5_DT_MIN), math.log(S5_DT_MAX)),
        "s5_b_re": nrm((n_s5, 2, S5_GROUPS, S5_STATE, S5_GROUP), (2 * S5_GROUP) ** -0.5),
        "s5_b_im": nrm((n_s5, 2, S5_GROUPS, S5_STATE, S5_GROUP), (2 * S5_GROUP) ** -0.5),
        "s5_c_re": nrm((n_s5, 2, S5_GROUPS, S5_GROUP, S5_STATE), S5_STATE ** -0.5),
        "s5_c_im": nrm((n_s5, 2, S5_GROUPS, S5_GROUP, S5_STATE), S5_STATE ** -0.5),
        "s5_d": nrm((n_s5, d), 1.0),
        "s5_w_glu": nrm((n_s5, d, 2 * d), d ** -0.5),
        "hg_w_in": nrm((n_hg, d, 5 * d), d ** -0.5),
        "hg_lb_raw": nrm((2, n_hg, HG_HEADS * HG_DK), 0.1),
        "hg_o_norm": gain((n_hg, d)),
        "hg_w_out": nrm((n_hg, d, d), d ** -0.5),
    }


def reference(x, c, ctx, c_ctx, w_mod, b_mod, norm_mix_pre, norm_mix_post, norm_mlp_pre, norm_mlp_post,
              w_mlp_in, w_mlp_out, s5_a_re, s5_a_im, s5_log_dt, s5_b_re, s5_b_im, s5_c_re, s5_c_im, s5_d,
              s5_w_glu, hg_w_in, hg_lb_raw, hg_o_norm, hg_w_out):
    lb_w = jax.nn.softmax(hg_lb_raw.astype(jnp.float32), axis=1)
    lb = jnp.cumsum(lb_w, axis=1) - lb_w[:, :1]
    x_lat, x_ctx = x, ctx
    for layer in range(DEPTH):
        ctx_live = layer < DEPTH - 1
        j = layer // N_MIXERS
        sh1, sc1, gt1, sh2, sc2, gt2 = adaln(c, w_mod[layer], b_mod[layer])
        csh1, csc1, cgt1, csh2, csc2, cgt2 = adaln(c_ctx, w_mod[layer], b_mod[layer])
        h_lat = modulate(rmsnorm(x_lat, norm_mix_pre[layer]), sh1[:, None], sc1[:, None])
        h_ctx = modulate(rmsnorm(x_ctx, norm_mix_pre[layer]), csh1, csc1)
        if layer % N_MIXERS == 0:
            y_ctx, y_lat = s5_mixer(h_ctx, h_lat, s5_a_re[j], s5_a_im[j], s5_log_dt[j], s5_b_re[j], s5_b_im[j],
                                    s5_c_re[j], s5_c_im[j], s5_d[j], s5_w_glu[j], ctx_live)
        else:
            y_ctx, y_lat = hgrn_mixer(h_ctx, raster_to_colmajor(h_lat), hg_w_in[j], lb[0, j], lb[1, j],
                                      hg_o_norm[j], hg_w_out[j], ctx_live)
            y_lat = colmajor_to_raster(y_lat)
        x_lat = x_lat + gt1[:, None] * rmsnorm(y_lat, norm_mix_post[layer])
        h_lat = modulate(rmsnorm(x_lat, norm_mlp_pre[layer]), sh2[:, None], sc2[:, None])
        x_lat = x_lat + gt2[:, None] * rmsnorm(sq_relu_mlp(h_lat, w_mlp_in[layer], w_mlp_out[layer]),
                                               norm_mlp_post[layer])
        if ctx_live:
            x_ctx = x_ctx + cgt1 * rmsnorm(y_ctx, norm_mix_post[layer])
            h_ctx = modulate(rmsnorm(x_ctx, norm_mlp_pre[layer]), csh2, csc2)
            x_ctx = x_ctx + cgt2 * rmsnorm(sq_relu_mlp(h_ctx, w_mlp_in[layer], w_mlp_out[layer]),
                                           norm_mlp_post[layer])
    return x_lat
```

```cpp
#include <hip/hip_runtime.h>
#include <cstdio>
#include <cstdint>
#define GAS __attribute__((address_space(1)))
#ifndef PG_WGM
#define PG_WGM 8
#endif
namespace pg8 {
#define PG8_LAS __attribute__((address_space(3)))
typedef unsigned short bf16_t;
typedef short bf16x8 __attribute__((ext_vector_type(8)));
typedef float f32x4 __attribute__((ext_vector_type(4)));
typedef unsigned u32x4 __attribute__((ext_vector_type(4)));
constexpr int BM = 256, BK = 64, HALF = 128, HTB = HALF * BK * 2  , STAGE_BYTES = 8 * HTB, NXCD = 8, WGM = PG_WGM;

__host__ __device__ __forceinline__ int lds_byte(int r, int c) { const int st = (r >> 4) * 2 + (c >> 5), rr = r & 15, cc = c & 31, ob = rr * 64 + cc * 2; return st * 1024 + (ob ^ (((ob >> 9) & 1) << 5)); }
__host__ __device__ __forceinline__ void stage_rc(int b, int& R, int& C) { const int st = b / 1024, sb = b % 1024, swz = sb ^ (((sb >> 9) & 1) << 5); R = (st >> 1) * 16 + swz / 64; C = (st & 1) * 32 + (swz % 64) / 2; }
__host__ __device__ __forceinline__ int perm32(int rho) { const int n = rho >> 4, i = rho & 15; return 8 * (i >> 2) + 4 * n + (i & 3); }

struct Unit { int pm, pn; };
struct Gemm { const bf16_t* A; const bf16_t* Bt; int M, N, K; };

struct StaticOrder {
    int nM, nN, nwg, G, c, wgm;
    __host__ __device__ void init(int M, int N, int G_, int c_, int wgm_ = WGM) { nM = M / BM; nN = N / BM; nwg = nM * nN; G = G_; c = c_; wgm = wgm_; }
    __host__ __device__ bool next(int i, Unit& u) const {
        const long L = (long)i * G + c; if (L >= nwg) return false;
        int wgid = (int)L; { const int q = nwg / NXCD, r = nwg % NXCD, xcd = wgid % NXCD, off = wgid / NXCD; wgid = (xcd < r ? xcd * (q + 1) : r * (q + 1) + (xcd - r) * q) + off; }
        const int nig = wgm * nN, gid = wgid / nig, fm = gid * wgm, gsz = (nM - fm) < wgm ? (nM - fm) : wgm;
        u.pm = fm + ((wgid % nig) % gsz); u.pn = (wgid % nig) / gsz; return true;
    }
    __device__ __forceinline__ void a_ready(const Unit&) const {}
    __device__ __forceinline__ void done(const Unit&) const {}
};

__device__ __forceinline__ unsigned cvt_pk_bf16(float lo, float hi) { unsigned r; asm volatile("v_cvt_pk_bf16_f32 %0, %1, %2" : "=v"(r) : "v"(lo), "v"(hi)); return r; }
typedef float f32x2 __attribute__((ext_vector_type(2)));
#ifndef EPI_NT
#define EPI_NT 0
#endif
#if EPI_NT
#define EPI_ST(p, v) __builtin_nontemporal_store((v), (p))
#else
#define EPI_ST(p, v) (*(p) = (v))
#endif
__device__ __forceinline__ float sigmoid_f(float x) { return __builtin_amdgcn_rcpf(1.0f + __expf(-x)); }
__device__ __forceinline__ float silu_f(float x) { return x * sigmoid_f(x); }
__device__ __forceinline__ float logf_gate(float z, float lb, float  ) {
    const float e = __expf(-fabsf(z));
    const float r = __builtin_amdgcn_rcpf(1.0f + e);
    const float sg = z >= 0.f ? r : e * r;
    const float a = fminf(z, 0.0f) - __logf(1.0f + e);
    const float b = __logf(lb + (1.0f - lb) * sg);
    return lb > 0.0f ? b : a;
}

struct EpiF32 {
    static constexpr bool PERM = false, AFTER_DRAIN = false;
    GAS float* C; int ldc;
    __device__ __forceinline__ void operator()(const f32x4 (&acc)[2][2][4][2], const Unit& u, int wr, int wc, int fr, int fq) const {
        const int row0 = u.pm * BM + wr * 64 + fr, col0 = u.pn * BM + wc * 32 + 4 * fq;
#pragma unroll
        for (int ai = 0; ai < 2; ++ai)
#pragma unroll
            for (int m = 0; m < 4; ++m) { GAS float* rowp = C + (size_t)(row0 + ai * HALF + m * 16) * ldc + col0;
#pragma unroll
                for (int bj = 0; bj < 2; ++bj)
#pragma unroll
                    for (int n = 0; n < 2; ++n) *(GAS f32x4*)(rowp + bj * HALF + n * 16) = acc[ai][bj][m][n]; }
    }
};
struct EpiRelu2 {
    static constexpr bool PERM = true, AFTER_DRAIN = false;
    GAS bf16_t* O; int ldc;
    __device__ __forceinline__ void operator()(const f32x4 (&acc)[2][2][4][2], const Unit& u, int wr, int wc, int fr, int fq) const {
        const int row0 = u.pm * BM + wr * 64 + fr, col0 = u.pn * BM + wc * 32 + 8 * fq;
#pragma unroll
        for (int ai = 0; ai < 2; ++ai)
#pragma unroll
            for (int m = 0; m < 4; ++m) { GAS bf16_t* rowp = O + (size_t)(row0 + ai * HALF + m * 16) * ldc + col0;
#pragma unroll
                for (int bj = 0; bj < 2; ++bj) { f32x4 v0 = acc[ai][bj][m][0], v1 = acc[ai][bj][m][1];
#pragma unroll
                    for (int j = 0; j < 4; ++j) { const float a = fmaxf(v0[j], 0.f), b = fmaxf(v1[j], 0.f); v0[j] = a * a; v1[j] = b * b; }
                    u32x4 w; w.x = cvt_pk_bf16(v0[0], v0[1]); w.y = cvt_pk_bf16(v0[2], v0[3]); w.z = cvt_pk_bf16(v1[0], v1[1]); w.w = cvt_pk_bf16(v1[2], v1[3]);
                    EPI_ST((GAS u32x4*)(rowp + bj * HALF), w); } }
    }
};
struct EpiBf16P {
    static constexpr bool PERM = true, AFTER_DRAIN = false;
    GAS bf16_t* O; int ldc;
    __device__ __forceinline__ void operator()(const f32x4 (&acc)[2][2][4][2], const Unit& u, int wr, int wc, int fr, int fq) const {
        const int row0 = u.pm * BM + wr * 64 + fr, col0 = u.pn * BM + wc * 32 + 8 * fq;
#pragma unroll
        for (int ai = 0; ai < 2; ++ai)
#pragma unroll
            for (int m = 0; m < 4; ++m) { GAS bf16_t* rowp = O + (size_t)(row0 + ai * HALF + m * 16) * ldc + col0;
#pragma unroll
                for (int bj = 0; bj < 2; ++bj) { const f32x4 v0 = acc[ai][bj][m][0], v1 = acc[ai][bj][m][1];
                    u32x4 w; w.x = cvt_pk_bf16(v0[0], v0[1]); w.y = cvt_pk_bf16(v0[2], v0[3]); w.z = cvt_pk_bf16(v1[0], v1[1]); w.w = cvt_pk_bf16(v1[2], v1[3]);
                    EPI_ST((GAS u32x4*)(rowp + bj * HALF), w); } }
    }
};
struct EpiGlu {
    static constexpr bool PERM = true, AFTER_DRAIN = false;
    GAS bf16_t* O; int ldc;
    __device__ __forceinline__ void operator()(const f32x4 (&acc)[2][2][4][2], const Unit& u, int wr, int wc, int fr, int fq) const {
        const int row0 = u.pm * BM + wr * 64 + fr, col0 = u.pn * HALF + wc * 32 + 8 * fq;
#pragma unroll
        for (int ai = 0; ai < 2; ++ai)
#pragma unroll
            for (int m = 0; m < 4; ++m) { GAS bf16_t* rowp = O + (size_t)(row0 + ai * HALF + m * 16) * ldc + col0;
                f32x4 o0, o1;
#pragma unroll
                for (int j = 0; j < 4; ++j) { o0[j] = acc[ai][0][m][0][j] * sigmoid_f(acc[ai][1][m][0][j]); o1[j] = acc[ai][0][m][1][j] * sigmoid_f(acc[ai][1][m][1][j]); }
                u32x4 w; w.x = cvt_pk_bf16(o0[0], o0[1]); w.y = cvt_pk_bf16(o0[2], o0[3]); w.z = cvt_pk_bf16(o1[0], o1[1]); w.w = cvt_pk_bf16(o1[2], o1[3]);
                EPI_ST((GAS u32x4*)(rowp), w); }
    }
};
struct EpiHgIn {
    static constexpr bool PERM = true, AFTER_DRAIN = false;
    GAS bf16_t* Q; size_t hstride; GAS bf16_t* LF; size_t fstride; const GAS float* lbv;
    template <int BJ> __device__ __forceinline__ void gate_half(const f32x4 (&acc)[2][2][4][2], GAS bf16_t* O, const GAS float* lbp, int row0, int col0) const {
        const f32x4 lb0 = *(const GAS f32x4*)(lbp + BJ * HALF), lb1 = *(const GAS f32x4*)(lbp + BJ * HALF + 4);
#pragma unroll
        for (int ai = 0; ai < 2; ++ai)
#pragma unroll
            for (int m = 0; m < 4; ++m) { GAS bf16_t* rowp = O + (size_t)(row0 + ai * HALF + m * 16) * 2048 + col0 + BJ * HALF;
                f32x4 o0, o1;
#pragma unroll
                for (int j = 0; j < 4; ++j) { o0[j] = logf_gate(acc[ai][BJ][m][0][j], lb0[j], 0.f); o1[j] = logf_gate(acc[ai][BJ][m][1][j], lb1[j], 0.f); }
                u32x4 w; w.x = cvt_pk_bf16(o0[0], o0[1]); w.y = cvt_pk_bf16(o0[2], o0[3]); w.z = cvt_pk_bf16(o1[0], o1[1]); w.w = cvt_pk_bf16(o1[2], o1[3]);
                EPI_ST((GAS u32x4*)(rowp), w); }
    }
    __device__ __forceinline__ void operator()(const f32x4 (&acc)[2][2][4][2], const Unit& u, int wr, int wc, int fr, int fq) const {
        const int typ = u.pn >> 3, row0 = u.pm * BM + wr * 64 + fr, col0 = (u.pn & 7) * BM + wc * 32 + 8 * fq;
        if (typ == 2 || typ == 3) {
            GAS bf16_t* O = LF + (size_t)(typ - 2) * fstride;
            const GAS float* lbp = lbv + (typ == 2 ? 0 : 2048) + col0;
            gate_half<0>(acc, O, lbp, row0, col0); gate_half<1>(acc, O, lbp, row0, col0);
        } else {
            GAS bf16_t* O = Q + (size_t)((typ >> 2) * 2 + (typ & 1)) * hstride; const bool act = typ != 1;
#pragma unroll
            for (int ai = 0; ai < 2; ++ai)
#pragma unroll
                for (int m = 0; m < 4; ++m) { GAS bf16_t* rowp = O + (size_t)(row0 + ai * HALF + m * 16) * 2048 + col0;
#pragma unroll
                    for (int bj = 0; bj < 2; ++bj) { f32x4 v0 = acc[ai][bj][m][0], v1 = acc[ai][bj][m][1];
                        if (act) {
#pragma unroll
                            for (int j = 0; j < 4; ++j) { v0[j] = silu_f(v0[j]); v1[j] = silu_f(v1[j]); } }
                        u32x4 w; w.x = cvt_pk_bf16(v0[0], v0[1]); w.y = cvt_pk_bf16(v0[2], v0[3]); w.z = cvt_pk_bf16(v1[0], v1[1]); w.w = cvt_pk_bf16(v1[2], v1[3]);
                        EPI_ST((GAS u32x4*)(rowp + bj * HALF), w); } }
        }
    }
};
#ifndef PG_AUX_A
#define PG_AUX_A 0
#endif
#ifndef PG_AUX_B
#define PG_AUX_B 0
#endif
template <class Epi, class Sched, bool ALIGN_EPI = false, bool SP2 = false>
__device__ __forceinline__ void gemm_phase(PG8_LAS unsigned char* lds, const Gemm g, const Sched& S, const Epi& E) {
    int tid_ = threadIdx.x; asm volatile("" : "+v"(tid_));
    const int tid = tid_, wid = __builtin_amdgcn_readfirstlane(tid >> 6), lane = tid & 63, wr = wid >> 2, wc = wid & 3, fr = lane & 15, fq = lane >> 4;
    const int K = g.K, nt = K / BK;
    unsigned voffA[2], voffB[2];
#pragma unroll
    for (int i = 0; i < 2; ++i) { int R, C; stage_rc(tid * 16 + i * 8192, R, C); const int Rb = Epi::PERM ? ((R & ~31) + perm32(R & 31)) : R;
        voffA[i] = (unsigned)(R * K + C) * 2u; voffB[i] = (unsigned)(Rb * K + C) * 2u; }
    const size_t kstep = (size_t)(BK * 2);
    const size_t hstep = (size_t)HALF * K * 2;
    const size_t tstep = 2 * hstep;
    const unsigned ldsw = (unsigned)wid * 1024u;
    const int aoff = lds_byte(wr * 64 + fr, fq * 8), boff = lds_byte(wc * 32 + fr, fq * 8);
#define PG8_SA(b, h) (((b) * 2 + (h)) * HTB)
#define PG8_SB(b, h) ((4 + (b) * 2 + (h)) * HTB)
#define PG8_STAGE(bufoff, gbase, voff) do { _Pragma("unroll") for (int _i = 0; _i < 2; ++_i) \
        __builtin_amdgcn_global_load_lds((const unsigned*)((const char*)(gbase) + (voff)[_i]), (PG8_LAS unsigned*)(lds + (bufoff) + ldsw + _i * 8192), 16, 0, PG_AUX_B); } while (0)
#define PG8_STAGEA(bufoff, gbase, voff) do { _Pragma("unroll") for (int _i = 0; _i < 2; ++_i) \
        __builtin_amdgcn_global_load_lds((const unsigned*)((const char*)(gbase) + (voff)[_i]), (PG8_LAS unsigned*)(lds + (bufoff) + ldsw + _i * 8192), 16, 0, PG_AUX_A); } while (0)
#define PG8_LDA(dst, b, h) do { _Pragma("unroll") for (int m = 0; m < 4; ++m) _Pragma("unroll") for (int k = 0; k < 2; ++k) dst[m][k] = *(const PG8_LAS bf16x8*)(lds + PG8_SA(b, h) + aoff + m * 2048 + k * 1024); } while (0)
#define PG8_LDB(dst, b, h) do { _Pragma("unroll") for (int n = 0; n < 2; ++n) _Pragma("unroll") for (int k = 0; k < 2; ++k) dst[n][k] = *(const PG8_LAS bf16x8*)(lds + PG8_SB(b, h) + boff + n * 2048 + k * 1024); } while (0)
#define PG8_MMA(ai, bj, At, Bt) do { __builtin_amdgcn_s_setprio(1); _Pragma("unroll") for (int m = 0; m < 4; ++m) _Pragma("unroll") for (int n = 0; n < 2; ++n) _Pragma("unroll") for (int k = 0; k < 2; ++k) \
        acc[ai][bj][m][n] = __builtin_amdgcn_mfma_f32_16x16x32_bf16(Bt[n][k], At[m][k], acc[ai][bj][m][n], 0, 0, 0); __builtin_amdgcn_s_setprio(0); } while (0)
#define PG8_WAIT_V(n) asm volatile("s_waitcnt vmcnt(" #n ")" ::: "memory")
#define PG8_WAIT_L(n) asm volatile("s_waitcnt lgkmcnt(" #n ")" ::: "memory")
#define PG8_BAR __builtin_amdgcn_s_barrier()
#define PG8_SCHED __builtin_amdgcn_sched_barrier(0)
    Unit cur, nxt; int ui = 0;
    if (!S.next(0, cur)) return;
    f32x4 acc[2][2][4][2];
#pragma unroll
    for (int a = 0; a < 2; ++a)
#pragma unroll
        for (int b = 0; b < 2; ++b)
#pragma unroll
            for (int m = 0; m < 4; ++m)
#pragma unroll
                for (int n = 0; n < 2; ++n) acc[a][b][m][n] = (f32x4){0.f, 0.f, 0.f, 0.f};
    bf16x8 At[4][2], B0[2][2], B1[2][2];
    const char* cA = (const char*)g.A + (size_t)cur.pm * tstep; const char* cB = (const char*)g.Bt + (size_t)cur.pn * tstep;
    S.a_ready(cur);
    if constexpr (SP2) {
        PG8_STAGE(PG8_SB(0, 0), cB, voffB); PG8_STAGE(PG8_SB(0, 1), cB + hstep, voffB); PG8_STAGEA(PG8_SA(0, 0), cA, voffA); PG8_STAGEA(PG8_SA(0, 1), cA + hstep, voffA);
        if (wr == 1) PG8_BAR;
        PG8_WAIT_V(2); PG8_BAR;
        PG8_STAGE(PG8_SB(1, 0), cB + kstep, voffB); PG8_STAGEA(PG8_SA(1, 0), cA + kstep, voffA); PG8_STAGE(PG8_SB(1, 1), cB + hstep + kstep, voffB);
        PG8_WAIT_V(6); PG8_BAR;
    } else {
        PG8_STAGE(PG8_SB(0, 0), cB, voffB); PG8_STAGEA(PG8_SA(0, 0), cA, voffA); PG8_STAGE(PG8_SB(0, 1), cB + hstep, voffB); PG8_STAGEA(PG8_SA(0, 1), cA + hstep, voffA);
        if (wr == 1) PG8_BAR;
        PG8_WAIT_V(4); PG8_BAR;
        PG8_STAGE(PG8_SB(1, 0), cB + kstep, voffB); PG8_STAGEA(PG8_SA(1, 0), cA + kstep, voffA); PG8_STAGE(PG8_SB(1, 1), cB + hstep + kstep, voffB);
        PG8_WAIT_V(6); PG8_BAR;
    }
    for (;;) {
        const bool has_next = S.next(ui + 1, nxt);
        const char* nA = has_next ? (const char*)g.A + (size_t)nxt.pm * tstep : cA; const char* nB = has_next ? (const char*)g.Bt + (size_t)nxt.pn * tstep : cB;
        for (int t = 0; t < nt; t += 2) {
            const bool last = (t == nt - 2);
            const char* a1 = cA + (size_t)(t + 1) * kstep;
            const char* a2 = last ? nA : cA + (size_t)(t + 2) * kstep; const char* b2 = last ? nB : cB + (size_t)(t + 2) * kstep;
            const char* a3 = a2 + kstep; const char* b3 = b2 + kstep;
            if (last && has_next) S.a_ready(nxt);
            if constexpr (SP2) {
            PG8_LDB(B0, 0, 0); PG8_LDB(B1, 0, 1); PG8_SCHED; PG8_LDA(At, 0, 0); PG8_STAGEA(PG8_SA(1, 1), a1 + hstep, voffA);
            PG8_WAIT_V(8); PG8_WAIT_L(0); PG8_BAR; PG8_MMA(0, 0, At, B0); PG8_MMA(0, 1, At, B1); PG8_BAR; PG8_SCHED;
            PG8_LDA(At, 0, 1); PG8_STAGE(PG8_SB(0, 0), b2, voffB); PG8_STAGE(PG8_SB(0, 1), b2 + hstep, voffB); PG8_STAGEA(PG8_SA(0, 0), a2, voffA);
            PG8_WAIT_V(8); PG8_WAIT_L(0); PG8_BAR; PG8_MMA(1, 0, At, B0); PG8_MMA(1, 1, At, B1); PG8_BAR; PG8_SCHED;
            PG8_LDB(B0, 1, 0); PG8_LDB(B1, 1, 1); PG8_SCHED; PG8_LDA(At, 1, 0); PG8_STAGEA(PG8_SA(0, 1), a2 + hstep, voffA);
            PG8_WAIT_V(8); PG8_WAIT_L(0); PG8_BAR; PG8_MMA(0, 0, At, B0); PG8_MMA(0, 1, At, B1); PG8_BAR; PG8_SCHED;
            PG8_LDA(At, 1, 1); PG8_STAGE(PG8_SB(1, 0), b3, voffB); PG8_STAGE(PG8_SB(1, 1), b3 + hstep, voffB); PG8_STAGEA(PG8_SA(1, 0), a3, voffA);
            PG8_WAIT_V(8); PG8_WAIT_L(0); PG8_BAR; PG8_MMA(1, 0, At, B0); PG8_MMA(1, 1, At, B1); PG8_BAR; PG8_SCHED;
            } else {
            PG8_LDB(B0, 0, 0); PG8_SCHED; PG8_LDA(At, 0, 0); PG8_STAGEA(PG8_SA(1, 1), a1 + hstep, voffA);
            PG8_WAIT_L(8); PG8_BAR; PG8_WAIT_L(0); PG8_MMA(0, 0, At, B0); PG8_BAR; PG8_SCHED;
            PG8_LDB(B1, 0, 1); PG8_STAGE(PG8_SB(0, 0), b2, voffB);
            PG8_BAR; PG8_WAIT_L(0); PG8_MMA(0, 1, At, B1); PG8_BAR;
            PG8_LDA(At, 0, 1); PG8_STAGEA(PG8_SA(0, 0), a2, voffA);
            PG8_BAR; PG8_WAIT_L(0); PG8_MMA(1, 0, At, B0); PG8_BAR; PG8_SCHED;
            PG8_STAGE(PG8_SB(0, 1), b2 + hstep, voffB);
            PG8_WAIT_V(6); PG8_BAR; PG8_MMA(1, 1, At, B1); PG8_BAR;
            PG8_LDB(B0, 1, 0); PG8_SCHED; PG8_LDA(At, 1, 0); PG8_STAGEA(PG8_SA(0, 1), a2 + hstep, voffA);
            PG8_WAIT_L(8); PG8_BAR; PG8_WAIT_L(0); PG8_MMA(0, 0, At, B0); PG8_BAR; PG8_SCHED;
            PG8_LDB(B1, 1, 1); PG8_STAGE(PG8_SB(1, 0), b3, voffB);
            PG8_BAR; PG8_WAIT_L(0); PG8_MMA(0, 1, At, B1); PG8_BAR;
            PG8_LDA(At, 1, 1); PG8_STAGEA(PG8_SA(1, 0), a3, voffA);
            PG8_BAR; PG8_WAIT_L(0); PG8_MMA(1, 0, At, B0); PG8_BAR; PG8_SCHED;
            PG8_STAGE(PG8_SB(1, 1), b3 + hstep, voffB);
            PG8_WAIT_V(6); PG8_BAR; PG8_MMA(1, 1, At, B1); PG8_BAR;
            }
        }
        if constexpr (ALIGN_EPI) { if (wr == 0) PG8_BAR; }
        if constexpr (!Epi::AFTER_DRAIN) { E(acc, cur, wr, wc, fr, fq); S.done(cur); }
        if (!has_next) break;
#pragma unroll
        for (int a = 0; a < 2; ++a)
#pragma unroll
            for (int b = 0; b < 2; ++b)
#pragma unroll
                for (int m = 0; m < 4; ++m)
#pragma unroll
                    for (int n = 0; n < 2; ++n) acc[a][b][m][n] = (f32x4){0.f, 0.f, 0.f, 0.f};
        cur = nxt; cA = nA; cB = nB; ++ui;
        if constexpr (ALIGN_EPI) { if (wr == 1) PG8_BAR; }
    }
    PG8_WAIT_V(0);
    if constexpr (!ALIGN_EPI) { if (wr == 0) PG8_BAR; }
    PG8_BAR;
    if constexpr (Epi::AFTER_DRAIN) { E.fused(acc, cur, wr, wc, fr, fq, lds, wid, lane); S.done(cur); }
#undef PG8_SA
#undef PG8_SB
#undef PG8_STAGE
#undef PG8_STAGEA
#undef PG8_LDA
#undef PG8_LDB
#undef PG8_MMA
#undef PG8_WAIT_V
#undef PG8_WAIT_L
#undef PG8_BAR
#undef PG8_SCHED
}
}
constexpr int DM = 2048, SEQ = 8192, CTXL = 256, MTOT = SEQ + CTXL, HID = 8192, NMOD = 6 * DM;
constexpr int NWAVES = 8, NTHR = 512;
constexpr float NEPS = 1e-6f;
#ifndef MK_PER_PHASE
#define MK_PER_PHASE 0
#endif
constexpr int NPHASES = 35;
#ifndef PG_CID
#define PG_CID ((int)((blockIdx.x >> 5) + 8 * (blockIdx.x & 31)))
#endif
#ifndef PG_ALIGN
#define PG_ALIGN true
#endif
#ifndef PG_SP2
#define PG_SP2 true
#endif
#ifndef REP_P0
#define REP_P0 0
#endif
#ifndef REP_S5
#define REP_S5 0
#endif
#ifndef REP_HG
#define REP_HG 0
#endif
#ifndef REP_GEMM
#define REP_GEMM 0
#endif
#ifndef REP_BAR
#define REP_BAR 0
#endif
#ifndef REP_R1
#define REP_R1 0
#endif
#ifndef REP_R2
#define REP_R2 0
#endif
#ifndef REP_GGLU
#define REP_GGLU 0
#endif
#ifndef REP_GIN
#define REP_GIN 0
#endif
#ifndef REP_GOUT
#define REP_GOUT 0
#endif
#ifndef REP_GHG
#define REP_GHG 0
#endif
#ifndef WGM_GLU
#define WGM_GLU 2
#endif
#ifndef WGM_IN
#define WGM_IN 2
#endif
#ifndef WGM_OUT
#define WGM_OUT 2
#endif
#ifndef WGM_HG
#define WGM_HG 2
#endif
#ifndef WGM_OP
#define WGM_OP 2
#endif
#ifndef REP_RN
#define REP_RN 0
#endif
#ifndef REP_CTX
#define REP_CTX 0
#endif
#ifndef REP_THIN
#define REP_THIN 0
#endif

constexpr size_t MiB = 1u << 20;
constexpr size_t WS_CTL = 0, CTL_ZERO_BYTES = 1 * MiB;
constexpr size_t WS_MOD = 1 * MiB;
constexpr size_t WS_LBV = 2 * MiB;
constexpr size_t WS_PART = 3 * MiB;
constexpr size_t WS_W1 = 16 * MiB;
constexpr size_t WS_W2 = WS_W1 + 128 * MiB;
constexpr size_t WS_WGLU = WS_W2 + 128 * MiB;
constexpr size_t WS_WIN = WS_WGLU + 32 * MiB;
constexpr size_t WS_WOUT = WS_WIN + 80 * MiB;
constexpr size_t WS_X = WS_WOUT + 16 * MiB;
constexpr size_t WS_H = WS_X + 66 * MiB;
constexpr size_t WS_Z = WS_H + 33 * MiB;
constexpr size_t WS_Y1 = WS_Z + 33 * MiB;
constexpr size_t WS_Y2 = WS_Y1 + 66 * MiB;
constexpr size_t WS_HID = WS_Y2 + 66 * MiB;
constexpr size_t WS_Q = WS_HID + 132 * MiB;
constexpr size_t WS_V = WS_Q + 33 * MiB;
constexpr size_t WS_SG = WS_V + 33 * MiB;
constexpr size_t WS_LF = WS_SG + 33 * MiB;
constexpr size_t WS_LB = WS_LF + 66 * MiB;
constexpr size_t WS_OF = WS_LB + 66 * MiB;
constexpr size_t WS_OB = WS_OF + 66 * MiB;
constexpr size_t WS_REC = WS_OB + 66 * MiB;
constexpr size_t WS_SEGS = WS_REC + 224 * MiB;
constexpr size_t WS_SEGD = WS_SEGS + 16 * MiB;
constexpr size_t WS_YP1 = WS_SEGD + 1 * MiB;
constexpr size_t WS_YP2 = WS_YP1 + 8 * MiB;
constexpr size_t WS_END = WS_YP2 + 8 * MiB;
constexpr int CW_BAR = 4096;

constexpr int RING_OFF = 0, RING_BYTES = 135168;
constexpr int LDSCTL_OFF = RING_BYTES, MISC_OFF = LDSCTL_OFF + 320;
constexpr int LDS_BYTES = 147456;

#define LAS __attribute__((address_space(3)))
typedef unsigned short bf16;
typedef unsigned v4u __attribute__((ext_vector_type(4)));
typedef unsigned v2u __attribute__((ext_vector_type(2)));
typedef float f32x4 __attribute__((ext_vector_type(4)));
typedef short bf16x8 __attribute__((ext_vector_type(8)));
#define LDS_WAIT() asm volatile("s_waitcnt lgkmcnt(0)" ::: "memory")
#define VM_WAIT() asm volatile("s_waitcnt vmcnt(0)" ::: "memory")
__device__ __forceinline__ unsigned f2bf(float f) { unsigned u = __builtin_bit_cast(unsigned, f); return (u + 0x7fffu + ((u >> 16) & 1u)) >> 16; }
__device__ __forceinline__ unsigned pk2(float lo, float hi) { return f2bf(lo) | (f2bf(hi) << 16); }
__device__ __forceinline__ float bflo(unsigned w) { return __builtin_bit_cast(float, w << 16); }
__device__ __forceinline__ float bfhi(unsigned w) { return __builtin_bit_cast(float, w & 0xffff0000u); }
typedef float f32x2 __attribute__((ext_vector_type(2)));
typedef __bf16 bf16x2n __attribute__((ext_vector_type(2)));
__device__ __forceinline__ unsigned pkbf(float lo, float hi) { f32x2 v = {lo, hi}; return __builtin_bit_cast(unsigned, __builtin_convertvector(v, bf16x2n)); }
__device__ __forceinline__ float bf1(bf16 b) { return __builtin_bit_cast(float, ((unsigned)b) << 16); }

#define XB_TMO      128
#define XB_XCNT(j)  (256  + 64 * (j))
#define XB_XSUB(j)  (1280 + 64 * (j))
#define XB_XGEN(j)  (2304 + 64 * (j))
#define XB_TOP      3328
#define XB_TOPGEN   3392
#define XCD_BAR_WORDS 3456
#define XB_SPIN_CAP (1u << 18)

__device__ __forceinline__ unsigned xb_ld(unsigned* p)              { return __hip_atomic_load(p, __ATOMIC_RELAXED, __HIP_MEMORY_SCOPE_AGENT); }
__device__ __forceinline__ unsigned xb_add(unsigned* p, unsigned v) { return __hip_atomic_fetch_add(p, v, __ATOMIC_RELAXED, __HIP_MEMORY_SCOPE_AGENT); }
__device__ __forceinline__ unsigned xb_xcc_id() { return (unsigned)__builtin_amdgcn_s_getreg((3 << 11) | 20) & 0xFu; }
#define XB_SPIN(cond, bar) do { unsigned _sp = 0; while (cond) { __builtin_amdgcn_s_sleep(1); \
    if ((++_sp & 255u) == 0u) { if (xb_ld(&(bar)[XB_TMO])) break; if (_sp > XB_SPIN_CAP) { atomicAdd(&(bar)[XB_TMO], 1u); break; } } } } while (0)

struct XcdBarrier {
    unsigned* bar; unsigned x;
    volatile LAS unsigned* st;
};

__device__ __forceinline__ XcdBarrier xcd_barrier_post(unsigned* bar, volatile LAS unsigned* st) {
    XcdBarrier b; b.bar = bar; b.x = xb_xcc_id(); b.st = st;
    if (threadIdx.x == 0) (void)xb_add(&bar[XB_XCNT(b.x)], 1u);
    return b;
}
__device__ __forceinline__ void xcd_barrier_complete(unsigned* bar, unsigned x, unsigned& nloc, unsigned& nx) {
    const unsigned G = gridDim.x * gridDim.y * gridDim.z;
    unsigned sum, cnt, mine, sp = 0u;
    for (;;) {
        sum = 0u; cnt = 0u; mine = 0u;
#pragma unroll
        for (unsigned j = 0; j < 16; ++j) { const unsigned c = xb_ld(&bar[XB_XCNT(j)]); sum += c; cnt += (c > 0u) ? 1u : 0u; mine = (j == x) ? c : mine; }
        if (sum == G) break;
        __builtin_amdgcn_s_sleep(1);
        if ((++sp & 255u) == 0u) { if (xb_ld(&bar[XB_TMO])) break; if (sp > XB_SPIN_CAP) { atomicAdd(&bar[XB_TMO], 1u); break; } }
    }
    nloc = mine > 0u ? mine : 1u; nx = cnt > 0u ? cnt : 1u;
}

__device__ __forceinline__ void xcd_barrier(const XcdBarrier& b) {
    asm volatile("s_waitcnt vmcnt(0)" ::: "memory");
    __syncthreads();
    if (threadIdx.x == 0) {
        unsigned* bar = b.bar;
        __builtin_amdgcn_s_waitcnt(0);
        unsigned nloc = b.st[0], nx = b.st[1];
        if (nloc == 0u) { xcd_barrier_complete(bar, b.x, nloc, nx); b.st[0] = nloc; b.st[1] = nx; }
        const unsigned old = xb_add(&bar[XB_XSUB(b.x)], 1u);
        const unsigned gen = old / nloc;
        if (old + 1u == (gen + 1u) * nloc) {
            __builtin_amdgcn_fence(__ATOMIC_RELEASE, "agent");
            asm volatile("s_waitcnt vmcnt(0)" ::: "memory");
            const unsigned og = xb_add(&bar[XB_TOP], 1u);
            const unsigned tg = og / nx;
            if (og + 1u == (tg + 1u) * nx) xb_add(&bar[XB_TOPGEN], 1u);
            else XB_SPIN(xb_ld(&bar[XB_TOPGEN]) == tg, bar);
            __builtin_amdgcn_fence(__ATOMIC_ACQUIRE, "agent");
            xb_add(&bar[XB_XGEN(b.x)], 1u);
            asm volatile("s_waitcnt vmcnt(0)" ::: "memory");
        } else {
            XB_SPIN(xb_ld(&bar[XB_XGEN(b.x)]) == gen, bar);
            __builtin_amdgcn_fence(__ATOMIC_ACQUIRE, "agent");
            asm volatile("s_waitcnt vmcnt(0)" ::: "memory");
        }
    }
    __syncthreads();
}

typedef const unsigned short* gen_cbf; typedef unsigned* gen_u32p;
struct Args { const float* in[25]; float* out; unsigned char* ws; int ph_lo, ph_hi; };
template <class T> __device__ __forceinline__ GAS T* opq(T* p) { GAS T* g = (GAS T*)p; asm volatile("" : "+s"(g)); return g; }
template <class T> __device__ __forceinline__ GAS T* opq(GAS T* g) { asm volatile("" : "+s"(g)); return g; }
__device__ __forceinline__ int opqv(int v) { asm volatile("" : "+v"(v)); return v; }
#define AIN(k) opq(args.in[k])
#define WSP(off) (opq(F.ws) + (off))
struct Frame {
    LAS unsigned char* lds;
    volatile LAS unsigned* MISC;
    int tid, lane, wave, vcu, G;
    GAS unsigned char* ws;
    GAS float* out;
};
__device__ __forceinline__ int opqs(int v) { asm volatile("" : "+s"(v)); return v; }
__device__ __forceinline__ void relane(Frame& F) { F.lane = opqv(F.lane); F.tid = opqv(F.tid); F.wave = opqs(F.wave); F.vcu = opqs(F.vcu);
    unsigned lb = (unsigned)(size_t)F.lds; asm volatile("" : "+s"(lb)); F.lds = (LAS unsigned char*)(size_t)lb; }
__device__ __forceinline__ float xshfl(float v, int lane, int o) { return __builtin_bit_cast(float, __builtin_amdgcn_ds_bpermute((lane ^ o) << 2, __builtin_bit_cast(int, v))); }
__device__ __forceinline__ float wave_sum(float v, int lane) {
#pragma unroll
    for (int o = 1; o < 64; o <<= 1) v += xshfl(v, lane, o);
    return v;
}

__device__ __forceinline__ void p0_transpose_item(const GAS float* W, int K, int N, GAS bf16* WT, int k0, int n0, int dst_row0, LAS unsigned char* scr, int lane) {
    const int n4 = (lane & 15) * 4, kp = lane >> 4;
    const GAS float* src = W + (size_t)(k0 + 2 * kp) * N + n0 + n4;
    f32x4 v[16];
#pragma unroll
    for (int i = 0; i < 8; ++i) { v[2 * i] = *(const GAS f32x4*)(src + (size_t)(8 * i) * N); v[2 * i + 1] = *(const GAS f32x4*)(src + (size_t)(8 * i + 1) * N); }
#pragma unroll
    for (int i = 0; i < 8; ++i) {
#pragma unroll
        for (int e = 0; e < 4; ++e) *(LAS unsigned*)(scr + (n4 + e) * 144 + (8 * i + 2 * kp) * 2) = pkbf(v[2 * i][e], v[2 * i + 1][e]);
    }
    LDS_WAIT(); asm volatile("" ::: "memory");
    const int c = lane & 7, nr = lane >> 3;
#pragma unroll
    for (int j = 0; j < 8; ++j) { const int n = nr + 8 * j; const v4u o = *(const LAS v4u*)(scr + n * 144 + c * 16);
        *(GAS v4u*)(WT + (size_t)(dst_row0 + n) * K + k0 + 8 * c) = o; }
    LDS_WAIT(); asm volatile("" ::: "memory");
}
__device__ __forceinline__ void phase_p0(Frame& F, const Args& args) {
    relane(F);
    LAS unsigned char* scr = F.lds + RING_OFF + F.wave * 9216;
    const int gw = F.vcu * NWAVES + F.wave, NGW = F.G * NWAVES;
    constexpr int I_W1 = (DM / 64) * (HID / 64);
    constexpr int I_W2 = (HID / 64) * (DM / 64);
    constexpr int I_GLU = (DM / 64) * (4096 / 64);
    constexpr int I_IN = (DM / 64) * (10240 / 64);
    constexpr int I_OUT = (DM / 64) * (DM / 64);
    constexpr int T_W1 = 4 * I_W1, T_W2 = 4 * I_W2, T_GLU = 2 * I_GLU, T_IN = 2 * I_IN, T_OUT = 2 * I_OUT;
    constexpr int NITEMS = T_W1 + T_W2 + T_GLU + T_IN + T_OUT;
    for (int it = gw; it < NITEMS; it += NGW) {
        int r = it;
        if (r < T_W1) { const int l = r / I_W1, q = r % I_W1, nblk = HID / 64, qg = q >> 3, qw = q & 3, qk = (q >> 2) & 1, kb = 2 * (qg / (nblk / 4)) + qk, nb = 4 * (qg % (nblk / 4)) + qw;
            p0_transpose_item(AIN(10) + (size_t)l * DM * HID, DM, HID, (GAS bf16*)(WSP(WS_W1)) + (size_t)l * HID * DM, 64 * kb, 64 * nb, 64 * nb, scr, F.lane); continue; } r -= T_W1;
        if (r < T_W2) { const int l = r / I_W2, q = r % I_W2, nblk = DM / 64, qg = q >> 3, qw = q & 3, qk = (q >> 2) & 1, kb = 2 * (qg / (nblk / 4)) + qk, nb = 4 * (qg % (nblk / 4)) + qw;
            p0_transpose_item(AIN(11) + (size_t)l * HID * DM, HID, DM, (GAS bf16*)(WSP(WS_W2)) + (size_t)l * DM * HID, 64 * kb, 64 * nb, 64 * nb, scr, F.lane); continue; } r -= T_W2;
        if (r < T_GLU) { const int l = r / I_GLU, q = r % I_GLU, nblk = 4096 / 64, qg = q >> 3, qw = q & 3, qk = (q >> 2) & 1, kb = 2 * (qg / (nblk / 4)) + qk, nb = 4 * (qg % (nblk / 4)) + qw, n0 = 64 * nb;
            const int c = n0 & 2047, dst = 256 * (c >> 7) + (n0 >= 2048 ? 128 : 0) + (c & 127);
            p0_transpose_item(AIN(20) + (size_t)l * DM * 4096, DM, 4096, (GAS bf16*)(WSP(WS_WGLU)) + (size_t)l * 4096 * DM, 64 * kb, n0, dst, scr, F.lane); continue; } r -= T_GLU;
        if (r < T_IN) { const int l = r / I_IN, q = r % I_IN, nblk = 10240 / 64, qg = q >> 3, qw = q & 3, qk = (q >> 2) & 1, kb = 2 * (qg / (nblk / 4)) + qk, nb = 4 * (qg % (nblk / 4)) + qw;
            p0_transpose_item(AIN(21) + (size_t)l * DM * 10240, DM, 10240, (GAS bf16*)(WSP(WS_WIN)) + (size_t)l * 10240 * DM, 64 * kb, 64 * nb, 64 * nb, scr, F.lane); continue; } r -= T_IN;
        { const int l = r / I_OUT, q = r % I_OUT, nblk = DM / 64, qg = q >> 3, qw = q & 3, qk = (q >> 2) & 1, kb = 2 * (qg / (nblk / 4)) + qk, nb = 4 * (qg % (nblk / 4)) + qw;
            p0_transpose_item(AIN(24) + (size_t)l * DM * DM, DM, DM, (GAS bf16*)(WSP(WS_WOUT)) + (size_t)l * DM * DM, 64 * kb, 64 * nb, 64 * nb, scr, F.lane); }
    }
    __syncthreads();
    LAS float* sc = (LAS float*)(F.lds + RING_OFF);
    for (int i = F.tid; i < 2 * DM; i += NTHR) { const float v = i < DM ? AIN(1)[i] : AIN(3)[i - DM]; sc[i] = v / (1.0f + __expf(-v)); }
    __syncthreads();
    LAS float* red = sc + 2 * DM;
    GAS float* PART = (GAS float*)(WSP(WS_PART));
    for (int it = F.vcu; it < 4 * 16 * 12; it += F.G) {
        const int l = it / 192, q = it % 192, kc = q / 12, cb = q % 12;
        const int c4 = F.tid & 255, rh = F.tid >> 8, col = cb * 1024 + c4 * 4;
        const GAS float* wp = AIN(4) + ((size_t)l * DM + kc * 128 + rh * 64) * NMOD + col;
        f32x4 a0 = {0.f, 0.f, 0.f, 0.f}, a1 = {0.f, 0.f, 0.f, 0.f};
#pragma unroll 8
        for (int k = 0; k < 64; ++k) { const f32x4 w = *(const GAS f32x4*)(wp + (size_t)k * NMOD); const float s0 = sc[kc * 128 + rh * 64 + k], s1 = sc[DM + kc * 128 + rh * 64 + k];
            a0 += w * s0; a1 += w * s1; }
        if (rh == 1) { *(LAS f32x4*)(red + c4 * 8) = a0; *(LAS f32x4*)(red + c4 * 8 + 4) = a1; }
        __syncthreads();
        if (rh == 0) { a0 += *(LAS f32x4*)(red + c4 * 8); a1 += *(LAS f32x4*)(red + c4 * 8 + 4);
            GAS float* o = PART + ((size_t)(l * 16 + kc) * 2) * NMOD + col;
            *(GAS f32x4*)o = a0; *(GAS f32x4*)(o + NMOD) = a1; }
        __syncthreads();
    }
}
__device__ __forceinline__ void phase_p1(Frame& F, const Args& args) {
    relane(F);
    const GAS float* PART = (const GAS float*)(WSP(WS_PART)); GAS float* MOD = (GAS float*)(WSP(WS_MOD)); GAS float* LBV = (GAS float*)(WSP(WS_LBV));
    const int gt = F.vcu * NTHR + F.tid, NT = F.G * NTHR;
    for (int i = gt; i < 4 * 2 * NMOD; i += NT) { const int l = i / (2 * NMOD), r = i % (2 * NMOD), w = r / NMOD, col = r % NMOD;
        float s = AIN(5)[l * NMOD + col];
#pragma unroll
        for (int kc = 0; kc < 16; ++kc) s += PART[((size_t)(l * 16 + kc) * 2 + w) * NMOD + col];
        MOD[i] = s; }
    for (int i = gt; i < 2 * 2 * DM; i += NT) { const int j = i / (2 * DM), r = i % (2 * DM), d = r / DM, col = r % DM;
        const float r0 = AIN(22)[(d * 2 + 0) * DM + col], r1 = AIN(22)[(d * 2 + 1) * DM + col];
        const float mx = fmaxf(r0, r1), e0 = expf(r0 - mx), e1 = expf(r1 - mx), w0 = e0 / (e0 + e1), w1 = e1 / (e0 + e1);
        LBV[i] = (j == 0) ? (w0 - w0) : ((w0 + w1) - w0); }
}

#define THIN_ROW_BODY(PG, PGP, PPRE, PSH, PSC, LD4, YV) do { \
        if (MODE != 0) { float s_ = 0.f; \
            _Pragma("unroll") for (int j = 0; j < 8; ++j) { const f32x4 yv_ = YV(j); s_ += (yv_.x * yv_.x + yv_.y * yv_.y) + (yv_.z * yv_.z + yv_.w * yv_.w); } \
            const float rs_ = 1.0f / sqrtf(wave_sum(s_, ln_) * (1.0f / DM) + NEPS); \
            _Pragma("unroll") for (int j = 0; j < 8; ++j) { const f32x4 g_ = LD4(PG, j), gp_ = LD4(PGP, j); x[j] += g_ * ((YV(j) * rs_) * gp_); if (j & 1) asm volatile("" ::: "memory"); } } \
        if (MODE == 2) { _Pragma("unroll") for (int j = 0; j < 8; ++j) *(GAS f32x4*)(F.out + (size_t)r * DM + 4 * ln_ + 256 * j) = x[j]; } \
        else { _Pragma("unroll") for (int j = 0; j < 8; ++j) { v2u xo_; xo_.x = pkbf(x[j].x, x[j].y); xo_.y = pkbf(x[j].z, x[j].w); *(GAS v2u*)(Xo + (size_t)r * DM + 4 * ln_ + 256 * j) = xo_; } \
            float s_ = 0.f; \
            _Pragma("unroll") for (int j = 0; j < 8; ++j) s_ += (x[j].x * x[j].x + x[j].y * x[j].y) + (x[j].z * x[j].z + x[j].w * x[j].w); \
            const float rs_ = 1.0f / sqrtf(wave_sum(s_, ln_) * (1.0f / DM) + NEPS); \
            _Pragma("unroll") for (int j = 0; j < 8; ++j) { const f32x4 gp_ = LD4(PPRE, j), sh_ = LD4(PSH, j), sc_ = LD4(PSC, j); \
                const f32x4 h_ = ((x[j] * rs_) * gp_) * (sc_ + 1.0f) + sh_; v2u o_; o_.x = pkbf(h_.x, h_.y); o_.y = pkbf(h_.z, h_.w); \
                *(GAS v2u*)(H + (size_t)r * DM + 4 * ln_ + 256 * j) = o_; if (j & 1) asm volatile("" ::: "memory"); } } } while (0)
#define THIN_YF(j) (y[j])
#define THIN_YP(j) ((f32x4){bflo(yp[j].x), bfhi(yp[j].x), bflo(yp[j].y), bfhi(yp[j].y)})
#define THIN_LDG(P, j) (*(const GAS f32x4*)((P) + 4 * ln_ + 256 * (j)))
#define THIN_LDL(P, j) (*(const LAS f32x4*)((P) + 4 * ln_ + 256 * (j)))
template <int MODE, int CP, bool DRY = false>
__device__ __forceinline__ void thin_rn(Frame& F, const Args& args, const GAS bf16* Y  , const GAS float* Yc  , int nrows_, const GAS float* gpost, const GAS float* modp  , int gate_chunk,
                                        const GAS float* gpre, const GAS float* modh  , int sh_chunk, int sc_chunk) {
    relane(F);
    GAS bf16* X = (GAS bf16*)(WSP(WS_X)); GAS bf16* H = (GAS bf16*)(WSP(WS_H)); GAS bf16* Xo = DRY ? (GAS bf16*)(WSP(WS_REC)) : X;
    const int gw = F.vcu * NWAVES + F.wave, NGW = F.G * NWAVES, nrows = (MODE == 2) ? SEQ : nrows_;
    LAS float* PL = (LAS float*)(F.lds + RING_OFF);
    for (int i = F.tid; i < DM / 4; i += NTHR) {
        if (MODE != 0) { *(LAS f32x4*)(PL + 4 * i) = *(const GAS f32x4*)(modp + gate_chunk * DM + 4 * i); *(LAS f32x4*)(PL + DM + 4 * i) = *(const GAS f32x4*)(gpost + 4 * i); }
        if (MODE != 2) { *(LAS f32x4*)(PL + 2 * DM + 4 * i) = *(const GAS f32x4*)(gpre + 4 * i); *(LAS f32x4*)(PL + 3 * DM + 4 * i) = *(const GAS f32x4*)(modh + sh_chunk * DM + 4 * i); *(LAS f32x4*)(PL + 4 * DM + 4 * i) = *(const GAS f32x4*)(modh + sc_chunk * DM + 4 * i); }
    }
    __syncthreads();
    {
        f32x4 xn[8]; v2u xq[8], yn[8];
        const GAS float* xb0 = AIN(0);
#define THIN_PREF(rr) do { const int ln_ = opqv(F.lane); const int rc_ = (rr) < SEQ ? (rr) : SEQ - 1; if (MODE == 0) { _Pragma("unroll") for (int j = 0; j < 8; ++j) xn[j] = *(const GAS f32x4*)(xb0 + (size_t)rc_ * DM + 4 * ln_ + 256 * j); } \
            else { _Pragma("unroll") for (int j = 0; j < 8; ++j) xq[j] = *(const GAS v2u*)(X + (size_t)rc_ * DM + 4 * ln_ + 256 * j); } \
            if (MODE != 0) { _Pragma("unroll") for (int j = 0; j < 8; ++j) yn[j] = *(const GAS v2u*)(Y + (size_t)rc_ * DM + 4 * ln_ + 256 * j); } } while (0)
        THIN_PREF(gw);
        for (int r = gw; r < SEQ; r += NGW) {
            const int ln_ = opqv(F.lane);
            LAS float* PLr = PL + opqv(0);
            f32x4 x[8]; v2u yp[8];
#pragma unroll
            for (int j = 0; j < 8; ++j) { if (MODE == 0) x[j] = xn[j]; else { x[j] = (f32x4){bflo(xq[j].x), bfhi(xq[j].x), bflo(xq[j].y), bfhi(xq[j].y)}; yp[j] = yn[j]; } }
            THIN_PREF(r + NGW);
            THIN_ROW_BODY(PLr, PLr + DM, PLr + 2 * DM, PLr + 3 * DM, PLr + 4 * DM, THIN_LDL, THIN_YP);
        }
#undef THIN_PREF
    }
    for (int r = SEQ + gw; r < nrows; r += NGW) {
        const int ln_ = opqv(F.lane);
        f32x4 x[8], y[8];
#pragma unroll
        for (int j = 0; j < 8; ++j) { if (MODE == 0) x[j] = *(const GAS f32x4*)(AIN(2) + (size_t)(r - SEQ) * DM + 4 * ln_ + 256 * j);
            else { const v2u t = *(const GAS v2u*)(X + (size_t)r * DM + 4 * ln_ + 256 * j); x[j] = (f32x4){bflo(t.x), bfhi(t.x), bflo(t.y), bfhi(t.y)}; } }
        if (MODE != 0) {
#pragma unroll
            for (int j = 0; j < 8; ++j) y[j] = *(const GAS f32x4*)(Yc + (size_t)(r - SEQ) * DM + 4 * ln_ + 256 * j);
#pragma unroll
            for (int k = 1; k < CP; ++k) { asm volatile("" ::: "memory");
#pragma unroll
                for (int j = 0; j < 8; ++j) y[j] += *(const GAS f32x4*)(Yc + ((size_t)k * CTXL + (r - SEQ)) * DM + 4 * ln_ + 256 * j); }
        }
        const GAS float* gt = modp + NMOD + gate_chunk * DM; const GAS float* shp = modh + NMOD + sh_chunk * DM; const GAS float* scp = modh + NMOD + sc_chunk * DM;
        THIN_ROW_BODY(gt, gpost, gpre, shp, scp, THIN_LDG, THIN_YF);
    }
}
__device__ __forceinline__ float gelu_tanh(float x) { const float u = 1.5957691216f * (x + 0.044715f * x * x * x); return x / (1.0f + __expf(-u)); }
__device__ __forceinline__ void phase_a2(Frame& F, const Args& args) {
    relane(F);
    const GAS v4u* yf = (const GAS v4u*)(WSP(WS_OF)); const GAS v4u* yb = (const GAS v4u*)(WSP(WS_OB)); GAS v4u* z = (GAS v4u*)(WSP(WS_Z));
    const size_t n = (size_t)MTOT * DM / 8;
    for (size_t i = (size_t)F.vcu * NTHR + F.tid; i < n; i += (size_t)F.G * NTHR) {
        const v4u a = yf[i], b = yb[i]; v4u o;
#pragma unroll
        for (int j = 0; j < 4; ++j) { const float lo = gelu_tanh(bflo(a[j]) + bflo(b[j])), hi = gelu_tanh(bfhi(a[j]) + bfhi(b[j])); o[j] = pkbf(lo, hi); }
        z[i] = o; }
}
__device__ __forceinline__ void phase_a4(Frame& F, const Args& args, const GAS float* onorm) {
    relane(F);
    const GAS bf16* OFp = (const GAS bf16*)(WSP(WS_OF)); const GAS bf16* OBp = (const GAS bf16*)(WSP(WS_OB)); const GAS bf16* SG = (const GAS bf16*)(WSP(WS_SG)); GAS bf16* Z = (GAS bf16*)(WSP(WS_Z));
    const int gw = F.vcu * NWAVES + F.wave, NGW = F.G * NWAVES;
    for (int r = gw; r < MTOT; r += NGW) {
#pragma unroll
        for (int j = 0; j < 8; ++j) { const size_t off = (size_t)r * DM + 4 * F.lane + 256 * j;
            const v2u a = *(const GAS v2u*)(OFp + off), b = *(const GAS v2u*)(OBp + off);
            const f32x4 o = {bflo(a.x) + bflo(b.x), bfhi(a.x) + bfhi(b.x), bflo(a.y) + bflo(b.y), bfhi(a.y) + bfhi(b.y)};
            float s = (o.x * o.x + o.y * o.y) + (o.z * o.z + o.w * o.w);
#pragma unroll
            for (int d = 1; d < 32; d <<= 1) s += xshfl(s, F.lane, d);
            const float rs = 1.0f / sqrtf(s * (1.0f / 128.0f) + NEPS);
            const f32x4 gn = *(const GAS f32x4*)(onorm + 4 * F.lane + 256 * j); const v2u sg = *(const GAS v2u*)(SG + off);
            v2u w; w.x = pkbf(o.x * rs * gn.x * bflo(sg.x), o.y * rs * gn.y * bfhi(sg.x)); w.y = pkbf(o.z * rs * gn.z * bflo(sg.y), o.w * rs * gn.w * bfhi(sg.y));
            *(GAS v2u*)(Z + off) = w; }
    }
}

constexpr int S5_W8 = 0, S5_FB = 32768, S5_V8 = 32768, S5_T8 = 65536, S5_PAR = 98304;
constexpr int S5P_LAMP = 0, S5P_BB = 4608, S5P_CM = 4608 + 8192, S5P_L72 = 4608 + 16384, S5P_DSK = S5P_L72 + 512;
constexpr int S5_NSTEP = 9, S5_SLEN = 72;
__device__ __forceinline__ f32x2 cmul(f32x2 a, f32x2 b) { return (f32x2){a.x * b.x - a.y * b.y, a.x * b.y + a.y * b.x}; }
__device__ __forceinline__ int s5_row(int pos, int d) { if (pos < CTXL) return SEQ + (d ? CTXL - 1 - pos : pos); const int r = pos - CTXL; return d ? SEQ - 1 - r : r; }

__device__ __forceinline__ void phase_s5(Frame& F, const Args& args, int j) {
    relane(F);
    LAS unsigned char* L = F.lds + RING_OFF;
    LAS f32x2* LAMP = (LAS f32x2*)(L + S5_PAR + S5P_LAMP); LAS f32x2* BB = (LAS f32x2*)(L + S5_PAR + S5P_BB); LAS f32x2* CM = (LAS f32x2*)(L + S5_PAR + S5P_CM);
    LAS f32x2* L72 = (LAS f32x2*)(L + S5_PAR + S5P_L72); LAS float* DSK = (LAS float*)(L + S5_PAR + S5P_DSK);
    LAS f32x2* FB = (LAS f32x2*)(L + S5_FB);
    const int tid = F.tid, lane = F.lane, wave = F.wave, nl = lane & 15, q = lane >> 4;
    for (int it = F.vcu; it < 256; it += F.G) {
        const int g = it >> 1, d = it & 1, pi = (j * 2 + d) * 128 + g;
        const GAS bf16* H = (const GAS bf16*)(WSP(WS_H)) + g * 16;
        GAS bf16* Yo = (GAS bf16*)(opq(F.ws) + (d == 0 ? WS_OF : WS_OB)) + g * 16;
        if (tid < 64) {
            const int p = tid;
            const float dt = expf(AIN(14)[pi]); const float ar = AIN(12)[pi * 64 + p], ai = AIN(13)[pi * 64 + p];
            const float xr = ar * dt, yi = ai * dt;
            float tt = yi * 0.15915494309189535f; tt -= rintf(tt); const float ang = tt * 6.283185307179586f;
            const float cs = cosf(ang), sn = sinf(ang), ex = expf(xr), em1 = expm1f(xr), sh = sinf(0.5f * ang);
            const f32x2 lam1 = {ex * cs, ex * sn};
            const float nr = em1 * cs - 2.0f * sh * sh, ni = ex * sn;
            const float den = 1.0f / (ar * ar + ai * ai);
            const f32x2 kap = {(nr * ar + ni * ai) * den, (ni * ar - nr * ai) * den};
            f32x2 z = {1.0f, 0.0f};
#pragma unroll
            for (int k = 0; k < 9; ++k) { LAMP[k * 64 + p] = z; if (k < 8) z = cmul(z, lam1); }
            f32x2 z72 = z;
#pragma unroll
            for (int k = 0; k < 8; ++k) z72 = cmul(z72, z);
            L72[p] = z72;
#pragma unroll
            for (int h = 0; h < 16; ++h) { const f32x2 b = {AIN(15)[((size_t)pi * 64 + p) * 16 + h], AIN(16)[((size_t)pi * 64 + p) * 16 + h]}; BB[p * 16 + h] = cmul(kap, b); }
        }
        for (int i = tid; i < 1024; i += NTHR) { CM[i] = (f32x2){AIN(17)[(size_t)pi * 1024 + i], AIN(18)[(size_t)pi * 1024 + i]}; }
        if (tid < 16) DSK[tid] = (d == 0) ? AIN(19)[j * DM + g * 16 + tid] : 0.0f;
        __syncthreads();
#pragma unroll
        for (int i = 0; i < 4; ++i) {
            const int f = (tid >> 6) + 8 * i, mb = f >> 2, ks = f & 3, p = 16 * (mb >> 1) + nl, part = mb & 1, jj = 2 * ks + (q >> 1), h0 = 8 * (q & 1);
            const f32x2 lp = LAMP[(7 - jj) * 64 + p];
            float v[8];
#pragma unroll
            for (int e = 0; e < 8; ++e) { const f32x2 z = cmul(lp, BB[p * 16 + h0 + e]); v[e] = part ? z.y : z.x; }
            v4u o; o.x = pkbf(v[0], v[1]); o.y = pkbf(v[2], v[3]); o.z = pkbf(v[4], v[5]); o.w = pkbf(v[6], v[7]);
            *(LAS v4u*)(L + S5_W8 + (f * 64 + lane) * 16) = o;
        }
        __syncthreads();
        const int n = 16 * wave + nl, pos0 = S5_SLEN * n;
#define S5_LOADU(U, b) do { _Pragma("unroll") for (int ks = 0; ks < 4; ++ks) { int pos = pos0 + 8 * (b) + 2 * ks + (q >> 1); asm volatile("" : "+v"(pos)); const bool ok = pos < MTOT; \
            const int row = s5_row(ok ? pos : 0, d); v4u w = *(const GAS v4u*)(H + (size_t)row * DM + 8 * (q & 1)); if (!ok) w = (v4u){0u, 0u, 0u, 0u}; U[ks] = __builtin_bit_cast(bf16x8, w); } } while (0)
#define S5_AFRAG(base, f) (*(const LAS bf16x8*)(L + (base) + (f) * 1024 + lofs))
#define S5_MFMA(a, b, c) __builtin_amdgcn_mfma_f32_16x16x32_bf16((a), (b), (c), 0, 0, 0)
#define S5_UPDATE() do { _Pragma("unroll") for (int t = 0; t < 4; ++t) { const LAS f32x4* lp_ = (const LAS f32x4*)(L + S5_PAR + S5P_LAMP + (8 * 64 + 16 * t) * 8 + zofs + q * 32); const f32x4 la_ = lp_[0], lb_ = lp_[1]; \
            const float l8r_[4] = {la_[0], la_[2], lb_[0], lb_[2]}, l8i_[4] = {la_[1], la_[3], lb_[1], lb_[3]}; \
            _Pragma("unroll") for (int r = 0; r < 4; ++r) { \
            const float nr_ = l8r_[r] * Sre[t][r] - l8i_[r] * Sim[t][r] + acc[2 * t][r], ni_ = l8r_[r] * Sim[t][r] + l8i_[r] * Sre[t][r] + acc[2 * t + 1][r]; Sre[t][r] = nr_; Sim[t][r] = ni_; } } } while (0)
        f32x4 Sre[4], Sim[4];
#pragma unroll
        for (int t = 0; t < 4; ++t) { Sre[t] = (f32x4){0.f, 0.f, 0.f, 0.f}; Sim[t] = (f32x4){0.f, 0.f, 0.f, 0.f}; }
        {
            bf16x8 U[4]; S5_LOADU(U, 0);
            for (int b = 0; b < S5_NSTEP; ++b) {
                int lofs = lane * 16; asm volatile("" : "+v"(lofs)); int zofs = 0; asm volatile("" : "+v"(zofs));
                bf16x8 Un[4];
                if (b + 1 < S5_NSTEP) S5_LOADU(Un, b + 1); else { _Pragma("unroll") for (int ks = 0; ks < 4; ++ks) Un[ks] = U[ks]; }
                f32x4 acc[8];
#pragma unroll
                for (int mb = 0; mb < 8; ++mb) { acc[mb] = (f32x4){0.f, 0.f, 0.f, 0.f};
#pragma unroll
                    for (int ks = 0; ks < 4; ++ks) acc[mb] = S5_MFMA(S5_AFRAG(S5_W8, mb * 4 + ks), U[ks], acc[mb]);
                    if (mb & 1) asm volatile("" ::: "memory"); }
                S5_UPDATE();
#pragma unroll
                for (int ks = 0; ks < 4; ++ks) U[ks] = Un[ks];
            }
        }
#pragma unroll
        for (int t = 0; t < 4; ++t) { LAS f32x4* o = (LAS f32x4*)(FB + n * 64 + 16 * t + 4 * q);
            o[0] = (f32x4){Sre[t][0], Sim[t][0], Sre[t][1], Sim[t][1]}; o[1] = (f32x4){Sre[t][2], Sim[t][2], Sre[t][3], Sim[t][3]}; }
        __syncthreads();
        if (wave == 0) {
            const f32x2 l72 = L72[lane]; f32x2 I = {0.f, 0.f};
            for (int n0 = 0; n0 < 128; n0 += 8) {
                f32x2 fv[8];
#pragma unroll
                for (int k = 0; k < 8; ++k) fv[k] = FB[(n0 + k) * 64 + lane];
#pragma unroll
                for (int k = 0; k < 8; ++k) { FB[(n0 + k) * 64 + lane] = I; I = cmul(l72, I) + fv[k]; }
            }
        }
        __syncthreads();
#pragma unroll
        for (int t = 0; t < 4; ++t) { const LAS f32x4* o = (const LAS f32x4*)(FB + n * 64 + 16 * t + 4 * q); const f32x4 a = o[0], b = o[1];
            Sre[t] = (f32x4){a[0], a[2], b[0], b[2]}; Sim[t] = (f32x4){a[1], a[3], b[1], b[3]}; }
        __syncthreads();
#pragma unroll
        for (int i = 0; i < 4; ++i) {
            const int f = (tid >> 6) + 8 * i, im = f >> 2, ks = f & 3, h = nl;
            float v[8];
#pragma unroll
            for (int e = 0; e < 4; ++e) { const int p = 16 * ks + 4 * q + e; const f32x2 z = cmul(CM[h * 64 + p], LAMP[(im + 1) * 64 + p]); v[e] = z.x; v[4 + e] = -z.y; }
            v4u o; o.x = pkbf(v[0], v[1]); o.y = pkbf(v[2], v[3]); o.z = pkbf(v[4], v[5]); o.w = pkbf(v[6], v[7]);
            *(LAS v4u*)(L + S5_V8 + (f * 64 + lane) * 16) = o;
        }
        {
            const int dg = tid >> 6, h = nl, jl = q >> 1, h0 = 8 * (q & 1), lag = dg - jl;
            float v[8];
#pragma unroll
            for (int e = 0; e < 8; ++e) v[e] = 0.f;
            if (lag >= 0) {
                for (int p = 0; p < 64; ++p) { const f32x2 cl = cmul(CM[h * 64 + p], LAMP[lag * 64 + p]);
#pragma unroll
                    for (int e = 0; e < 8; ++e) { const f32x2 b = BB[p * 16 + h0 + e]; v[e] += cl.x * b.x - cl.y * b.y; } }
                if (lag == 0) {
#pragma unroll
                    for (int e = 0; e < 8; ++e) if (h0 + e == h) v[e] += DSK[h];
                }
            }
            v4u o; o.x = pkbf(v[0], v[1]); o.y = pkbf(v[2], v[3]); o.z = pkbf(v[4], v[5]); o.w = pkbf(v[6], v[7]);
            *(LAS v4u*)(L + S5_T8 + (dg * 64 + lane) * 16) = o;
        }
        __syncthreads();
        {
            bf16x8 U[4]; S5_LOADU(U, 0);
            for (int b = 0; b < S5_NSTEP; ++b) {
                int lofs = lane * 16; asm volatile("" : "+v"(lofs)); int zofs = 0; asm volatile("" : "+v"(zofs));
                bf16x8 Un[4];
                if (b + 1 < S5_NSTEP) S5_LOADU(Un, b + 1); else { _Pragma("unroll") for (int ks = 0; ks < 4; ++ks) Un[ks] = U[ks]; }
                bf16x8 BS[4];
#pragma unroll
                for (int ks = 0; ks < 4; ++ks) { v4u w; w.x = pkbf(Sre[ks][0], Sre[ks][1]); w.y = pkbf(Sre[ks][2], Sre[ks][3]); w.z = pkbf(Sim[ks][0], Sim[ks][1]); w.w = pkbf(Sim[ks][2], Sim[ks][3]); BS[ks] = __builtin_bit_cast(bf16x8, w); }
#pragma unroll
                for (int mb = 0; mb < 8; ++mb) {
                    f32x4 y = {0.f, 0.f, 0.f, 0.f};
#pragma unroll
                    for (int ks = 0; ks < 4; ++ks) if (2 * ks <= mb) y = S5_MFMA(S5_AFRAG(S5_T8, mb - 2 * ks), U[ks], y);
#pragma unroll
                    for (int ks = 0; ks < 4; ++ks) y = S5_MFMA(S5_AFRAG(S5_V8, mb * 4 + ks), BS[ks], y);
                    asm volatile("" ::: "memory");
                    int pos = pos0 + 8 * b + mb; asm volatile("" : "+v"(pos));
                    if (pos < MTOT) { v2u o; o.x = pkbf(y[0], y[1]); o.y = pkbf(y[2], y[3]); *(GAS v2u*)(Yo + (size_t)s5_row(pos, d) * DM + 4 * q) = o; }
                }
                f32x4 acc[8];
#pragma unroll
                for (int mb = 0; mb < 8; ++mb) { acc[mb] = (f32x4){0.f, 0.f, 0.f, 0.f};
#pragma unroll
                    for (int ks = 0; ks < 4; ++ks) acc[mb] = S5_MFMA(S5_AFRAG(S5_W8, mb * 4 + ks), U[ks], acc[mb]);
                    if (mb & 1) asm volatile("" ::: "memory"); }
                S5_UPDATE();
#pragma unroll
                for (int ks = 0; ks < 4; ++ks) U[ks] = Un[ks];
            }
        }
        __syncthreads();
#undef S5_LOADU
#undef S5_AFRAG
#undef S5_MFMA
#undef S5_UPDATE
    }
}
constexpr int HG_QP = 272;
constexpr int HG_KP = 64;
constexpr int HGR_QB = 0, HGR_KE = 8704, HGR_VT = HGR_KE + 128 * HG_KP, HGR_SC = HGR_VT + 128 * HG_KP, HGR_DEC = HGR_SC + 2048;
constexpr int HGL1_KB = 110592  , HGL1_TOT = 128000  ;
constexpr int HGL_RECB = 0  , HGL_OB = 110592  ;
constexpr int HG_OP = 272;
constexpr int HG_NCH = 33, HG_NCHT = 264;
__device__ __forceinline__ int hg_row(int p, int d) { if (p < CTXL) return SEQ + (d ? CTXL - 1 - p : p); int n = p - CTXL; if (d) n = SEQ - 1 - n; return (n & 127) * 64 + (n >> 7); }
#define HG_MFMA(a, b, c) __builtin_amdgcn_mfma_f32_16x16x32_bf16((a), (b), (c), 0, 0, 0)
#define HG_STATE_STEP(RB, vt) do { _Pragma("unroll") for (int mb = 0; mb < 8; ++mb) { \
        const bf16x8 a_ = *(const LAS bf16x8*)(L + (RB) + HGR_KE + (16 * mb + r16) * HG_KP + qd * 16 + zofs); \
        const f32x4 u_ = HG_MFMA(a_, vt, ((f32x4){0.f, 0.f, 0.f, 0.f})); \
        const f32x4 dc_ = *(const LAS f32x4*)(L + (RB) + HGR_DEC + (16 * mb + 4 * qd) * 4 + zofs); S[mb] = dc_ * S[mb] + u_; } } while (0)

constexpr int HGP_REC = HGR_DEC + 512;
constexpr int HGP_KB = 2 * HGP_REC, HGP_TOT = HGP_KB + 2 * 8704, HGP_OB = HGP_TOT + 4096, HGP_END = HGP_OB + 2 * 32 * HG_OP;
static_assert(HGP_END <= RING_BYTES, "HGRN pass LDS");
template <bool FULL>
__device__ __forceinline__ void hg_pass(Frame& F, const Args& args) {
    relane(F);
    LAS unsigned char* L = F.lds + RING_OFF;
    const int wave = F.wave;
    LAS float* TOTS = (LAS float*)(L + HGP_TOT);
#define HG_TIDS() int tid = F.tid; asm volatile("" : "+v"(tid)); const int lane = tid & 63, r16 = lane & 15, qd = lane >> 4, kk = tid & 127, sq = tid >> 7, kl = kk & 31, pcol = (kk & ~31) + 8 * ((kl >> 2) & 3) + 4 * (kl >> 4) + (kl & 3); (void)r16; (void)qd; (void)pcol; (void)lane
    for (int it = F.vcu; it < 256; it += F.G) {
        const int hd = it >> 4, d = (it >> 3) & 1, sg = it & 7, hdd = hd * 2 + d;
        const GAS bf16* LG = (const GAS bf16*)(opq(F.ws) + (d ? WS_LB : WS_LF)) + hd * 128;
        const GAS bf16* Qp = (const GAS bf16*)(WSP(WS_Q)) + hd * 128; const GAS bf16* Vp = (const GAS bf16*)(WSP(WS_V)) + hd * 128;
        GAS bf16* O = (GAS bf16*)(opq(F.ws) + (d ? WS_OB : WS_OF)) + hd * 128;
        f32x4 S[8];
#pragma unroll
        for (int mb = 0; mb < 8; ++mb) S[mb] = (f32x4){0.f, 0.f, 0.f, 0.f};
        if (FULL) { HG_TIDS();
            f32x4 P[8], fv[8], dv[8];
#pragma unroll
            for (int mb = 0; mb < 8; ++mb) P[mb] = (f32x4){1.f, 1.f, 1.f, 1.f};
#define HG_SLOAD(s2_) do { const int sc_ = (s2_) >= 0 ? (s2_) : 0; const GAS f32x4* sp_ = (const GAS f32x4*)(opq(F.ws) + WS_SEGS) + ((size_t)((hdd * 8 + sc_) * 8 + wave) * 8) * 64 + lane; \
                const GAS float* dp_ = (const GAS float*)(opq(F.ws) + WS_SEGD) + (hdd * 8 + sc_) * 128 + 4 * qd; \
                _Pragma("unroll") for (int mb = 0; mb < 8; ++mb) { fv[mb] = sp_[mb * 64]; dv[mb] = *(const GAS f32x4*)(dp_ + 16 * mb); } } while (0)
            HG_SLOAD(sg - 1);
            for (int s2 = sg - 1; s2 >= 0; --s2) {
                f32x4 fc[8], dc[8];
#pragma unroll
                for (int mb = 0; mb < 8; ++mb) { fc[mb] = fv[mb]; dc[mb] = dv[mb]; }
                HG_SLOAD(s2 - 1);
#pragma unroll
                for (int mb = 0; mb < 8; ++mb) { S[mb] += P[mb] * fc[mb]; P[mb] *= dc[mb]; }
            }
#undef HG_SLOAD
        }
        float dsum = 0.f;
        float lf[2][8]; unsigned qv[2][8];
#define HG_INLOAD(cp) do { _Pragma("unroll") for (int h = 0; h < 2; ++h) { int c_ = 2 * (cp) + h; c_ = c_ < HG_NCH ? c_ : HG_NCH - 1; int p0_ = (sg * HG_NCH + c_) * 32 + 8 * sq; asm volatile("" : "+v"(p0_)); \
              \
            const int row0_ = hg_row(p0_, d), step_ = (p0_ < CTXL ? 1 : 64) * (d ? -1 : 1); unsigned off_ = (unsigned)row0_ * DM + kk; const int dstep_ = step_ * DM; \
            _Pragma("unroll") for (int i = 0; i < 8; ++i) { lf[h][i] = bf1(LG[off_]); qv[h][i] = (FULL ? (unsigned)Qp[off_] : 0u) | ((unsigned)Vp[off_] << 16); off_ += dstep_; } } } while (0)
#define HG_OSTORE(c, h) do { int p_ = (sg * HG_NCH + (c)) * 32 + (tid >> 4); asm volatile("" : "+v"(p_)); const v4u o_ = *(const LAS v4u*)(L + HGP_OB + (h) * (32 * HG_OP) + (tid >> 4) * HG_OP + (tid & 15) * 16); \
            *(GAS v4u*)(O + (size_t)hg_row(p_, d) * DM + 8 * (tid & 15)) = o_; } while (0)
        { HG_TIDS(); HG_INLOAD(0); }
        for (int cp = 0; cp < (HG_NCH + 1) / 2; ++cp) {
            HG_TIDS();
            int zofs = 0; asm volatile("" : "+v"(zofs));
            float cs[2][8];
#pragma unroll
            for (int h = 0; h < 2; ++h) { float run = 0.f;
#pragma unroll
                for (int i = 0; i < 8; ++i) { run += lf[h][i]; cs[h][i] = run; }
                TOTS[(h * 4 + sq) * 128 + kk] = run; }
            __syncthreads();
            if (FULL && cp > 0) { HG_OSTORE(2 * cp - 2, 0); HG_OSTORE(2 * cp - 1, 1); }
#pragma unroll
            for (int h = 0; h < 2; ++h) {
                const int RB = h * HGP_REC, KB = HGP_KB + h * (32 * HG_QP);
                const float t0 = TOTS[(h * 4 + 0) * 128 + kk], t1 = TOTS[(h * 4 + 1) * 128 + kk], t2 = TOTS[(h * 4 + 2) * 128 + kk], t3 = TOTS[(h * 4 + 3) * 128 + kk];
                const float offc = (sq > 0 ? t0 : 0.f) + (sq > 1 ? t1 : 0.f) + (sq > 2 ? t2 : 0.f), tot = (t0 + t1) + (t2 + t3), dec = __expf(tot);
                float ke[8];
#pragma unroll
                for (int i = 0; i < 8; ++i) { const float cum = cs[h][i] + offc, kv = 1.0f - __expf(i ? cs[h][i] - cs[h][i - 1] : cs[h][0]);
                    const float kb = kv * __expf(-cum); ke[i] = kb * dec;
                    if (FULL) { const float qb = bflo(qv[h][i]) * __expf(cum);
                        *(LAS bf16*)(L + RB + HGR_QB + (8 * sq + i) * HG_QP + pcol * 2) = (bf16)(pkbf(qb, 0.f) & 0xffffu);
                        *(LAS bf16*)(L + KB + (8 * sq + i) * HG_QP + pcol * 2) = (bf16)(pkbf(kb, 0.f) & 0xffffu); } }
                { v4u o; o.x = pkbf(ke[0], ke[1]); o.y = pkbf(ke[2], ke[3]); o.z = pkbf(ke[4], ke[5]); o.w = pkbf(ke[6], ke[7]);
                  *(LAS v4u*)(L + RB + HGR_KE + kk * HG_KP + sq * 16) = o;
                  v4u w; w.x = (qv[h][0] >> 16) | (qv[h][1] & 0xffff0000u); w.y = (qv[h][2] >> 16) | (qv[h][3] & 0xffff0000u); w.z = (qv[h][4] >> 16) | (qv[h][5] & 0xffff0000u); w.w = (qv[h][6] >> 16) | (qv[h][7] & 0xffff0000u);
                  *(LAS v4u*)(L + RB + HGR_VT + kk * HG_KP + sq * 16) = w; }
                if (sq == 0) { *(LAS float*)(L + RB + HGR_DEC + kk * 4) = dec; if (!FULL && 2 * cp + h < HG_NCH) dsum += tot; }
            }
            HG_INLOAD(cp + 1);
            __syncthreads();
            if (FULL) {
                const int h = wave >> 2, w4 = wave & 3, mblk = w4 >> 1, nblk = w4 & 1; const int RB = h * HGP_REC, KB = HGP_KB + h * (32 * HG_QP);
                f32x4 acc = {0.f, 0.f, 0.f, 0.f};
#pragma unroll
                for (int ks = 0; ks < 4; ++ks) { const bf16x8 a = *(const LAS bf16x8*)(L + RB + HGR_QB + (16 * mblk + r16) * HG_QP + (32 * ks + 8 * qd) * 2 + zofs);
                    const bf16x8 b = *(const LAS bf16x8*)(L + KB + (16 * nblk + r16) * HG_QP + (32 * ks + 8 * qd) * 2 + zofs); acc = HG_MFMA(a, b, acc); }
#pragma unroll
                for (int r = 0; r < 4; ++r) { const int cc = 16 * mblk + 4 * qd + r, ss = 16 * nblk + r16; const float v = ss <= cc ? acc[r] : 0.f;
                    *(LAS bf16*)(L + RB + HGR_SC + (cc * 32 + ss) * 2) = (bf16)(pkbf(v, 0.f) & 0xffffu); }
                __syncthreads();
            }
#pragma unroll
            for (int h = 0; h < 2; ++h) if (2 * cp + h < HG_NCH) { const int RB = h * HGP_REC;
                const bf16x8 vt = *(const LAS bf16x8*)(L + RB + HGR_VT + (16 * wave + r16) * HG_KP + qd * 16 + zofs);
                if (FULL) {
                    bf16x8 BS[4];
#pragma unroll
                    for (int ks = 0; ks < 4; ++ks) { v4u w; w.x = pkbf(S[2 * ks][0], S[2 * ks][1]); w.y = pkbf(S[2 * ks][2], S[2 * ks][3]); w.z = pkbf(S[2 * ks + 1][0], S[2 * ks + 1][1]); w.w = pkbf(S[2 * ks + 1][2], S[2 * ks + 1][3]);
                        BS[ks] = __builtin_bit_cast(bf16x8, w); }
#pragma unroll
                    for (int mblk = 0; mblk < 2; ++mblk) {
                        f32x4 o = {0.f, 0.f, 0.f, 0.f};
                        { const bf16x8 a = *(const LAS bf16x8*)(L + RB + HGR_SC + (16 * mblk + r16) * 64 + qd * 16 + zofs); o = HG_MFMA(a, vt, o); }
#pragma unroll
                        for (int ks = 0; ks < 4; ++ks) { const bf16x8 a = *(const LAS bf16x8*)(L + RB + HGR_QB + (16 * mblk + r16) * HG_QP + (32 * ks + 8 * qd) * 2 + zofs); o = HG_MFMA(a, BS[ks], o); }
#pragma unroll
                        for (int r = 0; r < 4; ++r) *(LAS bf16*)(L + HGP_OB + h * (32 * HG_OP) + (16 * mblk + 4 * qd + r) * HG_OP + (16 * wave + r16) * 2) = (bf16)(pkbf(o[r], 0.f) & 0xffffu);
                    }
                }
                HG_STATE_STEP(RB, vt); }
        }
        __syncthreads();
        if (FULL) { HG_TIDS(); HG_OSTORE(HG_NCH - 1, 0); }
        else { HG_TIDS(); GAS f32x4* sp = (GAS f32x4*)(opq(F.ws) + WS_SEGS) + ((size_t)((hdd * 8 + sg) * 8 + wave) * 8) * 64 + lane;
#pragma unroll
          for (int mb = 0; mb < 8; ++mb) sp[mb * 64] = S[mb];
          if (sq == 0) ((GAS float*)(opq(F.ws) + WS_SEGD))[(hdd * 8 + sg) * 128 + kk] = __expf(dsum); }
        __syncthreads();
#undef HG_INLOAD
#undef HG_OSTORE
    }
#undef HG_TIDS
}
__device__ __forceinline__ void phase_hg_r1(Frame& F, const Args& args) { hg_pass<false>(F, args); }
__device__ __forceinline__ void phase_hg_r2(Frame& F, const Args& args) { hg_pass<true>(F, args); }
template <int MT, int NB, int KS, int WR, class Epi>
__device__ __forceinline__ void ctx_gemm(Frame& F, const GAS bf16* A, const GAS bf16* Bt, int K, int ncolt, const Epi& E) {
    constexpr int WC = 8 / WR, MB = MT / (16 * WR), NBW = NB / WC, RT = 256 / MT, PITCH = 144, APIECES = MT * 8, BPIECES = NB * 16 * 8, NA = (APIECES + NTHR - 1) / NTHR, NBL = (BPIECES + NTHR - 1) / NTHR;
    constexpr int ABYTES = MT * PITCH, BBYTES = NB * 16 * PITCH, BUF = ABYTES + BBYTES;
    static_assert(3 * BUF <= RING_BYTES && NB % WC == 0 && MT % (16 * WR) == 0, "ctx_gemm geometry");
    relane(F);
    LAS unsigned char* L = F.lds + RING_OFF;
    const int tid = F.tid, lane = F.lane, wave = F.wave, r16 = lane & 15, qd = lane >> 4, wr = wave / WC, wc = wave % WC;
    const int units = RT * ncolt * KS, klen = K / KS, nkt = klen / 64;
    for (int u = F.vcu; u < units; u += F.G) {
        const int ks = u % KS, t = u / KS, rt = t % RT, ct = t / RT;
        const int rowb = rt * MT;
        const GAS bf16* ga[NA]; const GAS bf16* gb[NBL]; int la[NA], lb[NBL]; bool oka[NA], okb[NBL];
#pragma unroll
        for (int j = 0; j < NA; ++j) { const int i = tid + NTHR * j, row = i >> 3, ch = i & 7; oka[j] = i < APIECES; const int rr = oka[j] ? row : 0; ga[j] = A + (size_t)(rowb + rr) * K + ks * klen + 8 * ch; la[j] = rr * PITCH + ch * 16; }
#pragma unroll
        for (int j = 0; j < NBL; ++j) { const int i = tid + NTHR * j, row = i >> 3, ch = i & 7; okb[j] = i < BPIECES; const int rr = okb[j] ? row : 0;
            gb[j] = Bt + (size_t)E.brow(ct, rr >> 4, rr & 15) * K + ks * klen + 8 * ch; lb[j] = ABYTES + rr * PITCH + ch * 16; }
        v4u ra[2][NA], rb[2][NBL];
#define CG_LOAD(P, kt) do { _Pragma("unroll") for (int j = 0; j < NA; ++j) ra[P][j] = *(const GAS v4u*)(ga[j] + (kt) * 64); _Pragma("unroll") for (int j = 0; j < NBL; ++j) rb[P][j] = *(const GAS v4u*)(gb[j] + (kt) * 64); } while (0)
#define CG_STORE(P, bo) do { _Pragma("unroll") for (int j = 0; j < NA; ++j) if (oka[j]) *(LAS v4u*)(L + (bo) + la[j]) = ra[P][j]; _Pragma("unroll") for (int j = 0; j < NBL; ++j) if (okb[j]) *(LAS v4u*)(L + (bo) + lb[j]) = rb[P][j]; } while (0)
#define CG_COMPUTE(bo) do { _Pragma("unroll") for (int k2 = 0; k2 < 2; ++k2) { bf16x8 a[MB], b[NBW]; \
            _Pragma("unroll") for (int mb = 0; mb < MB; ++mb) a[mb] = *(const LAS bf16x8*)(L + (bo) + (wr * (MT / WR) + 16 * mb + r16) * PITCH + (4 * k2 + qd) * 16); \
            _Pragma("unroll") for (int nb = 0; nb < NBW; ++nb) b[nb] = *(const LAS bf16x8*)(L + (bo) + ABYTES + (16 * (wc + WC * nb) + r16) * PITCH + (4 * k2 + qd) * 16); \
            _Pragma("unroll") for (int mb = 0; mb < MB; ++mb) _Pragma("unroll") for (int nb = 0; nb < NBW; ++nb) acc[mb][nb] = __builtin_amdgcn_mfma_f32_16x16x32_bf16(a[mb], b[nb], acc[mb][nb], 0, 0, 0); } } while (0)
        f32x4 acc[MB][NBW];
#pragma unroll
        for (int mb = 0; mb < MB; ++mb)
#pragma unroll
            for (int nb = 0; nb < NBW; ++nb) acc[mb][nb] = (f32x4){0.f, 0.f, 0.f, 0.f};
        CG_LOAD(0, 0); CG_LOAD(1, 1); CG_STORE(0, 0);
        __syncthreads();
        for (int kt = 0; kt < nkt; kt += 2) {
            { const int b0 = (kt % 3) * BUF, b1 = ((kt + 1) % 3) * BUF;
              if (kt + 2 < nkt) CG_LOAD(0, kt + 2);
              CG_COMPUTE(b0);
              CG_STORE(1, b1);
              __syncthreads(); }
            { const int b1 = ((kt + 1) % 3) * BUF, b2 = ((kt + 2) % 3) * BUF;
              if (kt + 3 < nkt) CG_LOAD(1, kt + 3);
              CG_COMPUTE(b1);
              if (kt + 2 < nkt) CG_STORE(0, b2);
              __syncthreads(); }
        }
#undef CG_LOAD
#undef CG_STORE
#undef CG_COMPUTE
        const int row0 = rowb + wr * (MT / WR);
#pragma unroll
        for (int mb = 0; mb < MB; ++mb) E.store(acc[mb], row0 + 16 * mb + 4 * qd, ct, ks, r16, wc);
    }
}
struct CtxRelu2 {
    GAS bf16* O;
    __device__ __forceinline__ int brow(int ct, int nb, int r) const { return 64 * ct + 16 * nb + r; }
    __device__ __forceinline__ void store(const f32x4 (&acc)[2], int row, int ct, int ks, int r, int wc) const {
#pragma unroll
        for (int t = 0; t < 2; ++t)
#pragma unroll
            for (int g = 0; g < 4; ++g) { const float v = fmaxf(acc[t][g], 0.f); O[(size_t)(SEQ + row + g) * HID + 64 * ct + 16 * (wc + 2 * t) + r] = (bf16)(pkbf(v * v, 0.f) & 0xffffu); }
    }
};
struct CtxGlu {
    GAS float* Y;
    __device__ __forceinline__ int brow(int ct, int nb, int r) const { const int c = 32 * ct + 16 * (nb & 1) + r; return 256 * (c >> 7) + (c & 127) + 128 * (nb >> 1); }
    __device__ __forceinline__ void store(const f32x4 (&acc)[2], int row, int ct, int ks, int r, int wc) const {
#pragma unroll
        for (int g = 0; g < 4; ++g) Y[(size_t)(row + g) * DM + 32 * ct + 16 * wc + r] = acc[0][g] * pg8::sigmoid_f(acc[1][g]);
    }
};
struct CtxPart {
    GAS float* YP;
    __device__ __forceinline__ int brow(int ct, int nb, int r) const { return 64 * ct + 16 * nb + r; }
    __device__ __forceinline__ void store(const f32x4 (&acc)[2], int row, int ct, int ks, int r, int wc) const {
#pragma unroll
        for (int t = 0; t < 2; ++t)
#pragma unroll
            for (int g = 0; g < 4; ++g) YP[((size_t)ks * CTXL + row + g) * DM + 64 * ct + 16 * (wc + 2 * t) + r] = acc[t][g];
    }
};
struct CtxHgIn {
    GAS bf16* Q; size_t hstride; GAS bf16* LF; size_t fstride; const GAS float* lbv;
    __device__ __forceinline__ int brow(int ct, int nb, int r) const { return 80 * ct + 16 * nb + r; }
    __device__ __forceinline__ void store(const f32x4 (&acc)[5], int row, int ct, int ks, int r, int  ) const {
#pragma unroll
        for (int nb = 0; nb < 5; ++nb) { const int col = 80 * ct + 16 * nb + r, typ = col >> 11, cc = col & 2047;
            if (typ == 2 || typ == 3) { const float lb = lbv[(typ - 2) * 2048 + cc], llb = lb > 0.f ? logf(lb) : 0.f; GAS bf16* O = LF + (size_t)(typ - 2) * fstride;
#pragma unroll
                for (int g = 0; g < 4; ++g) O[(size_t)(SEQ + row + g) * DM + cc] = (bf16)(pkbf(pg8::logf_gate(acc[nb][g], lb, llb), 0.f) & 0xffffu);
            } else { GAS bf16* O = Q + (size_t)((typ >> 2) * 2 + (typ & 1)) * hstride;
#pragma unroll
                for (int g = 0; g < 4; ++g) { const float v = acc[nb][g], w = typ == 1 ? v : pg8::silu_f(v); O[(size_t)(SEQ + row + g) * DM + cc] = (bf16)(pkbf(w, 0.f) & 0xffffu); } }
        }
    }
};

#if MK_PER_PHASE
#define IN(k) (args.ph_lo <= (k) && (k) < args.ph_hi)
#else
#define IN(k) true
#endif
#define SEAM(k) do { if (IN(k) && IN((k) + 1)) { if (!MK_PER_PHASE) xcd_barrier(bar); } } while (0)
#define MOD ((const GAS float*)(WSP(WS_MOD)))
#define Hb ((const GAS bf16*)(WSP(WS_H)))
#define Zb ((const GAS bf16*)(WSP(WS_Z)))
#define HIDb ((const GAS bf16*)(WSP(WS_HID)))
#define Y1 ((GAS bf16*)(WSP(WS_Y1)))
#define Y2 ((GAS bf16*)(WSP(WS_Y2)))
#define YP1 ((GAS float*)(WSP(WS_YP1)))
#define YP2 ((GAS float*)(WSP(WS_YP2)))
#define CTXLIVE (pair == 0)

template <int pair>
__device__ __forceinline__ void layer_pair(Frame& F, const Args& args, const XcdBarrier& bar) {
        const int base = 2 + 16 * pair, l0 = 2 * pair, l1 = l0 + 1, j = pair;
        relane(F); F.ws = opq(F.ws);
#define mod0 (MOD + (size_t)l0 * 2 * NMOD)
#define mod1 (MOD + (size_t)l1 * 2 * NMOD)
#define modp (MOD + (size_t)(l0 - 1) * 2 * NMOD)
        if (IN(base + 0)) {
            if (pair == 0) thin_rn<0, 1>(F, args, nullptr, nullptr, MTOT, nullptr, nullptr, 0, AIN(6) + l0 * DM, mod0, 0, 1);
            else { if (REP_RN) { thin_rn<1, 4, true>(F, args, Y2, YP2, MTOT, AIN(9) + (l0 - 1) * DM, modp, 5, AIN(6) + l0 * DM, mod0, 0, 1); } thin_rn<1, 4>(F, args, Y2, YP2, MTOT, AIN(9) + (l0 - 1) * DM, modp, 5, AIN(6) + l0 * DM, mod0, 0, 1); }
        } SEAM(base + 0);
        if (IN(base + 1)) {
            for (int rep = 0; rep <= REP_S5; ++rep) phase_s5(F, args, j);
        } SEAM(base + 1);
        if (IN(base + 2)) { for (int rep = 0; rep <= REP_THIN; ++rep) phase_a2(F, args); } SEAM(base + 2);
        if (IN(base + 3)) {
            pg8::Gemm g{(gen_cbf)(Zb), (gen_cbf)((const GAS bf16*)(WSP(WS_WGLU)) + (size_t)j * 4096 * DM), SEQ, 4096, DM}; pg8::StaticOrder S; S.init(SEQ, 4096, F.G, PG_CID, WGM_GLU);
            pg8::EpiGlu E{Y1, DM};
            for (int rep = 0; rep <= REP_GEMM + REP_GGLU; ++rep)
            pg8::gemm_phase<pg8::EpiGlu, pg8::StaticOrder, PG_ALIGN, PG_SP2>(F.lds + RING_OFF, g, S, E);
            { CtxGlu CE{YP1}; for (int rep = 0; rep <= REP_CTX; ++rep) ctx_gemm<64, 4, 1, 4>(F, Zb + (size_t)SEQ * DM, (const GAS bf16*)(WSP(WS_WGLU)) + (size_t)j * 4096 * DM, DM, 64, CE); }
        } SEAM(base + 3);
        if (IN(base + 4)) { if (REP_RN) { thin_rn<1, 1, true>(F, args, Y1, YP1, MTOT, AIN(7) + l0 * DM, mod0, 2, AIN(8) + l0 * DM, mod0, 3, 4); } thin_rn<1, 1>(F, args, Y1, YP1, MTOT, AIN(7) + l0 * DM, mod0, 2, AIN(8) + l0 * DM, mod0, 3, 4); } SEAM(base + 4);
        if (IN(base + 5)) {
            pg8::Gemm g{(gen_cbf)(Hb), (gen_cbf)((const GAS bf16*)(WSP(WS_W1)) + (size_t)l0 * HID * DM), SEQ, HID, DM}; pg8::StaticOrder S; S.init(SEQ, HID, F.G, PG_CID, WGM_IN);
            pg8::EpiRelu2 E{(GAS bf16*)(WSP(WS_HID)), HID};
            for (int rep = 0; rep <= REP_GEMM + REP_GIN; ++rep)
            pg8::gemm_phase<pg8::EpiRelu2, pg8::StaticOrder, PG_ALIGN, PG_SP2>(F.lds + RING_OFF, g, S, E);
            { CtxRelu2 CE{(GAS bf16*)(WSP(WS_HID))}; for (int rep = 0; rep <= REP_CTX; ++rep) ctx_gemm<128, 4, 1, 4>(F, Hb + (size_t)SEQ * DM, (const GAS bf16*)(WSP(WS_W1)) + (size_t)l0 * HID * DM, DM, 128, CE); }
        } SEAM(base + 5);
        if (IN(base + 6)) {
            pg8::Gemm g{(gen_cbf)(HIDb), (gen_cbf)((const GAS bf16*)(WSP(WS_W2)) + (size_t)l0 * DM * HID), SEQ, DM, HID}; pg8::StaticOrder S; S.init(SEQ, DM, F.G, PG_CID, WGM_OUT);
            pg8::EpiBf16P E{Y2, DM};
            for (int rep = 0; rep <= REP_GEMM + REP_GOUT; ++rep)
            pg8::gemm_phase<pg8::EpiBf16P, pg8::StaticOrder, PG_ALIGN, PG_SP2>(F.lds + RING_OFF, g, S, E);
            { CtxPart CE{YP2}; for (int rep = 0; rep <= REP_CTX; ++rep) ctx_gemm<128, 4, 4, 4>(F, HIDb + (size_t)SEQ * HID, (const GAS bf16*)(WSP(WS_W2)) + (size_t)l0 * DM * HID, HID, 32, CE); }
        } SEAM(base + 6);
        if (IN(base + 7)) { if (REP_RN) { thin_rn<1, 4, true>(F, args, Y2, YP2, MTOT, AIN(9) + l0 * DM, mod0, 5, AIN(6) + l1 * DM, mod1, 0, 1); } thin_rn<1, 4>(F, args, Y2, YP2, MTOT, AIN(9) + l0 * DM, mod0, 5, AIN(6) + l1 * DM, mod1, 0, 1); } SEAM(base + 7);
        if (IN(base + 8)) {
            pg8::Gemm g{(gen_cbf)(Hb), (gen_cbf)((const GAS bf16*)(WSP(WS_WIN)) + (size_t)j * 10240 * DM), SEQ, 10240, DM}; pg8::StaticOrder S; S.init(SEQ, 10240, F.G, PG_CID, WGM_HG);
            pg8::EpiHgIn E{(GAS bf16*)(WSP(WS_Q)), (WS_V - WS_Q) / 2, (GAS bf16*)(WSP(WS_LF)), (WS_LB - WS_LF) / 2, (const GAS float*)(WSP(WS_LBV)) + (size_t)j * 2 * DM};
            static_assert(WS_SG - WS_V == WS_V - WS_Q, "Q|V|SG equally spaced");
            for (int rep = 0; rep <= REP_GEMM + REP_GHG; ++rep)
            pg8::gemm_phase<pg8::EpiHgIn, pg8::StaticOrder, PG_ALIGN, PG_SP2>(F.lds + RING_OFF, g, S, E);
#if defined(REP_GHG_CHEAP)
            { pg8::EpiBf16P E2{(GAS bf16*)(WSP(WS_REC)), 10240}; pg8::gemm_phase<pg8::EpiBf16P, pg8::StaticOrder, PG_ALIGN, PG_SP2>(F.lds + RING_OFF, g, S, E2); }
#endif
            { CtxHgIn CE{(GAS bf16*)(WSP(WS_Q)), (WS_V - WS_Q) / 2, (GAS bf16*)(WSP(WS_LF)), (WS_LB - WS_LF) / 2, (const GAS float*)(WSP(WS_LBV)) + (size_t)j * 2 * DM}; for (int rep = 0; rep <= REP_CTX; ++rep) ctx_gemm<128, 5, 1, 8>(F, Hb + (size_t)SEQ * DM, (const GAS bf16*)(WSP(WS_WIN)) + (size_t)j * 10240 * DM, DM, 128, CE); }
        } SEAM(base + 8);
        for (int rep = 0; rep <= REP_HG; ++rep) {
        for (int rep1 = 0; rep1 <= REP_R1; ++rep1) { if (IN(base + 9)) { phase_hg_r1(F, args); } SEAM(base + 9); }
        for (int rep2 = 0; rep2 <= REP_R2; ++rep2) { if (IN(base + 10)) { phase_hg_r2(F, args); } SEAM(base + 10); }
        }
        if (IN(base + 11)) { for (int rep = 0; rep <= REP_THIN; ++rep) phase_a4(F, args, AIN(23) + j * DM); } SEAM(base + 11);
        if (IN(base + 12)) {
            pg8::Gemm g{(gen_cbf)(Zb), (gen_cbf)((const GAS bf16*)(WSP(WS_WOUT)) + (size_t)j * DM * DM), SEQ, DM, DM}; pg8::StaticOrder S; S.init(SEQ, DM, F.G, PG_CID, WGM_OP);
            pg8::EpiBf16P E{Y1, DM};
            for (int rep = 0; rep <= REP_GEMM + REP_GOUT; ++rep)
            pg8::gemm_phase<pg8::EpiBf16P, pg8::StaticOrder, PG_ALIGN, PG_SP2>(F.lds + RING_OFF, g, S, E);
            if (CTXLIVE) { CtxPart CE{YP1}; for (int rep = 0; rep <= REP_CTX; ++rep) ctx_gemm<128, 4, 4, 4>(F, Zb + (size_t)SEQ * DM, (const GAS bf16*)(WSP(WS_WOUT)) + (size_t)j * DM * DM, DM, 32, CE); }
        } SEAM(base + 12);
        if (IN(base + 13)) { if (REP_RN) { thin_rn<1, 4, true>(F, args, Y1, YP1, (pair == 1 ? SEQ : MTOT), AIN(7) + l1 * DM, mod1, 2, AIN(8) + l1 * DM, mod1, 3, 4); } thin_rn<1, 4>(F, args, Y1, YP1, (pair == 1 ? SEQ : MTOT), AIN(7) + l1 * DM, mod1, 2, AIN(8) + l1 * DM, mod1, 3, 4); } SEAM(base + 13);
        if (IN(base + 14)) {
            pg8::Gemm g{(gen_cbf)(Hb), (gen_cbf)((const GAS bf16*)(WSP(WS_W1)) + (size_t)l1 * HID * DM), SEQ, HID, DM}; pg8::StaticOrder S; S.init(SEQ, HID, F.G, PG_CID, WGM_IN);
            pg8::EpiRelu2 E{(GAS bf16*)(WSP(WS_HID)), HID};
            for (int rep = 0; rep <= REP_GEMM + REP_GIN; ++rep)
            pg8::gemm_phase<pg8::EpiRelu2, pg8::StaticOrder, PG_ALIGN, PG_SP2>(F.lds + RING_OFF, g, S, E);
            if (CTXLIVE) { CtxRelu2 CE{(GAS bf16*)(WSP(WS_HID))}; for (int rep = 0; rep <= REP_CTX; ++rep) ctx_gemm<128, 4, 1, 4>(F, Hb + (size_t)SEQ * DM, (const GAS bf16*)(WSP(WS_W1)) + (size_t)l1 * HID * DM, DM, 128, CE); }
        } SEAM(base + 14);
        if (IN(base + 15)) {
            pg8::Gemm g{(gen_cbf)(HIDb), (gen_cbf)((const GAS bf16*)(WSP(WS_W2)) + (size_t)l1 * DM * HID), SEQ, DM, HID}; pg8::StaticOrder S; S.init(SEQ, DM, F.G, PG_CID, WGM_OUT);
            pg8::EpiBf16P E{Y2, DM};
            for (int rep = 0; rep <= REP_GEMM + REP_GOUT; ++rep)
            pg8::gemm_phase<pg8::EpiBf16P, pg8::StaticOrder, PG_ALIGN, PG_SP2>(F.lds + RING_OFF, g, S, E);
            if (CTXLIVE) { CtxPart CE{YP2}; for (int rep = 0; rep <= REP_CTX; ++rep) ctx_gemm<128, 4, 4, 4>(F, HIDb + (size_t)SEQ * HID, (const GAS bf16*)(WSP(WS_W2)) + (size_t)l1 * DM * HID, HID, 32, CE); }
        } SEAM(base + 15);
    }
__global__ void __launch_bounds__(NTHR, 2) mk_fwd(Args args) {
    extern __shared__ __attribute__((aligned(16))) unsigned char lds[];
    Frame F;
    F.lds = (LAS unsigned char*)lds;
    F.MISC = (volatile LAS unsigned*)(F.lds + MISC_OFF);
    F.tid = threadIdx.x; F.lane = F.tid & 63; F.wave = __builtin_amdgcn_readfirstlane(F.tid >> 6);
    F.G = gridDim.x; { const int bx = blockIdx.x; F.vcu = (F.G % 8 == 0) ? (bx % 8) * (F.G / 8) + bx / 8 : bx; }
    F.ws = (GAS unsigned char*)args.ws; F.out = (GAS float*)args.out;
    for (int u = F.tid; u < (LDS_BYTES - LDSCTL_OFF) / 4; u += NTHR) ((LAS unsigned*)(F.lds + LDSCTL_OFF))[u] = 0u;
    __syncthreads();
    gen_u32p barw = (gen_u32p)((GAS unsigned*)(WSP(WS_CTL)) + CW_BAR);
    XcdBarrier bar; bar.bar = barw; bar.x = 0; bar.st = nullptr;
    if (!MK_PER_PHASE) bar = xcd_barrier_post(barw, F.MISC + 8);
    if (IN(0)) { for (int rep = 0; rep <= REP_P0; ++rep) phase_p0(F, args); } SEAM(0);
    for (int rep = 0; rep < REP_BAR; ++rep) xcd_barrier(bar);
    if (IN(1)) { phase_p1(F, args); } SEAM(1);

    layer_pair<0>(F, args, bar);
    layer_pair<1>(F, args, bar);
    if (IN(34)) { thin_rn<2, 1>(F, args, Y2, nullptr, SEQ, AIN(9) + 3 * DM, MOD + (size_t)3 * 2 * NMOD, 5, nullptr, nullptr, 0, 0); }
#undef IN
#undef SEAM
}

extern "C" void kernel_launch(void* const* d_in, const int* in_sizes, int n_in, void* d_out, int out_size, void* d_ws, size_t ws_size, hipStream_t stream) {
    static int grid = 0;
    if (grid == 0) {
        if (n_in != 25 || out_size != SEQ * DM || ws_size < WS_END) { fprintf(stderr, "kernel_launch: unexpected shapes (n_in %d out %d ws %zu need %zu)\n", n_in, out_size, ws_size, (size_t)WS_END); grid = -1; return; }
        int dev = 0, cus = 0, per_cu = 0;
        if (hipGetDevice(&dev) != hipSuccess || hipDeviceGetAttribute(&cus, hipDeviceAttributeMultiprocessorCount, dev) != hipSuccess) { grid = -1; return; }
        if (hipFuncSetAttribute((const void*)mk_fwd, hipFuncAttributeMaxDynamicSharedMemorySize, LDS_BYTES) != hipSuccess) { fprintf(stderr, "kernel_launch: hipFuncSetAttribute failed\n"); grid = -1; return; }
        if (hipOccupancyMaxActiveBlocksPerMultiprocessor(&per_cu, (const void*)mk_fwd, NTHR, LDS_BYTES) != hipSuccess || per_cu < 1) { fprintf(stderr, "kernel_launch: occupancy query says %d\n", per_cu); (void)hipGetLastError(); }
        grid = cus;
    }
    if (grid < 0) return;
    if (hipMemsetAsync((char*)d_ws + WS_CTL, 0, CTL_ZERO_BYTES, stream) != hipSuccess) return;
    Args a{};
    for (int i = 0; i < 25; ++i) a.in[i] = (const float*)d_in[i];
    a.out = (float*)d_out; a.ws = (unsigned char*)d_ws;
#if MK_PER_PHASE
    for (int p = 0; p < NPHASES; ++p) {  a.ph_lo = p; a.ph_hi = p + 1; hipLaunchKernelGGL(mk_fwd, dim3(grid), dim3(NTHR), LDS_BYTES, stream, a); }
#else
    a.ph_lo = 0; a.ph_hi = NPHASES; hipLaunchKernelGGL(mk_fwd, dim3(grid), dim3(NTHR), LDS_BYTES, stream, a);
#endif
}
```

```cpp
#include <hip/hip_runtime.h>
#include <cstdio>
#include <cstdint>
#define GAS __attribute__((address_space(1)))
#ifndef PG_WGM
#define PG_WGM 8
#endif
namespace pg8 {
#define PG8_LAS __attribute__((address_space(3)))
typedef unsigned short bf16_t;
typedef short bf16x8 __attribute__((ext_vector_type(8)));
typedef float f32x4 __attribute__((ext_vector_type(4)));
typedef unsigned u32x4 __attribute__((ext_vector_type(4)));
constexpr int BM = 256, BK = 64, HALF = 128, HTB = HALF * BK * 2  , STAGE_BYTES = 8 * HTB, NXCD = 8, WGM = PG_WGM;

__host__ __device__ __forceinline__ int lds_byte(int r, int c) { const int st = (r >> 4) * 2 + (c >> 5), rr = r & 15, cc = c & 31, ob = rr * 64 + cc * 2; return st * 1024 + (ob ^ (((ob >> 9) & 1) << 5)); }
__host__ __device__ __forceinline__ void stage_rc(int b, int& R, int& C) { const int st = b / 1024, sb = b % 1024, swz = sb ^ (((sb >> 9) & 1) << 5); R = (st >> 1) * 16 + swz / 64; C = (st & 1) * 32 + (swz % 64) / 2; }
__host__ __device__ __forceinline__ int perm32(int rho) { const int n = rho >> 4, i = rho & 15; return 8 * (i >> 2) + 4 * n + (i & 3); }

struct Unit { int pm, pn; };
struct Gemm { const bf16_t* A; const bf16_t* Bt; int M, N, K; };

struct StaticOrder {
    int nM, nN, nwg, G, c, wgm;
    __host__ __device__ void init(int M, int N, int G_, int c_, int wgm_ = WGM) { nM = M / BM; nN = N / BM; nwg = nM * nN; G = G_; c = c_; wgm = wgm_; }
    __host__ __device__ bool next(int i, Unit& u) const {
        const long L = (long)i * G + c; if (L >= nwg) return false;
        int wgid = (int)L; { const int q = nwg / NXCD, r = nwg % NXCD, xcd = wgid % NXCD, off = wgid / NXCD; wgid = (xcd < r ? xcd * (q + 1) : r * (q + 1) + (xcd - r) * q) + off; }
        const int nig = wgm * nN, gid = wgid / nig, fm = gid * wgm, gsz = (nM - fm) < wgm ? (nM - fm) : wgm;
        u.pm = fm + ((wgid % nig) % gsz); u.pn = (wgid % nig) / gsz; return true;
    }
    __device__ __forceinline__ void a_ready(const Unit&) const {}
    __device__ __forceinline__ void done(const Unit&) const {}
};

__device__ __forceinline__ unsigned cvt_pk_bf16(float lo, float hi) { unsigned r; asm volatile("v_cvt_pk_bf16_f32 %0, %1, %2" : "=v"(r) : "v"(lo), "v"(hi)); return r; }
typedef float f32x2 __attribute__((ext_vector_type(2)));
#ifndef EPI_NT
#define EPI_NT 0
#endif
#if EPI_NT
#define EPI_ST(p, v) __builtin_nontemporal_store((v), (p))
#else
#define EPI_ST(p, v) (*(p) = (v))
#endif
__device__ __forceinline__ float sigmoid_f(float x) { return __builtin_amdgcn_rcpf(1.0f + __expf(-x)); }
__device__ __forceinline__ float silu_f(float x) { return x * sigmoid_f(x); }
__device__ __forceinline__ float logf_gate(float z, float lb, float  ) {
    const float e = __expf(-fabsf(z));
    const float r = __builtin_amdgcn_rcpf(1.0f + e);
    const float sg = z >= 0.f ? r : e * r;
    const float a = fminf(z, 0.0f) - __logf(1.0f + e);
    const float b = __logf(lb + (1.0f - lb) * sg);
    return lb > 0.0f ? b : a;
}

struct EpiF32 {
    static constexpr bool PERM = false, AFTER_DRAIN = false;
    GAS float* C; int ldc;
    __device__ __forceinline__ void operator()(const f32x4 (&acc)[2][2][4][2], const Unit& u, int wr, int wc, int fr, int fq) const {
        const int row0 = u.pm * BM + wr * 64 + fr, col0 = u.pn * BM + wc * 32 + 4 * fq;
#pragma unroll
        for (int ai = 0; ai < 2; ++ai)
#pragma unroll
            for (int m = 0; m < 4; ++m) { GAS float* rowp = C + (size_t)(row0 + ai * HALF + m * 16) * ldc + col0;
#pragma unroll
                for (int bj = 0; bj < 2; ++bj)
#pragma unroll
                    for (int n = 0; n < 2; ++n) *(GAS f32x4*)(rowp + bj * HALF + n * 16) = acc[ai][bj][m][n]; }
    }
};
struct EpiRelu2 {
    static constexpr bool PERM = true, AFTER_DRAIN = false;
    GAS bf16_t* O; int ldc;
    __device__ __forceinline__ void operator()(const f32x4 (&acc)[2][2][4][2], const Unit& u, int wr, int wc, int fr, int fq) const {
        const int row0 = u.pm * BM + wr * 64 + fr, col0 = u.pn * BM + wc * 32 + 8 * fq;
#pragma unroll
        for (int ai = 0; ai < 2; ++ai)
#pragma unroll
            for (int m = 0; m < 4; ++m) { GAS bf16_t* rowp = O + (size_t)(row0 + ai * HALF + m * 16) * ldc + col0;
#pragma unroll
                for (int bj = 0; bj < 2; ++bj) { f32x4 v0 = acc[ai][bj][m][0], v1 = acc[ai][bj][m][1];
#pragma unroll
                    for (int j = 0; j < 4; ++j) { const float a = fmaxf(v0[j], 0.f), b = fmaxf(v1[j], 0.f); v0[j] = a * a; v1[j] = b * b; }
                    u32x4 w; w.x = cvt_pk_bf16(v0[0], v0[1]); w.y = cvt_pk_bf16(v0[2], v0[3]); w.z = cvt_pk_bf16(v1[0], v1[1]); w.w = cvt_pk_bf16(v1[2], v1[3]);
                    EPI_ST((GAS u32x4*)(rowp + bj * HALF), w); } }
    }
};
struct EpiBf16P {
    static constexpr bool PERM = true, AFTER_DRAIN = false;
    GAS bf16_t* O; int ldc;
    __device__ __forceinline__ void operator()(const f32x4 (&acc)[2][2][4][2], const Unit& u, int wr, int wc, int fr, int fq) const {
        const int row0 = u.pm * BM + wr * 64 + fr, col0 = u.pn * BM + wc * 32 + 8 * fq;
#pragma unroll
        for (int ai = 0; ai < 2; ++ai)
#pragma unroll
            for (int m = 0; m < 4; ++m) { GAS bf16_t* rowp = O + (size_t)(row0 + ai * HALF + m * 16) * ldc + col0;
#pragma unroll
                for (int bj = 0; bj < 2; ++bj) { const f32x4 v0 = acc[ai][bj][m][0], v1 = acc[ai][bj][m][1];
                    u32x4 w; w.x = cvt_pk_bf16(v0[0], v0[1]); w.y = cvt_pk_bf16(v0[2], v0[3]); w.z = cvt_pk_bf16(v1[0], v1[1]); w.w = cvt_pk_bf16(v1[2], v1[3]);
                    EPI_ST((GAS u32x4*)(rowp + bj * HALF), w); } }
    }
};
struct EpiGlu {
    static constexpr bool PERM = true, AFTER_DRAIN = false;
    GAS bf16_t* O; int ldc;
    __device__ __forceinline__ void operator()(const f32x4 (&acc)[2][2][4][2], const Unit& u, int wr, int wc, int fr, int fq) const {
        const int row0 = u.pm * BM + wr * 64 + fr, col0 = u.pn * HALF + wc * 32 + 8 * fq;
#pragma unroll
        for (int ai = 0; ai < 2; ++ai)
#pragma unroll
            for (int m = 0; m < 4; ++m) { GAS bf16_t* rowp = O + (size_t)(row0 + ai * HALF + m * 16) * ldc + col0;
                f32x4 o0, o1;
#pragma unroll
                for (int j = 0; j < 4; ++j) { o0[j] = acc[ai][0][m][0][j] * sigmoid_f(acc[ai][1][m][0][j]); o1[j] = acc[ai][0][m][1][j] * sigmoid_f(acc[ai][1][m][1][j]); }
                u32x4 w; w.x = cvt_pk_bf16(o0[0], o0[1]); w.y = cvt_pk_bf16(o0[2], o0[3]); w.z = cvt_pk_bf16(o1[0], o1[1]); w.w = cvt_pk_bf16(o1[2], o1[3]);
                EPI_ST((GAS u32x4*)(rowp), w); }
    }
};
struct EpiHgIn {
    static constexpr bool PERM = true, AFTER_DRAIN = false;
    GAS bf16_t* Q; size_t hstride; GAS bf16_t* LF; size_t fstride; const GAS float* lbv;
    template <int BJ> __device__ __forceinline__ void gate_half(const f32x4 (&acc)[2][2][4][2], GAS bf16_t* O, const GAS float* lbp, int row0, int col0) const {
        const f32x4 lb0 = *(const GAS f32x4*)(lbp + BJ * HALF), lb1 = *(const GAS f32x4*)(lbp + BJ * HALF + 4);
#pragma unroll
        for (int ai = 0; ai < 2; ++ai)
#pragma unroll
            for (int m = 0; m < 4; ++m) { GAS bf16_t* rowp = O + (size_t)(row0 + ai * HALF + m * 16) * 2048 + col0 + BJ * HALF;
                f32x4 o0, o1;
#pragma unroll
                for (int j = 0; j < 4; ++j) { o0[j] = logf_gate(acc[ai][BJ][m][0][j], lb0[j], 0.f); o1[j] = logf_gate(acc[ai][BJ][m][1][j], lb1[j], 0.f); }
                u32x4 w; w.x = cvt_pk_bf16(o0[0], o0[1]); w.y = cvt_pk_bf16(o0[2], o0[3]); w.z = cvt_pk_bf16(o1[0], o1[1]); w.w = cvt_pk_bf16(o1[2], o1[3]);
                EPI_ST((GAS u32x4*)(rowp), w); }
    }
    __device__ __forceinline__ void operator()(const f32x4 (&acc)[2][2][4][2], const Unit& u, int wr, int wc, int fr, int fq) const {
        const int typ = u.pn >> 3, row0 = u.pm * BM + wr * 64 + fr, col0 = (u.pn & 7) * BM + wc * 32 + 8 * fq;
        if (typ == 2 || typ == 3) {
            GAS bf16_t* O = LF + (size_t)(typ - 2) * fstride;
            const GAS float* lbp = lbv + (typ == 2 ? 0 : 2048) + col0;
            gate_half<0>(acc, O, lbp, row0, col0); gate_half<1>(acc, O, lbp, row0, col0);
        } else {
            GAS bf16_t* O = Q + (size_t)((typ >> 2) * 2 + (typ & 1)) * hstride; const bool act = typ != 1;
#pragma unroll
            for (int ai = 0; ai < 2; ++ai)
#pragma unroll
                for (int m = 0; m < 4; ++m) { GAS bf16_t* rowp = O + (size_t)(row0 + ai * HALF + m * 16) * 2048 + col0;
#pragma unroll
                    for (int bj = 0; bj < 2; ++bj) { f32x4 v0 = acc[ai][bj][m][0], v1 = acc[ai][bj][m][1];
                        if (act) {
#pragma unroll
                            for (int j = 0; j < 4; ++j) { v0[j] = silu_f(v0[j]); v1[j] = silu_f(v1[j]); } }
                        u32x4 w; w.x = cvt_pk_bf16(v0[0], v0[1]); w.y = cvt_pk_bf16(v0[2], v0[3]); w.z = cvt_pk_bf16(v1[0], v1[1]); w.w = cvt_pk_bf16(v1[2], v1[3]);
                        EPI_ST((GAS u32x4*)(rowp + bj * HALF), w); } }
        }
    }
};
#ifndef PG_AUX_A
#define PG_AUX_A 0
#endif
#ifndef PG_AUX_B
#define PG_AUX_B 0
#endif
template <class Epi, class Sched, bool ALIGN_EPI = false, bool SP2 = false>
__device__ __forceinline__ void gemm_phase(PG8_LAS unsigned char* lds, const Gemm g, const Sched& S, const Epi& E) {
    int tid_ = threadIdx.x; asm volatile("" : "+v"(tid_));
    const int tid = tid_, wid = __builtin_amdgcn_readfirstlane(tid >> 6), lane = tid & 63, wr = wid >> 2, wc = wid & 3, fr = lane & 15, fq = lane >> 4;
    const int K = g.K, nt = K / BK;
    unsigned voffA[2], voffB[2];
#pragma unroll
    for (int i = 0; i < 2; ++i) { int R, C; stage_rc(tid * 16 + i * 8192, R, C); const int Rb = Epi::PERM ? ((R & ~31) + perm32(R & 31)) : R;
        voffA[i] = (unsigned)(R * K + C) * 2u; voffB[i] = (unsigned)(Rb * K + C) * 2u; }
    const size_t kstep = (size_t)(BK * 2);
    const size_t hstep = (size_t)HALF * K * 2;
    const size_t tstep = 2 * hstep;
    const unsigned ldsw = (unsigned)wid * 1024u;
    const int aoff = lds_byte(wr * 64 + fr, fq * 8), boff = lds_byte(wc * 32 + fr, fq * 8);
#define PG8_SA(b, h) (((b) * 2 + (h)) * HTB)
#define PG8_SB(b, h) ((4 + (b) * 2 + (h)) * HTB)
#define PG8_STAGE(bufoff, gbase, voff) do { _Pragma("unroll") for (int _i = 0; _i < 2; ++_i) \
        __builtin_amdgcn_global_load_lds((const unsigned*)((const char*)(gbase) + (voff)[_i]), (PG8_LAS unsigned*)(lds + (bufoff) + ldsw + _i * 8192), 16, 0, PG_AUX_B); } while (0)
#define PG8_STAGEA(bufoff, gbase, voff) do { _Pragma("unroll") for (int _i = 0; _i < 2; ++_i) \
        __builtin_amdgcn_global_load_lds((const unsigned*)((const char*)(gbase) + (voff)[_i]), (PG8_LAS unsigned*)(lds + (bufoff) + ldsw + _i * 8192), 16, 0, PG_AUX_A); } while (0)
#define PG8_LDA(dst, b, h) do { _Pragma("unroll") for (int m = 0; m < 4; ++m) _Pragma("unroll") for (int k = 0; k < 2; ++k) dst[m][k] = *(const PG8_LAS bf16x8*)(lds + PG8_SA(b, h) + aoff + m * 2048 + k * 1024); } while (0)
#define PG8_LDB(dst, b, h) do { _Pragma("unroll") for (int n = 0; n < 2; ++n) _Pragma("unroll") for (int k = 0; k < 2; ++k) dst[n][k] = *(const PG8_LAS bf16x8*)(lds + PG8_SB(b, h) + boff + n * 2048 + k * 1024); } while (0)
#define PG8_MMA(ai, bj, At, Bt) do { __builtin_amdgcn_s_setprio(1); _Pragma("unroll") for (int m = 0; m < 4; ++m) _Pragma("unroll") for (int n = 0; n < 2; ++n) _Pragma("unroll") for (int k = 0; k < 2; ++k) \
        acc[ai][bj][m][n] = __builtin_amdgcn_mfma_f32_16x16x32_bf16(Bt[n][k], At[m][k], acc[ai][bj][m][n], 0, 0, 0); __builtin_amdgcn_s_setprio(0); } while (0)
#define PG8_WAIT_V(n) asm volatile("s_waitcnt vmcnt(" #n ")" ::: "memory")
#define PG8_WAIT_L(n) asm volatile("s_waitcnt lgkmcnt(" #n ")" ::: "memory")
#define PG8_BAR __builtin_amdgcn_s_barrier()
#define PG8_SCHED __builtin_amdgcn_sched_barrier(0)
    Unit cur, nxt; int ui = 0;
    if (!S.next(0, cur)) return;
    f32x4 acc[2][2][4][2];
#pragma unroll
    for (int a = 0; a < 2; ++a)
#pragma unroll
        for (int b = 0; b < 2; ++b)
#pragma unroll
            for (int m = 0; m < 4; ++m)
#pragma unroll
                for (int n = 0; n < 2; ++n) acc[a][b][m][n] = (f32x4){0.f, 0.f, 0.f, 0.f};
    bf16x8 At[4][2], B0[2][2], B1[2][2];
    const char* cA = (const char*)g.A + (size_t)cur.pm * tstep; const char* cB = (const char*)g.Bt + (size_t)cur.pn * tstep;
    S.a_ready(cur);
    if constexpr (SP2) {
        PG8_STAGE(PG8_SB(0, 0), cB, voffB); PG8_STAGE(PG8_SB(0, 1), cB + hstep, voffB); PG8_STAGEA(PG8_SA(0, 0), cA, voffA); PG8_STAGEA(PG8_SA(0, 1), cA + hstep, voffA);
        if (wr == 1) PG8_BAR;
        PG8_WAIT_V(2); PG8_BAR;
        PG8_STAGE(PG8_SB(1, 0), cB + kstep, voffB); PG8_STAGEA(PG8_SA(1, 0), cA + kstep, voffA); PG8_STAGE(PG8_SB(1, 1), cB + hstep + kstep, voffB);
        PG8_WAIT_V(6); PG8_BAR;
    } else {
        PG8_STAGE(PG8_SB(0, 0), cB, voffB); PG8_STAGEA(PG8_SA(0, 0), cA, voffA); PG8_STAGE(PG8_SB(0, 1), cB + hstep, voffB); PG8_STAGEA(PG8_SA(0, 1), cA + hstep, voffA);
        if (wr == 1) PG8_BAR;
        PG8_WAIT_V(4); PG8_BAR;
        PG8_STAGE(PG8_SB(1, 0), cB + kstep, voffB); PG8_STAGEA(PG8_SA(1, 0), cA + kstep, voffA); PG8_STAGE(PG8_SB(1, 1), cB + hstep + kstep, voffB);
        PG8_WAIT_V(6); PG8_BAR;
    }
    for (;;) {
        const bool has_next = S.next(ui + 1, nxt);
        const char* nA = has_next ? (const char*)g.A + (size_t)nxt.pm * tstep : cA; const char* nB = has_next ? (const char*)g.Bt + (size_t)nxt.pn * tstep : cB;
        for (int t = 0; t < nt; t += 2) {
            const bool last = (t == nt - 2);
            const char* a1 = cA + (size_t)(t + 1) * kstep;
            const char* a2 = last ? nA : cA + (size_t)(t + 2) * kstep; const char* b2 = last ? nB : cB + (size_t)(t + 2) * kstep;
            const char* a3 = a2 + kstep; const char* b3 = b2 + kstep;
            if (last && has_next) S.a_ready(nxt);
            if constexpr (SP2) {
            PG8_LDB(B0, 0, 0); PG8_LDB(B1, 0, 1); PG8_SCHED; PG8_LDA(At, 0, 0); PG8_STAGEA(PG8_SA(1, 1), a1 + hstep, voffA);
            PG8_WAIT_V(8); PG8_WAIT_L(0); PG8_BAR; PG8_MMA(0, 0, At, B0); PG8_MMA(0, 1, At, B1); PG8_BAR; PG8_SCHED;
            PG8_LDA(At, 0, 1); PG8_STAGE(PG8_SB(0, 0), b2, voffB); PG8_STAGE(PG8_SB(0, 1), b2 + hstep, voffB); PG8_STAGEA(PG8_SA(0, 0), a2, voffA);
            PG8_WAIT_V(8); PG8_WAIT_L(0); PG8_BAR; PG8_MMA(1, 0, At, B0); PG8_MMA(1, 1, At, B1); PG8_BAR; PG8_SCHED;
            PG8_LDB(B0, 1, 0); PG8_LDB(B1, 1, 1); PG8_SCHED; PG8_LDA(At, 1, 0); PG8_STAGEA(PG8_SA(0, 1), a2 + hstep, voffA);
            PG8_WAIT_V(8); PG8_WAIT_L(0); PG8_BAR; PG8_MMA(0, 0, At, B0); PG8_MMA(0, 1, At, B1); PG8_BAR; PG8_SCHED;
            PG8_LDA(At, 1, 1); PG8_STAGE(PG8_SB(1, 0), b3, voffB); PG8_STAGE(PG8_SB(1, 1), b3 + hstep, voffB); PG8_STAGEA(PG8_SA(1, 0), a3, voffA);
            PG8_WAIT_V(8); PG8_WAIT_L(0); PG8_BAR; PG8_MMA(1, 0, At, B0); PG8_MMA(1, 1, At, B1); PG8_BAR; PG8_SCHED;
            } else {
            PG8_LDB(B0, 0, 0); PG8_SCHED; PG8_LDA(At, 0, 0); PG8_STAGEA(PG8_SA(1, 1), a1 + hstep, voffA);
            PG8_WAIT_L(8); PG8_BAR; PG8_WAIT_L(0); PG8_MMA(0, 0, At, B0); PG8_BAR; PG8_SCHED;
            PG8_LDB(B1, 0, 1); PG8_STAGE(PG8_SB(0, 0), b2, voffB);
            PG8_BAR; PG8_WAIT_L(0); PG8_MMA(0, 1, At, B1); PG8_BAR;
            PG8_LDA(At, 0, 1); PG8_STAGEA(PG8_SA(0, 0), a2, voffA);
            PG8_BAR; PG8_WAIT_L(0); PG8_MMA(1, 0, At, B0); PG8_BAR; PG8_SCHED;
            PG8_STAGE(PG8_SB(0, 1), b2 + hstep, voffB);
            PG8_WAIT_V(6); PG8_BAR; PG8_MMA(1, 1, At, B1); PG8_BAR;
            PG8_LDB(B0, 1, 0); PG8_SCHED; PG8_LDA(At, 1, 0); PG8_STAGEA(PG8_SA(0, 1), a2 + hstep, voffA);
            PG8_WAIT_L(8); PG8_BAR; PG8_WAIT_L(0); PG8_MMA(0, 0, At, B0); PG8_BAR; PG8_SCHED;
            PG8_LDB(B1, 1, 1); PG8_STAGE(PG8_SB(1, 0), b3, voffB);
            PG8_BAR; PG8_WAIT_L(0); PG8_MMA(0, 1, At, B1); PG8_BAR;
            PG8_LDA(At, 1, 1); PG8_STAGEA(PG8_SA(1, 0), a3, voffA);
            PG8_BAR; PG8_WAIT_L(0); PG8_MMA(1, 0, At, B0); PG8_BAR; PG8_SCHED;
            PG8_STAGE(PG8_SB(1, 1), b3 + hstep, voffB);
            PG8_WAIT_V(6); PG8_BAR; PG8_MMA(1, 1, At, B1); PG8_BAR;
            }
        }
        if constexpr (ALIGN_EPI) { if (wr == 0) PG8_BAR; }
        if constexpr (!Epi::AFTER_DRAIN) { E(acc, cur, wr, wc, fr, fq); S.done(cur); }
        if (!has_next) break;
#pragma unroll
        for (int a = 0; a < 2; ++a)
#pragma unroll
            for (int b = 0; b < 2; ++b)
#pragma unroll
                for (int m = 0; m < 4; ++m)
#pragma unroll
                    for (int n = 0; n < 2; ++n) acc[a][b][m][n] = (f32x4){0.f, 0.f, 0.f, 0.f};
        cur = nxt; cA = nA; cB = nB; ++ui;
        if constexpr (ALIGN_EPI) { if (wr == 1) PG8_BAR; }
    }
    PG8_WAIT_V(0);
    if constexpr (!ALIGN_EPI) { if (wr == 0) PG8_BAR; }
    PG8_BAR;
    if constexpr (Epi::AFTER_DRAIN) { E.fused(acc, cur, wr, wc, fr, fq, lds, wid, lane); S.done(cur); }
#undef PG8_SA
#undef PG8_SB
#undef PG8_STAGE
#undef PG8_STAGEA
#undef PG8_LDA
#undef PG8_LDB
#undef PG8_MMA
#undef PG8_WAIT_V
#undef PG8_WAIT_L
#undef PG8_BAR
#undef PG8_SCHED
}
}
constexpr int DM = 2048, SEQ = 8192, CTXL = 256, MTOT = SEQ + CTXL, HID = 8192, NMOD = 6 * DM;
constexpr int NWAVES = 8, NTHR = 512;
constexpr float NEPS = 1e-6f;
#ifndef MK_PER_PHASE
#define MK_PER_PHASE 0
#endif
constexpr int NPHASES = 35;
#ifndef PG_CID
#define PG_CID ((int)((blockIdx.x >> 5) + 8 * (blockIdx.x & 31)))
#endif
#ifndef PG_ALIGN
#define PG_ALIGN true
#endif
#ifndef PG_SP2
#define PG_SP2 true
#endif
#ifndef REP_P0
#define REP_P0 0
#endif
#ifndef REP_S5
#define REP_S5 0
#endif
#ifndef REP_HG
#define REP_HG 0
#endif
#ifndef REP_GEMM
#define REP_GEMM 0
#endif
#ifndef REP_BAR
#define REP_BAR 0
#endif
#ifndef REP_R1
#define REP_R1 0
#endif
#ifndef REP_R2
#define REP_R2 0
#endif
#ifndef REP_GGLU
#define REP_GGLU 0
#endif
#ifndef REP_GIN
#define REP_GIN 0
#endif
#ifndef REP_GOUT
#define REP_GOUT 0
#endif
#ifndef REP_GHG
#define REP_GHG 0
#endif
#ifndef WGM_GLU
#define WGM_GLU 2
#endif
#ifndef WGM_IN
#define WGM_IN 2
#endif
#ifndef WGM_OUT
#define WGM_OUT 2
#endif
#ifndef WGM_HG
#define WGM_HG 2
#endif
#ifndef WGM_OP
#define WGM_OP 2
#endif
#ifndef REP_RN
#define REP_RN 0
#endif
#ifndef REP_CTX
#define REP_CTX 0
#endif
#ifndef REP_THIN
#define REP_THIN 0
#endif

constexpr size_t MiB = 1u << 20;
constexpr size_t WS_CTL = 0, CTL_ZERO_BYTES = 1 * MiB;
constexpr size_t WS_MOD = 1 * MiB;
constexpr size_t WS_LBV = 2 * MiB;
constexpr size_t WS_PART = 3 * MiB;
constexpr size_t WS_W1 = 16 * MiB;
constexpr size_t WS_W2 = WS_W1 + 128 * MiB;
constexpr size_t WS_WGLU = WS_W2 + 128 * MiB;
constexpr size_t WS_WIN = WS_WGLU + 32 * MiB;
constexpr size_t WS_WOUT = WS_WIN + 80 * MiB;
constexpr size_t WS_X = WS_WOUT + 16 * MiB;
constexpr size_t WS_H = WS_X + 66 * MiB;
constexpr size_t WS_Z = WS_H + 33 * MiB;
constexpr size_t WS_Y1 = WS_Z + 33 * MiB;
constexpr size_t WS_Y2 = WS_Y1 + 66 * MiB;
constexpr size_t WS_HID = WS_Y2 + 66 * MiB;
constexpr size_t WS_Q = WS_HID + 132 * MiB;
constexpr size_t WS_V = WS_Q + 33 * MiB;
constexpr size_t WS_SG = WS_V + 33 * MiB;
constexpr size_t WS_LF = WS_SG + 33 * MiB;
constexpr size_t WS_LB = WS_LF + 66 * MiB;
constexpr size_t WS_OF = WS_LB + 66 * MiB;
constexpr size_t WS_OB = WS_OF + 66 * MiB;
constexpr size_t WS_REC = WS_OB + 66 * MiB;
constexpr size_t WS_SEGS = WS_REC + 224 * MiB;
constexpr size_t WS_SEGD = WS_SEGS + 16 * MiB;
constexpr size_t WS_YP1 = WS_SEGD + 1 * MiB;
constexpr size_t WS_YP2 = WS_YP1 + 8 * MiB;
constexpr size_t WS_END = WS_YP2 + 8 * MiB;
constexpr int CW_BAR = 4096;

constexpr int RING_OFF = 0, RING_BYTES = 135168;
constexpr int LDSCTL_OFF = RING_BYTES, MISC_OFF = LDSCTL_OFF + 320;
constexpr int LDS_BYTES = 147456;

#define LAS __attribute__((address_space(3)))
typedef unsigned short bf16;
typedef unsigned v4u __attribute__((ext_vector_type(4)));
typedef unsigned v2u __attribute__((ext_vector_type(2)));
typedef float f32x4 __attribute__((ext_vector_type(4)));
typedef short bf16x8 __attribute__((ext_vector_type(8)));
#define LDS_WAIT() asm volatile("s_waitcnt lgkmcnt(0)" ::: "memory")
#define VM_WAIT() asm volatile("s_waitcnt vmcnt(0)" ::: "memory")
__device__ __forceinline__ unsigned f2bf(float f) { unsigned u = __builtin_bit_cast(unsigned, f); return (u + 0x7fffu + ((u >> 16) & 1u)) >> 16; }
__device__ __forceinline__ unsigned pk2(float lo, float hi) { return f2bf(lo) | (f2bf(hi) << 16); }
__device__ __forceinline__ float bflo(unsigned w) { return __builtin_bit_cast(float, w << 16); }
__device__ __forceinline__ float bfhi(unsigned w) { return __builtin_bit_cast(float, w & 0xffff0000u); }
typedef float f32x2 __attribute__((ext_vector_type(2)));
typedef __bf16 bf16x2n __attribute__((ext_vector_type(2)));
__device__ __forceinline__ unsigned pkbf(float lo, float hi) { f32x2 v = {lo, hi}; return __builtin_bit_cast(unsigned, __builtin_convertvector(v, bf16x2n)); }
__device__ __forceinline__ float bf1(bf16 b) { return __builtin_bit_cast(float, ((unsigned)b) << 16); }

#define XB_TMO      128
#define XB_XCNT(j)  (256  + 64 * (j))
#define XB_XSUB(j)  (1280 + 64 * (j))
#define XB_XGEN(j)  (2304 + 64 * (j))
#define XB_TOP      3328
#define XB_TOPGEN   3392
#define XCD_BAR_WORDS 3456
#define XB_SPIN_CAP (1u << 18)

__device__ __forceinline__ unsigned xb_ld(unsigned* p)              { return __hip_atomic_load(p, __ATOMIC_RELAXED, __HIP_MEMORY_SCOPE_AGENT); }
__device__ __forceinline__ unsigned xb_add(unsigned* p, unsigned v) { return __hip_atomic_fetch_add(p, v, __ATOMIC_RELAXED, __HIP_MEMORY_SCOPE_AGENT); }
__device__ __forceinline__ unsigned xb_xcc_id() { return (unsigned)__builtin_amdgcn_s_getreg((3 << 11) | 20) & 0xFu; }
#define XB_SPIN(cond, bar) do { unsigned _sp = 0; while (cond) { __builtin_amdgcn_s_sleep(1); \
    if ((++_sp & 255u) == 0u) { if (xb_ld(&(bar)[XB_TMO])) break; if (_sp > XB_SPIN_CAP) { atomicAdd(&(bar)[XB_TMO], 1u); break; } } } } while (0)

struct XcdBarrier {
    unsigned* bar; unsigned x;
    volatile LAS unsigned* st;
};

__device__ __forceinline__ XcdBarrier xcd_barrier_post(unsigned* bar, volatile LAS unsigned* st) {
    XcdBarrier b; b.bar = bar; b.x = xb_xcc_id(); b.st = st;
    if (threadIdx.x == 0) (void)xb_add(&bar[XB_XCNT(b.x)], 1u);
    return b;
}
__device__ __forceinline__ void xcd_barrier_complete(unsigned* bar, unsigned x, unsigned& nloc, unsigned& nx) {
    const unsigned G = gridDim.x * gridDim.y * gridDim.z;
    unsigned sum, cnt, mine, sp = 0u;
    for (;;) {
        sum = 0u; cnt = 0u; mine = 0u;
#pragma unroll
        for (unsigned j = 0; j < 16; ++j) { const unsigned c = xb_ld(&bar[XB_XCNT(j)]); sum += c; cnt += (c > 0u) ? 1u : 0u; mine = (j == x) ? c : mine; }
        if (sum == G) break;
        __builtin_amdgcn_s_sleep(1);
        if ((++sp & 255u) == 0u) { if (xb_ld(&bar[XB_TMO])) break; if (sp > XB_SPIN_CAP) { atomicAdd(&bar[XB_TMO], 1u); break; } }
    }
    nloc = mine > 0u ? mine : 1u; nx = cnt > 0u ? cnt : 1u;
}

__device__ __forceinline__ void xcd_barrier(const XcdBarrier& b) {
    asm volatile("s_waitcnt vmcnt(0)" ::: "memory");
    __syncthreads();
    if (threadIdx.x == 0) {
        unsigned* bar = b.bar;
        __builtin_amdgcn_s_waitcnt(0);
        unsigned nloc = b.st[0], nx = b.st[1];
        if (nloc == 0u) { xcd_barrier_complete(bar, b.x, nloc, nx); b.st[0] = nloc; b.st[1] = nx; }
        const unsigned old = xb_add(&bar[XB_XSUB(b.x)], 1u);
        const unsigned gen = old / nloc;
        if (old + 1u == (gen + 1u) * nloc) {
            __builtin_amdgcn_fence(__ATOMIC_RELEASE, "agent");
            asm volatile("s_waitcnt vmcnt(0)" ::: "memory");
            const unsigned og = xb_add(&bar[XB_TOP], 1u);
            const unsigned tg = og / nx;
            if (og + 1u == (tg + 1u) * nx) xb_add(&bar[XB_TOPGEN], 1u);
            else XB_SPIN(xb_ld(&bar[XB_TOPGEN]) == tg, bar);
            __builtin_amdgcn_fence(__ATOMIC_ACQUIRE, "agent");
            xb_add(&bar[XB_XGEN(b.x)], 1u);
            asm volatile("s_waitcnt vmcnt(0)" ::: "memory");
        } else {
            XB_SPIN(xb_ld(&bar[XB_XGEN(b.x)]) == gen, bar);
            __builtin_amdgcn_fence(__ATOMIC_ACQUIRE, "agent");
            asm volatile("s_waitcnt vmcnt(0)" ::: "memory");
        }
    }
    __syncthreads();
}

typedef const unsigned short* gen_cbf; typedef unsigned* gen_u32p;
struct Args { const float* in[25]; float* out; unsigned char* ws; int ph_lo, ph_hi; };
template <class T> __device__ __forceinline__ GAS T* opq(T* p) { GAS T* g = (GAS T*)p; asm volatile("" : "+s"(g)); return g; }
template <class T> __device__ __forceinline__ GAS T* opq(GAS T* g) { asm volatile("" : "+s"(g)); return g; }
__device__ __forceinline__ int opqv(int v) { asm volatile("" : "+v"(v)); return v; }
#define AIN(k) opq(args.in[k])
#define WSP(off) (opq(F.ws) + (off))
struct Frame {
    LAS unsigned char* lds;
    volatile LAS unsigned* MISC;
    int tid, lane, wave, vcu, G;
    GAS unsigned char* ws;
    GAS float* out;
};
__device__ __forceinline__ int opqs(int v) { asm volatile("" : "+s"(v)); return v; }
__device__ __forceinline__ void relane(Frame& F) { F.lane = opqv(F.lane); F.tid = opqv(F.tid); F.wave = opqs(F.wave); F.vcu = opqs(F.vcu);
    unsigned lb = (unsigned)(size_t)F.lds; asm volatile("" : "+s"(lb)); F.lds = (LAS unsigned char*)(size_t)lb; }
__device__ __forceinline__ float xshfl(float v, int lane, int o) { return __builtin_bit_cast(float, __builtin_amdgcn_ds_bpermute((lane ^ o) << 2, __builtin_bit_cast(int, v))); }
__device__ __forceinline__ float wave_sum(float v, int lane) {
#pragma unroll
    for (int o = 1; o < 64; o <<= 1) v += xshfl(v, lane, o);
    return v;
}

__device__ __forceinline__ void p0_transpose_item(const GAS float* W, int K, int N, GAS bf16* WT, int k0, int n0, int dst_row0, LAS unsigned char* scr, int lane) {
    const int n4 = (lane & 15) * 4, kp = lane >> 4;
    const GAS float* src = W + (size_t)(k0 + 2 * kp) * N + n0 + n4;
    f32x4 v[16];
#pragma unroll
    for (int i = 0; i < 8; ++i) { v[2 * i] = *(const GAS f32x4*)(src + (size_t)(8 * i) * N); v[2 * i + 1] = *(const GAS f32x4*)(src + (size_t)(8 * i + 1) * N); }
#pragma unroll
    for (int i = 0; i < 8; ++i) {
#pragma unroll
        for (int e = 0; e < 4; ++e) *(LAS unsigned*)(scr + (n4 + e) * 144 + (8 * i + 2 * kp) * 2) = pkbf(v[2 * i][e], v[2 * i + 1][e]);
    }
    LDS_WAIT(); asm volatile("" ::: "memory");
    const int c = lane & 7, nr = lane >> 3;
#pragma unroll
    for (int j = 0; j < 8; ++j) { const int n = nr + 8 * j; const v4u o = *(const LAS v4u*)(scr + n * 144 + c * 16);
        *(GAS v4u*)(WT + (size_t)(dst_row0 + n) * K + k0 + 8 * c) = o; }
    LDS_WAIT(); asm volatile("" ::: "memory");
}
__device__ __forceinline__ void phase_p0(Frame& F, const Args& args) {
    relane(F);
    LAS unsigned char* scr = F.lds + RING_OFF + F.wave * 9216;
    const int gw = F.vcu * NWAVES + F.wave, NGW = F.G * NWAVES;
    constexpr int I_W1 = (DM / 64) * (HID / 64);
    constexpr int I_W2 = (HID / 64) * (DM / 64);
    constexpr int I_GLU = (DM / 64) * (4096 / 64);
    constexpr int I_IN = (DM / 64) * (10240 / 64);
    constexpr int I_OUT = (DM / 64) * (DM / 64);
    constexpr int T_W1 = 4 * I_W1, T_W2 = 4 * I_W2, T_GLU = 2 * I_GLU, T_IN = 2 * I_IN, T_OUT = 2 * I_OUT;
    constexpr int NITEMS = T_W1 + T_W2 + T_GLU + T_IN + T_OUT;
    for (int it = gw; it < NITEMS; it += NGW) {
        int r = it;
        if (r < T_W1) { const int l = r / I_W1, q = r % I_W1, nblk = HID / 64, qg = q >> 3, qw = q & 3, qk = (q >> 2) & 1, kb = 2 * (qg / (nblk / 4)) + qk, nb = 4 * (qg % (nblk / 4)) + qw;
            p0_transpose_item(AIN(10) + (size_t)l * DM * HID, DM, HID, (GAS bf16*)(WSP(WS_W1)) + (size_t)l * HID * DM, 64 * kb, 64 * nb, 64 * nb, scr, F.lane); continue; } r -= T_W1;
        if (r < T_W2) { const int l = r / I_W2, q = r % I_W2, nblk = DM / 64, qg = q >> 3, qw = q & 3, qk = (q >> 2) & 1, kb = 2 * (qg / (nblk / 4)) + qk, nb = 4 * (qg % (nblk / 4)) + qw;
            p0_transpose_item(AIN(11) + (size_t)l * HID * DM, HID, DM, (GAS bf16*)(WSP(WS_W2)) + (size_t)l * DM * HID, 64 * kb, 64 * nb, 64 * nb, scr, F.lane); continue; } r -= T_W2;
        if (r < T_GLU) { const int l = r / I_GLU, q = r % I_GLU, nblk = 4096 / 64, qg = q >> 3, qw = q & 3, qk = (q >> 2) & 1, kb = 2 * (qg / (nblk / 4)) + qk, nb = 4 * (qg % (nblk / 4)) + qw, n0 = 64 * nb;
            const int c = n0 & 2047, dst = 256 * (c >> 7) + (n0 >= 2048 ? 128 : 0) + (c & 127);
            p0_transpose_item(AIN(20) + (size_t)l * DM * 4096, DM, 4096, (GAS bf16*)(WSP(WS_WGLU)) + (size_t)l * 4096 * DM, 64 * kb, n0, dst, scr, F.lane); continue; } r -= T_GLU;
        if (r < T_IN) { const int l = r / I_IN, q = r % I_IN, nblk = 10240 / 64, qg = q >> 3, qw = q & 3, qk = (q >> 2) & 1, kb = 2 * (qg / (nblk / 4)) + qk, nb = 4 * (qg % (nblk / 4)) + qw;
            p0_transpose_item(AIN(21) + (size_t)l * DM * 10240, DM, 10240, (GAS bf16*)(WSP(WS_WIN)) + (size_t)l * 10240 * DM, 64 * kb, 64 * nb, 64 * nb, scr, F.lane); continue; } r -= T_IN;
        { const int l = r / I_OUT, q = r % I_OUT, nblk = DM / 64, qg = q >> 3, qw = q & 3, qk = (q >> 2) & 1, kb = 2 * (qg / (nblk / 4)) + qk, nb = 4 * (qg % (nblk / 4)) + qw;
            p0_transpose_item(AIN(24) + (size_t)l * DM * DM, DM, DM, (GAS bf16*)(WSP(WS_WOUT)) + (size_t)l * DM * DM, 64 * kb, 64 * nb, 64 * nb, scr, F.lane); }
    }
    __syncthreads();
    LAS float* sc = (LAS float*)(F.lds + RING_OFF);
    for (int i = F.tid; i < 2 * DM; i += NTHR) { const float v = i < DM ? AIN(1)[i] : AIN(3)[i - DM]; sc[i] = v / (1.0f + __expf(-v)); }
    __syncthreads();
    LAS float* red = sc + 2 * DM;
    GAS float* PART = (GAS float*)(WSP(WS_PART));
    for (int it = F.vcu; it < 4 * 16 * 12; it += F.G) {
        const int l = it / 192, q = it % 192, kc = q / 12, cb = q % 12;
        const int c4 = F.tid & 255, rh = F.tid >> 8, col = cb * 1024 + c4 * 4;
        const GAS float* wp = AIN(4) + ((size_t)l * DM + kc * 128 + rh * 64) * NMOD + col;
        f32x4 a0 = {0.f, 0.f, 0.f, 0.f}, a1 = {0.f, 0.f, 0.f, 0.f};
#pragma unroll 8
        for (int k = 0; k < 64; ++k) { const f32x4 w = *(const GAS f32x4*)(wp + (size_t)k * NMOD); const float s0 = sc[kc * 128 + rh * 64 + k], s1 = sc[DM + kc * 128 + rh * 64 + k];
            a0 += w * s0; a1 += w * s1; }
        if (rh == 1) { *(LAS f32x4*)(red + c4 * 8) = a0; *(LAS f32x4*)(red + c4 * 8 + 4) = a1; }
        __syncthreads();
        if (rh == 0) { a0 += *(LAS f32x4*)(red + c4 * 8); a1 += *(LAS f32x4*)(red + c4 * 8 + 4);
            GAS float* o = PART + ((size_t)(l * 16 + kc) * 2) * NMOD + col;
            *(GAS f32x4*)o = a0; *(GAS f32x4*)(o + NMOD) = a1; }
        __syncthreads();
    }
}
__device__ __forceinline__ void phase_p1(Frame& F, const Args& args) {
    relane(F);
    const GAS float* PART = (const GAS float*)(WSP(WS_PART)); GAS float* MOD = (GAS float*)(WSP(WS_MOD)); GAS float* LBV = (GAS float*)(WSP(WS_LBV));
    const int gt = F.vcu * NTHR + F.tid, NT = F.G * NTHR;
    for (int i = gt; i < 4 * 2 * NMOD; i += NT) { const int l = i / (2 * NMOD), r = i % (2 * NMOD), w = r / NMOD, col = r % NMOD;
        float s = AIN(5)[l * NMOD + col];
#pragma unroll
        for (int kc = 0; kc < 16; ++kc) s += PART[((size_t)(l * 16 + kc) * 2 + w) * NMOD + col];
        MOD[i] = s; }
    for (int i = gt; i < 2 * 2 * DM; i += NT) { const int j = i / (2 * DM), r = i % (2 * DM), d = r / DM, col = r % DM;
        const float r0 = AIN(22)[(d * 2 + 0) * DM + col], r1 = AIN(22)[(d * 2 + 1) * DM + col];
        const float mx = fmaxf(r0, r1), e0 = expf(r0 - mx), e1 = expf(r1 - mx), w0 = e0 / (e0 + e1), w1 = e1 / (e0 + e1);
        LBV[i] = (j == 0) ? (w0 - w0) : ((w0 + w1) - w0); }
}

#define THIN_ROW_BODY(PG, PGP, PPRE, PSH, PSC, LD4, YV) do { \
        if (MODE != 0) { float s_ = 0.f; \
            _Pragma("unroll") for (int j = 0; j < 8; ++j) { const f32x4 yv_ = YV(j); s_ += (yv_.x * yv_.x + yv_.y * yv_.y) + (yv_.z * yv_.z + yv_.w * yv_.w); } \
            const float rs_ = 1.0f / sqrtf(wave_sum(s_, ln_) * (1.0f / DM) + NEPS); \
            _Pragma("unroll") for (int j = 0; j < 8; ++j) { const f32x4 g_ = LD4(PG, j), gp_ = LD4(PGP, j); x[j] += g_ * ((YV(j) * rs_) * gp_); if (j & 1) asm volatile("" ::: "memory"); } } \
        if (MODE == 2) { _Pragma("unroll") for (int j = 0; j < 8; ++j) *(GAS f32x4*)(F.out + (size_t)r * DM + 4 * ln_ + 256 * j) = x[j]; } \
        else { _Pragma("unroll") for (int j = 0; j < 8; ++j) { v2u xo_; xo_.x = pkbf(x[j].x, x[j].y); xo_.y = pkbf(x[j].z, x[j].w); *(GAS v2u*)(Xo + (size_t)r * DM + 4 * ln_ + 256 * j) = xo_; } \
            float s_ = 0.f; \
            _Pragma("unroll") for (int j = 0; j < 8; ++j) s_ += (x[j].x * x[j].x + x[j].y * x[j].y) + (x[j].z * x[j].z + x[j].w * x[j].w); \
            const float rs_ = 1.0f / sqrtf(wave_sum(s_, ln_) * (1.0f / DM) + NEPS); \
            _Pragma("unroll") for (int j = 0; j < 8; ++j) { const f32x4 gp_ = LD4(PPRE, j), sh_ = LD4(PSH, j), sc_ = LD4(PSC, j); \
                const f32x4 h_ = ((x[j] * rs_) * gp_) * (sc_ + 1.0f) + sh_; v2u o_; o_.x = pkbf(h_.x, h_.y); o_.y = pkbf(h_.z, h_.w); \
                if (HGM) *(GAS v2u*)(H + ((size_t)((ln_ >> 2) + 16 * j) * MTOT + r) * 16 + 4 * (ln_ & 3)) = o_; else *(GAS v2u*)(H + (size_t)r * DM + 4 * ln_ + 256 * j) = o_; if (j & 1) asm volatile("" ::: "memory"); } } } while (0)
#define THIN_YF(j) (y[j])
#define THIN_YP(j) ((f32x4){bflo(yp[j].x), bfhi(yp[j].x), bflo(yp[j].y), bfhi(yp[j].y)})
#define THIN_LDG(P, j) (*(const GAS f32x4*)((P) + 4 * ln_ + 256 * (j)))
#define THIN_LDL(P, j) (*(const LAS f32x4*)((P) + 4 * ln_ + 256 * (j)))
template <int MODE, int CP, bool DRY = false, bool HGM = false>
__device__ __forceinline__ void thin_rn(Frame& F, const Args& args, const GAS bf16* Y  , const GAS float* Yc  , int nrows_, const GAS float* gpost, const GAS float* modp  , int gate_chunk,
                                        const GAS float* gpre, const GAS float* modh  , int sh_chunk, int sc_chunk) {
    relane(F);
    GAS bf16* X = (GAS bf16*)(WSP(WS_X)); GAS bf16* H = (GAS bf16*)(WSP(WS_H)); GAS bf16* Xo = DRY ? (GAS bf16*)(WSP(WS_REC)) : X;
    const int gw = F.vcu * NWAVES + F.wave, NGW = F.G * NWAVES, nrows = (MODE == 2) ? SEQ : nrows_;
    LAS float* PL = (LAS float*)(F.lds + RING_OFF);
    for (int i = F.tid; i < DM / 4; i += NTHR) {
        if (MODE != 0) { *(LAS f32x4*)(PL + 4 * i) = *(const GAS f32x4*)(modp + gate_chunk * DM + 4 * i); *(LAS f32x4*)(PL + DM + 4 * i) = *(const GAS f32x4*)(gpost + 4 * i); }
        if (MODE != 2) { *(LAS f32x4*)(PL + 2 * DM + 4 * i) = *(const GAS f32x4*)(gpre + 4 * i); *(LAS f32x4*)(PL + 3 * DM + 4 * i) = *(const GAS f32x4*)(modh + sh_chunk * DM + 4 * i); *(LAS f32x4*)(PL + 4 * DM + 4 * i) = *(const GAS f32x4*)(modh + sc_chunk * DM + 4 * i); }
    }
    __syncthreads();
    {
        f32x4 xn[8]; v2u xq[8], yn[8];
        const GAS float* xb0 = AIN(0);
#define THIN_PREF(rr) do { const int ln_ = opqv(F.lane); const int rc_ = (rr) < SEQ ? (rr) : SEQ - 1; if (MODE == 0) { _Pragma("unroll") for (int j = 0; j < 8; ++j) xn[j] = *(const GAS f32x4*)(xb0 + (size_t)rc_ * DM + 4 * ln_ + 256 * j); } \
            else { _Pragma("unroll") for (int j = 0; j < 8; ++j) xq[j] = *(const GAS v2u*)(X + (size_t)rc_ * DM + 4 * ln_ + 256 * j); } \
            if (MODE != 0) { _Pragma("unroll") for (int j = 0; j < 8; ++j) yn[j] = *(const GAS v2u*)(Y + (size_t)rc_ * DM + 4 * ln_ + 256 * j); } } while (0)
        THIN_PREF(gw);
        for (int r = gw; r < SEQ; r += NGW) {
            const int ln_ = opqv(F.lane);
            LAS float* PLr = PL + opqv(0);
            f32x4 x[8]; v2u yp[8];
#pragma unroll
            for (int j = 0; j < 8; ++j) { if (MODE == 0) x[j] = xn[j]; else { x[j] = (f32x4){bflo(xq[j].x), bfhi(xq[j].x), bflo(xq[j].y), bfhi(xq[j].y)}; yp[j] = yn[j]; } }
            THIN_PREF(r + NGW);
            THIN_ROW_BODY(PLr, PLr + DM, PLr + 2 * DM, PLr + 3 * DM, PLr + 4 * DM, THIN_LDL, THIN_YP);
        }
#undef THIN_PREF
    }
    for (int r = SEQ + gw; r < nrows; r += NGW) {
        const int ln_ = opqv(F.lane);
        f32x4 x[8], y[8];
#pragma unroll
        for (int j = 0; j < 8; ++j) { if (MODE == 0) x[j] = *(const GAS f32x4*)(AIN(2) + (size_t)(r - SEQ) * DM + 4 * ln_ + 256 * j);
            else { const v2u t = *(const GAS v2u*)(X + (size_t)r * DM + 4 * ln_ + 256 * j); x[j] = (f32x4){bflo(t.x), bfhi(t.x), bflo(t.y), bfhi(t.y)}; } }
        if (MODE != 0) {
#pragma unroll
            for (int j = 0; j < 8; ++j) y[j] = *(const GAS f32x4*)(Yc + (size_t)(r - SEQ) * DM + 4 * ln_ + 256 * j);
#pragma unroll
            for (int k = 1; k < CP; ++k) { asm volatile("" ::: "memory");
#pragma unroll
                for (int j = 0; j < 8; ++j) y[j] += *(const GAS f32x4*)(Yc + ((size_t)k * CTXL + (r - SEQ)) * DM + 4 * ln_ + 256 * j); }
        }
        const GAS float* gt = modp + NMOD + gate_chunk * DM; const GAS float* shp = modh + NMOD + sh_chunk * DM; const GAS float* scp = modh + NMOD + sc_chunk * DM;
        THIN_ROW_BODY(gt, gpost, gpre, shp, scp, THIN_LDG, THIN_YF);
    }
}
__device__ __forceinline__ float gelu_tanh(float x) { const float u = 1.5957691216f * (x + 0.044715f * x * x * x); return x / (1.0f + __expf(-u)); }
__device__ __forceinline__ void phase_a2(Frame& F, const Args& args) {
    relane(F);
    const GAS bf16* yf = (const GAS bf16*)(WSP(WS_OF)); const GAS bf16* yb = (const GAS bf16*)(WSP(WS_OB)); GAS bf16* z = (GAS bf16*)(WSP(WS_Z));
    LAS unsigned char* L = F.lds + RING_OFF;
    const int lane = F.lane, wave = F.wave, rl = lane >> 1, hf = lane & 1, rr = lane >> 4, c16 = lane & 15;
    int it = 0;
    for (int u = F.vcu; u < (MTOT / 32) * 16; u += F.G, ++it) {
        const int rb = u >> 4, gb = u & 15, g = gb * 8 + wave, r0 = rb * 32;
        const size_t off = ((size_t)g * MTOT + r0 + rl) * 16 + 8 * hf;
        const v4u a = *(const GAS v4u*)(yf + off), b = *(const GAS v4u*)(yb + off); v4u o;
#pragma unroll
        for (int j = 0; j < 4; ++j) { const float lo = gelu_tanh(bflo(a[j]) + bflo(b[j])), hi = gelu_tanh(bfhi(a[j]) + bfhi(b[j])); o[j] = pkbf(lo, hi); }
        LAS unsigned char* T = L + (it & 1) * (32 * 272);
        *(LAS v4u*)(T + rl * 272 + wave * 32 + hf * 16) = o;
        __syncthreads();
        const v4u w = *(const LAS v4u*)(T + (4 * wave + rr) * 272 + c16 * 16);
        *(GAS v4u*)(z + (size_t)(r0 + 4 * wave + rr) * DM + gb * 128 + c16 * 8) = w;
    }
    __syncthreads();
}
__device__ __forceinline__ void phase_a4(Frame& F, const Args& args, const GAS float* onorm) {
    relane(F);
    const GAS bf16* OFp = (const GAS bf16*)(WSP(WS_OF)); const GAS bf16* OBp = (const GAS bf16*)(WSP(WS_OB)); const GAS bf16* SG = (const GAS bf16*)(WSP(WS_SG)); GAS bf16* Z = (GAS bf16*)(WSP(WS_Z));
    const int gw = F.vcu * NWAVES + F.wave, NGW = F.G * NWAVES;
    for (int r = gw; r < MTOT; r += NGW) {
#pragma unroll
        for (int j = 0; j < 8; ++j) { const size_t off = (size_t)r * DM + 4 * F.lane + 256 * j;
            const v2u a = *(const GAS v2u*)(OFp + off), b = *(const GAS v2u*)(OBp + off);
            const f32x4 o = {bflo(a.x) + bflo(b.x), bfhi(a.x) + bfhi(b.x), bflo(a.y) + bflo(b.y), bfhi(a.y) + bfhi(b.y)};
            float s = (o.x * o.x + o.y * o.y) + (o.z * o.z + o.w * o.w);
#pragma unroll
            for (int d = 1; d < 32; d <<= 1) s += xshfl(s, F.lane, d);
            const float rs = 1.0f / sqrtf(s * (1.0f / 128.0f) + NEPS);
            const f32x4 gn = *(const GAS f32x4*)(onorm + 4 * F.lane + 256 * j); const v2u sg = *(const GAS v2u*)(SG + off);
            v2u w; w.x = pkbf(o.x * rs * gn.x * bflo(sg.x), o.y * rs * gn.y * bfhi(sg.x)); w.y = pkbf(o.z * rs * gn.z * bflo(sg.y), o.w * rs * gn.w * bfhi(sg.y));
            *(GAS v2u*)(Z + off) = w; }
    }
}

constexpr int S5_W8 = 0, S5_FB = 32768, S5_V8 = 32768, S5_T8 = 65536, S5_PAR = 98304;
constexpr int S5P_LAMP = 0, S5P_BB = 4608, S5P_CM = 4608 + 8192, S5P_L72 = 4608 + 16384, S5P_DSK = S5P_L72 + 512;
constexpr int S5_NSTEP = 9, S5_SLEN = 72;
__device__ __forceinline__ f32x2 cmul(f32x2 a, f32x2 b) { return (f32x2){a.x * b.x - a.y * b.y, a.x * b.y + a.y * b.x}; }
__device__ __forceinline__ int s5_row(int pos, int d) { if (pos < CTXL) return SEQ + (d ? CTXL - 1 - pos : pos); const int r = pos - CTXL; return d ? SEQ - 1 - r : r; }

__device__ __forceinline__ void phase_s5(Frame& F, const Args& args, int j) {
    relane(F);
    LAS unsigned char* L = F.lds + RING_OFF;
    LAS f32x2* LAMP = (LAS f32x2*)(L + S5_PAR + S5P_LAMP); LAS f32x2* BB = (LAS f32x2*)(L + S5_PAR + S5P_BB); LAS f32x2* CM = (LAS f32x2*)(L + S5_PAR + S5P_CM);
    LAS f32x2* L72 = (LAS f32x2*)(L + S5_PAR + S5P_L72); LAS float* DSK = (LAS float*)(L + S5_PAR + S5P_DSK);
    LAS f32x2* FB = (LAS f32x2*)(L + S5_FB);
    const int tid = F.tid, lane = F.lane, wave = F.wave, nl = lane & 15, q = lane >> 4;
    for (int it = F.vcu; it < 256; it += F.G) {
        const int g = it >> 1, d = it & 1, pi = (j * 2 + d) * 128 + g;
        const GAS bf16* H = (const GAS bf16*)(WSP(WS_H)) + (size_t)g * MTOT * 16;
        GAS bf16* Yo = (GAS bf16*)(opq(F.ws) + (d == 0 ? WS_OF : WS_OB)) + (size_t)g * MTOT * 16;
        if (tid < 64) {
            const int p = tid;
            const float dt = expf(AIN(14)[pi]); const float ar = AIN(12)[pi * 64 + p], ai = AIN(13)[pi * 64 + p];
            const float xr = ar * dt, yi = ai * dt;
            float tt = yi * 0.15915494309189535f; tt -= rintf(tt); const float ang = tt * 6.283185307179586f;
            const float cs = cosf(ang), sn = sinf(ang), ex = expf(xr), em1 = expm1f(xr), sh = sinf(0.5f * ang);
            const f32x2 lam1 = {ex * cs, ex * sn};
            const float nr = em1 * cs - 2.0f * sh * sh, ni = ex * sn;
            const float den = 1.0f / (ar * ar + ai * ai);
            const f32x2 kap = {(nr * ar + ni * ai) * den, (ni * ar - nr * ai) * den};
            f32x2 z = {1.0f, 0.0f};
#pragma unroll
            for (int k = 0; k < 9; ++k) { LAMP[k * 64 + p] = z; if (k < 8) z = cmul(z, lam1); }
            f32x2 z72 = z;
#pragma unroll
            for (int k = 0; k < 8; ++k) z72 = cmul(z72, z);
            L72[p] = z72;
#pragma unroll
            for (int h = 0; h < 16; ++h) { const f32x2 b = {AIN(15)[((size_t)pi * 64 + p) * 16 + h], AIN(16)[((size_t)pi * 64 + p) * 16 + h]}; BB[p * 16 + h] = cmul(kap, b); }
        }
        for (int i = tid; i < 1024; i += NTHR) { CM[i] = (f32x2){AIN(17)[(size_t)pi * 1024 + i], AIN(18)[(size_t)pi * 1024 + i]}; }
        if (tid < 16) DSK[tid] = (d == 0) ? AIN(19)[j * DM + g * 16 + tid] : 0.0f;
        __syncthreads();
#pragma unroll
        for (int i = 0; i < 4; ++i) {
            const int f = (tid >> 6) + 8 * i, mb = f >> 2, ks = f & 3, p = 16 * (mb >> 1) + nl, part = mb & 1, jj = 2 * ks + (q >> 1), h0 = 8 * (q & 1);
            const f32x2 lp = LAMP[(7 - jj) * 64 + p];
            float v[8];
#pragma unroll
            for (int e = 0; e < 8; ++e) { const f32x2 z = cmul(lp, BB[p * 16 + h0 + e]); v[e] = part ? z.y : z.x; }
            v4u o; o.x = pkbf(v[0], v[1]); o.y = pkbf(v[2], v[3]); o.z = pkbf(v[4], v[5]); o.w = pkbf(v[6], v[7]);
            *(LAS v4u*)(L + S5_W8 + (f * 64 + lane) * 16) = o;
        }
        __syncthreads();
        const int n = 16 * wave + nl, pos0 = S5_SLEN * n;
#define S5_LOADU(U, b) do { _Pragma("unroll") for (int ks = 0; ks < 4; ++ks) { int pos = pos0 + 8 * (b) + 2 * ks + (q >> 1); asm volatile("" : "+v"(pos)); const bool ok = pos < MTOT; \
            const int row = s5_row(ok ? pos : 0, d); v4u w = *(const GAS v4u*)(H + (size_t)row * 16 + 8 * (q & 1)); if (!ok) w = (v4u){0u, 0u, 0u, 0u}; U[ks] = __builtin_bit_cast(bf16x8, w); } } while (0)
#define S5_AFRAG(base, f) (*(const LAS bf16x8*)(L + (base) + (f) * 1024 + lofs))
#define S5_MFMA(a, b, c) __builtin_amdgcn_mfma_f32_16x16x32_bf16((a), (b), (c), 0, 0, 0)
#define S5_UPDATE() do { _Pragma("unroll") for (int t = 0; t < 4; ++t) { const LAS f32x4* lp_ = (const LAS f32x4*)(L + S5_PAR + S5P_LAMP + (8 * 64 + 16 * t) * 8 + zofs + q * 32); const f32x4 la_ = lp_[0], lb_ = lp_[1]; \
            const float l8r_[4] = {la_[0], la_[2], lb_[0], lb_[2]}, l8i_[4] = {la_[1], la_[3], lb_[1], lb_[3]}; \
            _Pragma("unroll") for (int r = 0; r < 4; ++r) { \
            const float nr_ = l8r_[r] * Sre[t][r] - l8i_[r] * Sim[t][r] + acc[2 * t][r], ni_ = l8r_[r] * Sim[t][r] + l8i_[r] * Sre[t][r] + acc[2 * t + 1][r]; Sre[t][r] = nr_; Sim[t][r] = ni_; } } } while (0)
        f32x4 Sre[4], Sim[4];
#pragma unroll
        for (int t = 0; t < 4; ++t) { Sre[t] = (f32x4){0.f, 0.f, 0.f, 0.f}; Sim[t] = (f32x4){0.f, 0.f, 0.f, 0.f}; }
        {
            bf16x8 U[4]; S5_LOADU(U, 0);
            for (int b = 0; b < S5_NSTEP; ++b) {
                int lofs = lane * 16; asm volatile("" : "+v"(lofs)); int zofs = 0; asm volatile("" : "+v"(zofs));
                bf16x8 Un[4];
                if (b + 1 < S5_NSTEP) S5_LOADU(Un, b + 1); else { _Pragma("unroll") for (int ks = 0; ks < 4; ++ks) Un[ks] = U[ks]; }
                f32x4 acc[8];
#pragma unroll
                for (int mb = 0; mb < 8; ++mb) { acc[mb] = (f32x4){0.f, 0.f, 0.f, 0.f};
#pragma unroll
                    for (int ks = 0; ks < 4; ++ks) acc[mb] = S5_MFMA(S5_AFRAG(S5_W8, mb * 4 + ks), U[ks], acc[mb]);
                    if (mb & 1) asm volatile("" ::: "memory"); }
                S5_UPDATE();
#pragma unroll
                for (int ks = 0; ks < 4; ++ks) U[ks] = Un[ks];
            }
        }
#pragma unroll
        for (int t = 0; t < 4; ++t) { LAS f32x4* o = (LAS f32x4*)(FB + n * 64 + 16 * t + 4 * q);
            o[0] = (f32x4){Sre[t][0], Sim[t][0], Sre[t][1], Sim[t][1]}; o[1] = (f32x4){Sre[t][2], Sim[t][2], Sre[t][3], Sim[t][3]}; }
        __syncthreads();
        if (wave == 0) {
            const f32x2 l72 = L72[lane]; f32x2 I = {0.f, 0.f};
            for (int n0 = 0; n0 < 128; n0 += 8) {
                f32x2 fv[8];
#pragma unroll
                for (int k = 0; k < 8; ++k) fv[k] = FB[(n0 + k) * 64 + lane];
#pragma unroll
                for (int k = 0; k < 8; ++k) { FB[(n0 + k) * 64 + lane] = I; I = cmul(l72, I) + fv[k]; }
            }
        }
        __syncthreads();
#pragma unroll
        for (int t = 0; t < 4; ++t) { const LAS f32x4* o = (const LAS f32x4*)(FB + n * 64 + 16 * t + 4 * q); const f32x4 a = o[0], b = o[1];
            Sre[t] = (f32x4){a[0], a[2], b[0], b[2]}; Sim[t] = (f32x4){a[1], a[3], b[1], b[3]}; }
        __syncthreads();
#pragma unroll
        for (int i = 0; i < 4; ++i) {
            const int f = (tid >> 6) + 8 * i, im = f >> 2, ks = f & 3, h = nl;
            float v[8];
#pragma unroll
            for (int e = 0; e < 4; ++e) { const int p = 16 * ks + 4 * q + e; const f32x2 z = cmul(CM[h * 64 + p], LAMP[(im + 1) * 64 + p]); v[e] = z.x; v[4 + e] = -z.y; }
            v4u o; o.x = pkbf(v[0], v[1]); o.y = pkbf(v[2], v[3]); o.z = pkbf(v[4], v[5]); o.w = pkbf(v[6], v[7]);
            *(LAS v4u*)(L + S5_V8 + (f * 64 + lane) * 16) = o;
        }
        {
            const int dg = tid >> 6, h = nl, jl = q >> 1, h0 = 8 * (q & 1), lag = dg - jl;
            float v[8];
#pragma unroll
            for (int e = 0; e < 8; ++e) v[e] = 0.f;
            if (lag >= 0) {
                for (int p = 0; p < 64; ++p) { const f32x2 cl = cmul(CM[h * 64 + p], LAMP[lag * 64 + p]);
#pragma unroll
                    for (int e = 0; e < 8; ++e) { const f32x2 b = BB[p * 16 + h0 + e]; v[e] += cl.x * b.x - cl.y * b.y; } }
                if (lag == 0) {
#pragma unroll
                    for (int e = 0; e < 8; ++e) if (h0 + e == h) v[e] += DSK[h];
                }
            }
            v4u o; o.x = pkbf(v[0], v[1]); o.y = pkbf(v[2], v[3]); o.z = pkbf(v[4], v[5]); o.w = pkbf(v[6], v[7]);
            *(LAS v4u*)(L + S5_T8 + (dg * 64 + lane) * 16) = o;
        }
        __syncthreads();
        {
            bf16x8 U[4]; S5_LOADU(U, 0);
            for (int b = 0; b < S5_NSTEP; ++b) {
                int lofs = lane * 16; asm volatile("" : "+v"(lofs)); int zofs = 0; asm volatile("" : "+v"(zofs));
                bf16x8 Un[4];
                if (b + 1 < S5_NSTEP) S5_LOADU(Un, b + 1); else { _Pragma("unroll") for (int ks = 0; ks < 4; ++ks) Un[ks] = U[ks]; }
                bf16x8 BS[4];
#pragma unroll
                for (int ks = 0; ks < 4; ++ks) { v4u w; w.x = pkbf(Sre[ks][0], Sre[ks][1]); w.y = pkbf(Sre[ks][2], Sre[ks][3]); w.z = pkbf(Sim[ks][0], Sim[ks][1]); w.w = pkbf(Sim[ks][2], Sim[ks][3]); BS[ks] = __builtin_bit_cast(bf16x8, w); }
#pragma unroll
                for (int mb = 0; mb < 8; ++mb) {
                    f32x4 y = {0.f, 0.f, 0.f, 0.f};
#pragma unroll
                    for (int ks = 0; ks < 4; ++ks) if (2 * ks <= mb) y = S5_MFMA(S5_AFRAG(S5_T8, mb - 2 * ks), U[ks], y);
#pragma unroll
                    for (int ks = 0; ks < 4; ++ks) y = S5_MFMA(S5_AFRAG(S5_V8, mb * 4 + ks), BS[ks], y);
                    asm volatile("" ::: "memory");
                    int pos = pos0 + 8 * b + mb; asm volatile("" : "+v"(pos));
                    if (pos < MTOT) { v2u o; o.x = pkbf(y[0], y[1]); o.y = pkbf(y[2], y[3]); *(GAS v2u*)(Yo + (size_t)s5_row(pos, d) * 16 + 4 * q) = o; }
                }
                f32x4 acc[8];
#pragma unroll
                for (int mb = 0; mb < 8; ++mb) { acc[mb] = (f32x4){0.f, 0.f, 0.f, 0.f};
#pragma unroll
                    for (int ks = 0; ks < 4; ++ks) acc[mb] = S5_MFMA(S5_AFRAG(S5_W8, mb * 4 + ks), U[ks], acc[mb]);
                    if (mb & 1) asm volatile("" ::: "memory"); }
                S5_UPDATE();
#pragma unroll
                for (int ks = 0; ks < 4; ++ks) U[ks] = Un[ks];
            }
        }
        __syncthreads();
#undef S5_LOADU
#undef S5_AFRAG
#undef S5_MFMA
#undef S5_UPDATE
    }
}
constexpr int HG_QP = 272;
constexpr int HG_KP = 64;
constexpr int HGR_QB = 0, HGR_KE = 8704, HGR_VT = HGR_KE + 128 * HG_KP, HGR_SC = HGR_VT + 128 * HG_KP, HGR_DEC = HGR_SC + 2048;
constexpr int HGL1_KB = 110592  , HGL1_TOT = 128000  ;
constexpr int HGL_RECB = 0  , HGL_OB = 110592  ;
constexpr int HG_OP = 272;
constexpr int HG_NCH = 33, HG_NCHT = 264;
__device__ __forceinline__ int hg_row(int p, int d) { if (p < CTXL) return SEQ + (d ? CTXL - 1 - p : p); int n = p - CTXL; if (d) n = SEQ - 1 - n; return (n & 127) * 64 + (n >> 7); }
#define HG_MFMA(a, b, c) __builtin_amdgcn_mfma_f32_16x16x32_bf16((a), (b), (c), 0, 0, 0)
#define HG_STATE_STEP(RB, vt) do { _Pragma("unroll") for (int mb = 0; mb < 8; ++mb) { \
        const bf16x8 a_ = *(const LAS bf16x8*)(L + (RB) + HGR_KE + (16 * mb + r16) * HG_KP + qd * 16 + zofs); \
        const f32x4 u_ = HG_MFMA(a_, vt, ((f32x4){0.f, 0.f, 0.f, 0.f})); \
        const f32x4 dc_ = *(const LAS f32x4*)(L + (RB) + HGR_DEC + (16 * mb + 4 * qd) * 4 + zofs); S[mb] = dc_ * S[mb] + u_; } } while (0)

constexpr int HGP_REC = HGR_DEC + 512;
constexpr int HGP_KB = 2 * HGP_REC, HGP_TOT = HGP_KB + 2 * 8704, HGP_OB = HGP_TOT + 4096, HGP_END = HGP_OB + 2 * 32 * HG_OP;
static_assert(HGP_END <= RING_BYTES, "HGRN pass LDS");
template <bool FULL>
__device__ __forceinline__ void hg_pass(Frame& F, const Args& args) {
    relane(F);
    LAS unsigned char* L = F.lds + RING_OFF;
    const int wave = F.wave;
    LAS float* TOTS = (LAS float*)(L + HGP_TOT);
#define HG_TIDS() int tid = F.tid; asm volatile("" : "+v"(tid)); const int lane = tid & 63, r16 = lane & 15, qd = lane >> 4, kk = tid & 127, sq = tid >> 7, kl = kk & 31, pcol = (kk & ~31) + 8 * ((kl >> 2) & 3) + 4 * (kl >> 4) + (kl & 3); (void)r16; (void)qd; (void)pcol; (void)lane
    for (int it = F.vcu; it < 256; it += F.G) {
        const int hd = it >> 4, d = (it >> 3) & 1, sg = it & 7, hdd = hd * 2 + d;
        const GAS bf16* LG = (const GAS bf16*)(opq(F.ws) + (d ? WS_LB : WS_LF)) + hd * 128;
        const GAS bf16* Qp = (const GAS bf16*)(WSP(WS_Q)) + hd * 128; const GAS bf16* Vp = (const GAS bf16*)(WSP(WS_V)) + hd * 128;
        GAS bf16* O = (GAS bf16*)(opq(F.ws) + (d ? WS_OB : WS_OF)) + hd * 128;
        f32x4 S[8];
#pragma unroll
        for (int mb = 0; mb < 8; ++mb) S[mb] = (f32x4){0.f, 0.f, 0.f, 0.f};
        if (FULL) { HG_TIDS();
            f32x4 P[8], fv[8], dv[8];
#pragma unroll
            for (int mb = 0; mb < 8; ++mb) P[mb] = (f32x4){1.f, 1.f, 1.f, 1.f};
#define HG_SLOAD(s2_) do { const int sc_ = (s2_) >= 0 ? (s2_) : 0; const GAS f32x4* sp_ = (const GAS f32x4*)(opq(F.ws) + WS_SEGS) + ((size_t)((hdd * 8 + sc_) * 8 + wave) * 8) * 64 + lane; \
                const GAS float* dp_ = (const GAS float*)(opq(F.ws) + WS_SEGD) + (hdd * 8 + sc_) * 128 + 4 * qd; \
                _Pragma("unroll") for (int mb = 0; mb < 8; ++mb) { fv[mb] = sp_[mb * 64]; dv[mb] = *(const GAS f32x4*)(dp_ + 16 * mb); } } while (0)
            HG_SLOAD(sg - 1);
            for (int s2 = sg - 1; s2 >= 0; --s2) {
                f32x4 fc[8], dc[8];
#pragma unroll
                for (int mb = 0; mb < 8; ++mb) { fc[mb] = fv[mb]; dc[mb] = dv[mb]; }
                HG_SLOAD(s2 - 1);
#pragma unroll
                for (int mb = 0; mb < 8; ++mb) { S[mb] += P[mb] * fc[mb]; P[mb] *= dc[mb]; }
            }
#undef HG_SLOAD
        }
        float dsum = 0.f;
        float lf[2][8]; unsigned qv[2][8];
#define HG_INLOAD(cp) do { _Pragma("unroll") for (int h = 0; h < 2; ++h) { int c_ = 2 * (cp) + h; c_ = c_ < HG_NCH ? c_ : HG_NCH - 1; int p0_ = (sg * HG_NCH + c_) * 32 + 8 * sq; asm volatile("" : "+v"(p0_)); \
              \
            const int row0_ = hg_row(p0_, d), step_ = (p0_ < CTXL ? 1 : 64) * (d ? -1 : 1); unsigned off_ = (unsigned)row0_ * DM + kk; const int dstep_ = step_ * DM; \
            _Pragma("unroll") for (int i = 0; i < 8; ++i) { lf[h][i] = bf1(LG[off_]); qv[h][i] = (FULL ? (unsigned)Qp[off_] : 0u) | ((unsigned)Vp[off_] << 16); off_ += dstep_; } } } while (0)
#define HG_OSTORE(c, h) do { int p_ = (sg * HG_NCH + (c)) * 32 + (tid >> 4); asm volatile("" : "+v"(p_)); const v4u o_ = *(const LAS v4u*)(L + HGP_OB + (h) * (32 * HG_OP) + (tid >> 4) * HG_OP + (tid & 15) * 16); \
            *(GAS v4u*)(O + (size_t)hg_row(p_, d) * DM + 8 * (tid & 15)) = o_; } while (0)
        { HG_TIDS(); HG_INLOAD(0); }
        for (int cp = 0; cp < (HG_NCH + 1) / 2; ++cp) {
            HG_TIDS();
            int zofs = 0; asm volatile("" : "+v"(zofs));
            float cs[2][8];
#pragma unroll
            for (int h = 0; h < 2; ++h) { float run = 0.f;
#pragma unroll
                for (int i = 0; i < 8; ++i) { run += lf[h][i]; cs[h][i] = run; }
                TOTS[(h * 4 + sq) * 128 + kk] = run; }
            __syncthreads();
            if (FULL && cp > 0) { HG_OSTORE(2 * cp - 2, 0); HG_OSTORE(2 * cp - 1, 1); }
#pragma unroll
            for (int h = 0; h < 2; ++h) {
                const int RB = h * HGP_REC, KB = HGP_KB + h * (32 * HG_QP);
                const float t0 = TOTS[(h * 4 + 0) * 128 + kk], t1 = TOTS[(h * 4 + 1) * 128 + kk], t2 = TOTS[(h * 4 + 2) * 128 + kk], t3 = TOTS[(h * 4 + 3) * 128 + kk];
                const float offc = (sq > 0 ? t0 : 0.f) + (sq > 1 ? t1 : 0.f) + (sq > 2 ? t2 : 0.f), tot = (t0 + t1) + (t2 + t3), dec = __expf(tot);
                float ke[8];
#pragma unroll
                for (int i = 0; i < 8; ++i) { const float cum = cs[h][i] + offc, kv = 1.0f - __expf(i ? cs[h][i] - cs[h][i - 1] : cs[h][0]);
                    const float kb = kv * __expf(-cum); ke[i] = kb * dec;
                    if (FULL) { const float qb = bflo(qv[h][i]) * __expf(cum);
                        *(LAS bf16*)(L + RB + HGR_QB + (8 * sq + i) * HG_QP + pcol * 2) = (bf16)(pkbf(qb, 0.f) & 0xffffu);
                        *(LAS bf16*)(L + KB + (8 * sq + i) * HG_QP + pcol * 2) = (bf16)(pkbf(kb, 0.f) & 0xffffu); } }
                { v4u o; o.x = pkbf(ke[0], ke[1]); o.y = pkbf(ke[2], ke[3]); o.z = pkbf(ke[4], ke[5]); o.w = pkbf(ke[6], ke[7]);
                  *(LAS v4u*)(L + RB + HGR_KE + kk * HG_KP + sq * 16) = o;
                  v4u w; w.x = (qv[h][0] >> 16) | (qv[h][1] & 0xffff0000u); w.y = (qv[h][2] >> 16) | (qv[h][3] & 0xffff0000u); w.z = (qv[h][4] >> 16) | (qv[h][5] & 0xffff0000u); w.w = (qv[h][6] >> 16) | (qv[h][7] & 0xffff0000u);
                  *(LAS v4u*)(L + RB + HGR_VT + kk * HG_KP + sq * 16) = w; }
                if (sq == 0) { *(LAS float*)(L + RB + HGR_DEC + kk * 4) = dec; if (!FULL && 2 * cp + h < HG_NCH) dsum += tot; }
            }
            HG_INLOAD(cp + 1);
            __syncthreads();
            if (FULL) {
                const int h = wave >> 2, w4 = wave & 3, mblk = w4 >> 1, nblk = w4 & 1; const int RB = h * HGP_REC, KB = HGP_KB + h * (32 * HG_QP);
                f32x4 acc = {0.f, 0.f, 0.f, 0.f};
#pragma unroll
                for (int ks = 0; ks < 4; ++ks) { const bf16x8 a = *(const LAS bf16x8*)(L + RB + HGR_QB + (16 * mblk + r16) * HG_QP + (32 * ks + 8 * qd) * 2 + zofs);
                    const bf16x8 b = *(const LAS bf16x8*)(L + KB + (16 * nblk + r16) * HG_QP + (32 * ks + 8 * qd) * 2 + zofs); acc = HG_MFMA(a, b, acc); }
#pragma unroll
                for (int r = 0; r < 4; ++r) { const int cc = 16 * mblk + 4 * qd + r, ss = 16 * nblk + r16; const float v = ss <= cc ? acc[r] : 0.f;
                    *(LAS bf16*)(L + RB + HGR_SC + (cc * 32 + ss) * 2) = (bf16)(pkbf(v, 0.f) & 0xffffu); }
                __syncthreads();
            }
#pragma unroll
            for (int h = 0; h < 2; ++h) if (2 * cp + h < HG_NCH) { const int RB = h * HGP_REC;
                const bf16x8 vt = *(const LAS bf16x8*)(L + RB + HGR_VT + (16 * wave + r16) * HG_KP + qd * 16 + zofs);
                if (FULL) {
                    bf16x8 BS[4];
#pragma unroll
                    for (int ks = 0; ks < 4; ++ks) { v4u w; w.x = pkbf(S[2 * ks][0], S[2 * ks][1]); w.y = pkbf(S[2 * ks][2], S[2 * ks][3]); w.z = pkbf(S[2 * ks + 1][0], S[2 * ks + 1][1]); w.w = pkbf(S[2 * ks + 1][2], S[2 * ks + 1][3]);
                        BS[ks] = __builtin_bit_cast(bf16x8, w); }
#pragma unroll
                    for (int mblk = 0; mblk < 2; ++mblk) {
                        f32x4 o = {0.f, 0.f, 0.f, 0.f};
                        { const bf16x8 a = *(const LAS bf16x8*)(L + RB + HGR_SC + (16 * mblk + r16) * 64 + qd * 16 + zofs); o = HG_MFMA(a, vt, o); }
#pragma unroll
                        for (int ks = 0; ks < 4; ++ks) { const bf16x8 a = *(const LAS bf16x8*)(L + RB + HGR_QB + (16 * mblk + r16) * HG_QP + (32 * ks + 8 * qd) * 2 + zofs); o = HG_MFMA(a, BS[ks], o); }
#pragma unroll
                        for (int r = 0; r < 4; ++r) *(LAS bf16*)(L + HGP_OB + h * (32 * HG_OP) + (16 * mblk + 4 * qd + r) * HG_OP + (16 * wave + r16) * 2) = (bf16)(pkbf(o[r], 0.f) & 0xffffu);
                    }
                }
                HG_STATE_STEP(RB, vt); }
        }
        __syncthreads();
        if (FULL) { HG_TIDS(); HG_OSTORE(HG_NCH - 1, 0); }
        else { HG_TIDS(); GAS f32x4* sp = (GAS f32x4*)(opq(F.ws) + WS_SEGS) + ((size_t)((hdd * 8 + sg) * 8 + wave) * 8) * 64 + lane;
#pragma unroll
          for (int mb = 0; mb < 8; ++mb) sp[mb * 64] = S[mb];
          if (sq == 0) ((GAS float*)(opq(F.ws) + WS_SEGD))[(hdd * 8 + sg) * 128 + kk] = __expf(dsum); }
        __syncthreads();
#undef HG_INLOAD
#undef HG_OSTORE
    }
#undef HG_TIDS
}
__device__ __forceinline__ void phase_hg_r1(Frame& F, const Args& args) { hg_pass<false>(F, args); }
__device__ __forceinline__ void phase_hg_r2(Frame& F, const Args& args) { hg_pass<true>(F, args); }
template <int MT, int NB, int KS, int WR, class Epi>
__device__ __forceinline__ void ctx_gemm(Frame& F, const GAS bf16* A, const GAS bf16* Bt, int K, int ncolt, const Epi& E) {
    constexpr int WC = 8 / WR, MB = MT / (16 * WR), NBW = NB / WC, RT = 256 / MT, PITCH = 144, APIECES = MT * 8, BPIECES = NB * 16 * 8, NA = (APIECES + NTHR - 1) / NTHR, NBL = (BPIECES + NTHR - 1) / NTHR;
    constexpr int ABYTES = MT * PITCH, BBYTES = NB * 16 * PITCH, BUF = ABYTES + BBYTES;
    static_assert(3 * BUF <= RING_BYTES && NB % WC == 0 && MT % (16 * WR) == 0, "ctx_gemm geometry");
    relane(F);
    LAS unsigned char* L = F.lds + RING_OFF;
    const int tid = F.tid, lane = F.lane, wave = F.wave, r16 = lane & 15, qd = lane >> 4, wr = wave / WC, wc = wave % WC;
    const int units = RT * ncolt * KS, klen = K / KS, nkt = klen / 64;
    for (int u = F.vcu; u < units; u += F.G) {
        const int ks = u % KS, t = u / KS, rt = t % RT, ct = t / RT;
        const int rowb = rt * MT;
        const GAS bf16* ga[NA]; const GAS bf16* gb[NBL]; int la[NA], lb[NBL]; bool oka[NA], okb[NBL];
#pragma unroll
        for (int j = 0; j < NA; ++j) { const int i = tid + NTHR * j, row = i >> 3, ch = i & 7; oka[j] = i < APIECES; const int rr = oka[j] ? row : 0; ga[j] = A + (size_t)(rowb + rr) * K + ks * klen + 8 * ch; la[j] = rr * PITCH + ch * 16; }
#pragma unroll
        for (int j = 0; j < NBL; ++j) { const int i = tid + NTHR * j, row = i >> 3, ch = i & 7; okb[j] = i < BPIECES; const int rr = okb[j] ? row : 0;
            gb[j] = Bt + (size_t)E.brow(ct, rr >> 4, rr & 15) * K + ks * klen + 8 * ch; lb[j] = ABYTES + rr * PITCH + ch * 16; }
        v4u ra[2][NA], rb[2][NBL];
#define CG_LOAD(P, kt) do { _Pragma("unroll") for (int j = 0; j < NA; ++j) ra[P][j] = *(const GAS v4u*)(ga[j] + (kt) * 64); _Pragma("unroll") for (int j = 0; j < NBL; ++j) rb[P][j] = *(const GAS v4u*)(gb[j] + (kt) * 64); } while (0)
#define CG_STORE(P, bo) do { _Pragma("unroll") for (int j = 0; j < NA; ++j) if (oka[j]) *(LAS v4u*)(L + (bo) + la[j]) = ra[P][j]; _Pragma("unroll") for (int j = 0; j < NBL; ++j) if (okb[j]) *(LAS v4u*)(L + (bo) + lb[j]) = rb[P][j]; } while (0)
#define CG_COMPUTE(bo) do { _Pragma("unroll") for (int k2 = 0; k2 < 2; ++k2) { bf16x8 a[MB], b[NBW]; \
            _Pragma("unroll") for (int mb = 0; mb < MB; ++mb) a[mb] = *(const LAS bf16x8*)(L + (bo) + (wr * (MT / WR) + 16 * mb + r16) * PITCH + (4 * k2 + qd) * 16); \
            _Pragma("unroll") for (int nb = 0; nb < NBW; ++nb) b[nb] = *(const LAS bf16x8*)(L + (bo) + ABYTES + (16 * (wc + WC * nb) + r16) * PITCH + (4 * k2 + qd) * 16); \
            _Pragma("unroll") for (int mb = 0; mb < MB; ++mb) _Pragma("unroll") for (int nb = 0; nb < NBW; ++nb) acc[mb][nb] = __builtin_amdgcn_mfma_f32_16x16x32_bf16(a[mb], b[nb], acc[mb][nb], 0, 0, 0); } } while (0)
        f32x4 acc[MB][NBW];
#pragma unroll
        for (int mb = 0; mb < MB; ++mb)
#pragma unroll
            for (int nb = 0; nb < NBW; ++nb) acc[mb][nb] = (f32x4){0.f, 0.f, 0.f, 0.f};
        CG_LOAD(0, 0); CG_LOAD(1, 1); CG_STORE(0, 0);
        __syncthreads();
        for (int kt = 0; kt < nkt; kt += 2) {
            { const int b0 = (kt % 3) * BUF, b1 = ((kt + 1) % 3) * BUF;
              if (kt + 2 < nkt) CG_LOAD(0, kt + 2);
              CG_COMPUTE(b0);
              CG_STORE(1, b1);
              __syncthreads(); }
            { const int b1 = ((kt + 1) % 3) * BUF, b2 = ((kt + 2) % 3) * BUF;
              if (kt + 3 < nkt) CG_LOAD(1, kt + 3);
              CG_COMPUTE(b1);
              if (kt + 2 < nkt) CG_STORE(0, b2);
              __syncthreads(); }
        }
#undef CG_LOAD
#undef CG_STORE
#undef CG_COMPUTE
        const int row0 = rowb + wr * (MT / WR);
#pragma unroll
        for (int mb = 0; mb < MB; ++mb) E.store(acc[mb], row0 + 16 * mb + 4 * qd, ct, ks, r16, wc);
    }
}
struct CtxRelu2 {
    GAS bf16* O;
    __device__ __forceinline__ int brow(int ct, int nb, int r) const { return 64 * ct + 16 * nb + r; }
    __device__ __forceinline__ void store(const f32x4 (&acc)[2], int row, int ct, int ks, int r, int wc) const {
#pragma unroll
        for (int t = 0; t < 2; ++t)
#pragma unroll
            for (int g = 0; g < 4; ++g) { const float v = fmaxf(acc[t][g], 0.f); O[(size_t)(SEQ + row + g) * HID + 64 * ct + 16 * (wc + 2 * t) + r] = (bf16)(pkbf(v * v, 0.f) & 0xffffu); }
    }
};
struct CtxGlu {
    GAS float* Y;
    __device__ __forceinline__ int brow(int ct, int nb, int r) const { const int c = 32 * ct + 16 * (nb & 1) + r; return 256 * (c >> 7) + (c & 127) + 128 * (nb >> 1); }
    __device__ __forceinline__ void store(const f32x4 (&acc)[2], int row, int ct, int ks, int r, int wc) const {
#pragma unroll
        for (int g = 0; g < 4; ++g) Y[(size_t)(row + g) * DM + 32 * ct + 16 * wc + r] = acc[0][g] * pg8::sigmoid_f(acc[1][g]);
    }
};
struct CtxPart {
    GAS float* YP;
    __device__ __forceinline__ int brow(int ct, int nb, int r) const { return 64 * ct + 16 * nb + r; }
    __device__ __forceinline__ void store(const f32x4 (&acc)[2], int row, int ct, int ks, int r, int wc) const {
#pragma unroll
        for (int t = 0; t < 2; ++t)
#pragma unroll
            for (int g = 0; g < 4; ++g) YP[((size_t)ks * CTXL + row + g) * DM + 64 * ct + 16 * (wc + 2 * t) + r] = acc[t][g];
    }
};
struct CtxHgIn {
    GAS bf16* Q; size_t hstride; GAS bf16* LF; size_t fstride; const GAS float* lbv;
    __device__ __forceinline__ int brow(int ct, int nb, int r) const { return 80 * ct + 16 * nb + r; }
    __device__ __forceinline__ void store(const f32x4 (&acc)[5], int row, int ct, int ks, int r, int  ) const {
#pragma unroll
        for (int nb = 0; nb < 5; ++nb) { const int col = 80 * ct + 16 * nb + r, typ = col >> 11, cc = col & 2047;
            if (typ == 2 || typ == 3) { const float lb = lbv[(typ - 2) * 2048 + cc], llb = lb > 0.f ? logf(lb) : 0.f; GAS bf16* O = LF + (size_t)(typ - 2) * fstride;
#pragma unroll
                for (int g = 0; g < 4; ++g) O[(size_t)(SEQ + row + g) * DM + cc] = (bf16)(pkbf(pg8::logf_gate(acc[nb][g], lb, llb), 0.f) & 0xffffu);
            } else { GAS bf16* O = Q + (size_t)((typ >> 2) * 2 + (typ & 1)) * hstride;
#pragma unroll
                for (int g = 0; g < 4; ++g) { const float v = acc[nb][g], w = typ == 1 ? v : pg8::silu_f(v); O[(size_t)(SEQ + row + g) * DM + cc] = (bf16)(pkbf(w, 0.f) & 0xffffu); } }
        }
    }
};

#if MK_PER_PHASE
#define IN(k) (args.ph_lo <= (k) && (k) < args.ph_hi)
#else
#define IN(k) true
#endif
#define SEAM(k) do { if (IN(k) && IN((k) + 1)) { if (!MK_PER_PHASE) xcd_barrier(bar); } } while (0)
#define MOD ((const GAS float*)(WSP(WS_MOD)))
#define Hb ((const GAS bf16*)(WSP(WS_H)))
#define Zb ((const GAS bf16*)(WSP(WS_Z)))
#define HIDb ((const GAS bf16*)(WSP(WS_HID)))
#define Y1 ((GAS bf16*)(WSP(WS_Y1)))
#define Y2 ((GAS bf16*)(WSP(WS_Y2)))
#define YP1 ((GAS float*)(WSP(WS_YP1)))
#define YP2 ((GAS float*)(WSP(WS_YP2)))
#define CTXLIVE (pair == 0)

template <int pair>
__device__ __forceinline__ void layer_pair(Frame& F, const Args& args, const XcdBarrier& bar) {
        const int base = 2 + 16 * pair, l0 = 2 * pair, l1 = l0 + 1, j = pair;
        relane(F); F.ws = opq(F.ws);
#define mod0 (MOD + (size_t)l0 * 2 * NMOD)
#define mod1 (MOD + (size_t)l1 * 2 * NMOD)
#define modp (MOD + (size_t)(l0 - 1) * 2 * NMOD)
        if (IN(base + 0)) {
            if (pair == 0) thin_rn<0, 1, false, true>(F, args, nullptr, nullptr, MTOT, nullptr, nullptr, 0, AIN(6) + l0 * DM, mod0, 0, 1);
            else { if (REP_RN) { thin_rn<1, 4, true, true>(F, args, Y2, YP2, MTOT, AIN(9) + (l0 - 1) * DM, modp, 5, AIN(6) + l0 * DM, mod0, 0, 1); } thin_rn<1, 4, false, true>(F, args, Y2, YP2, MTOT, AIN(9) + (l0 - 1) * DM, modp, 5, AIN(6) + l0 * DM, mod0, 0, 1); }
        } SEAM(base + 0);
        if (IN(base + 1)) {
            for (int rep = 0; rep <= REP_S5; ++rep) phase_s5(F, args, j);
        } SEAM(base + 1);
        if (IN(base + 2)) { for (int rep = 0; rep <= REP_THIN; ++rep) phase_a2(F, args); } SEAM(base + 2);
        if (IN(base + 3)) {
            pg8::Gemm g{(gen_cbf)(Zb), (gen_cbf)((const GAS bf16*)(WSP(WS_WGLU)) + (size_t)j * 4096 * DM), SEQ, 4096, DM}; pg8::StaticOrder S; S.init(SEQ, 4096, F.G, PG_CID, WGM_GLU);
            pg8::EpiGlu E{Y1, DM};
            for (int rep = 0; rep <= REP_GEMM + REP_GGLU; ++rep)
            pg8::gemm_phase<pg8::EpiGlu, pg8::StaticOrder, PG_ALIGN, PG_SP2>(F.lds + RING_OFF, g, S, E);
            { CtxGlu CE{YP1}; for (int rep = 0; rep <= REP_CTX; ++rep) ctx_gemm<64, 4, 1, 4>(F, Zb + (size_t)SEQ * DM, (const GAS bf16*)(WSP(WS_WGLU)) + (size_t)j * 4096 * DM, DM, 64, CE); }
        } SEAM(base + 3);
        if (IN(base + 4)) { if (REP_RN) { thin_rn<1, 1, true>(F, args, Y1, YP1, MTOT, AIN(7) + l0 * DM, mod0, 2, AIN(8) + l0 * DM, mod0, 3, 4); } thin_rn<1, 1>(F, args, Y1, YP1, MTOT, AIN(7) + l0 * DM, mod0, 2, AIN(8) + l0 * DM, mod0, 3, 4); } SEAM(base + 4);
        if (IN(base + 5)) {
            pg8::Gemm g{(gen_cbf)(Hb), (gen_cbf)((const GAS bf16*)(WSP(WS_W1)) + (size_t)l0 * HID * DM), SEQ, HID, DM}; pg8::StaticOrder S; S.init(SEQ, HID, F.G, PG_CID, WGM_IN);
            pg8::EpiRelu2 E{(GAS bf16*)(WSP(WS_HID)), HID};
            for (int rep = 0; rep <= REP_GEMM + REP_GIN; ++rep)
            pg8::gemm_phase<pg8::EpiRelu2, pg8::StaticOrder, PG_ALIGN, PG_SP2>(F.lds + RING_OFF, g, S, E);
            { CtxRelu2 CE{(GAS bf16*)(WSP(WS_HID))}; for (int rep = 0; rep <= REP_CTX; ++rep) ctx_gemm<128, 4, 1, 4>(F, Hb + (size_t)SEQ * DM, (const GAS bf16*)(WSP(WS_W1)) + (size_t)l0 * HID * DM, DM, 128, CE); }
        } SEAM(base + 5);
        if (IN(base + 6)) {
            pg8::Gemm g{(gen_cbf)(HIDb), (gen_cbf)((const GAS bf16*)(WSP(WS_W2)) + (size_t)l0 * DM * HID), SEQ, DM, HID}; pg8::StaticOrder S; S.init(SEQ, DM, F.G, PG_CID, WGM_OUT);
            pg8::EpiBf16P E{Y2, DM};
            for (int rep = 0; rep <= REP_GEMM + REP_GOUT; ++rep)
            pg8::gemm_phase<pg8::EpiBf16P, pg8::StaticOrder, PG_ALIGN, PG_SP2>(F.lds + RING_OFF, g, S, E);
            { CtxPart CE{YP2}; for (int rep = 0; rep <= REP_CTX; ++rep) ctx_gemm<128, 4, 4, 4>(F, HIDb + (size_t)SEQ * HID, (const GAS bf16*)(WSP(WS_W2)) + (size_t)l0 * DM * HID, HID, 32, CE); }
        } SEAM(base + 6);
        if (IN(base + 7)) { if (REP_RN) { thin_rn<1, 4, true>(F, args, Y2, YP2, MTOT, AIN(9) + l0 * DM, mod0, 5, AIN(6) + l1 * DM, mod1, 0, 1); } thin_rn<1, 4>(F, args, Y2, YP2, MTOT, AIN(9) + l0 * DM, mod0, 5, AIN(6) + l1 * DM, mod1, 0, 1); } SEAM(base + 7);
        if (IN(base + 8)) {
            pg8::Gemm g{(gen_cbf)(Hb), (gen_cbf)((const GAS bf16*)(WSP(WS_WIN)) + (size_t)j * 10240 * DM), SEQ, 10240, DM}; pg8::StaticOrder S; S.init(SEQ, 10240, F.G, PG_CID, WGM_HG);
            pg8::EpiHgIn E{(GAS bf16*)(WSP(WS_Q)), (WS_V - WS_Q) / 2, (GAS bf16*)(WSP(WS_LF)), (WS_LB - WS_LF) / 2, (const GAS float*)(WSP(WS_LBV)) + (size_t)j * 2 * DM};
            static_assert(WS_SG - WS_V == WS_V - WS_Q, "Q|V|SG equally spaced");
            for (int rep = 0; rep <= REP_GEMM + REP_GHG; ++rep)
            pg8::gemm_phase<pg8::EpiHgIn, pg8::StaticOrder, PG_ALIGN, PG_SP2>(F.lds + RING_OFF, g, S, E);
#if defined(REP_GHG_CHEAP)
            { pg8::EpiBf16P E2{(GAS bf16*)(WSP(WS_REC)), 10240}; pg8::gemm_phase<pg8::EpiBf16P, pg8::StaticOrder, PG_ALIGN, PG_SP2>(F.lds + RING_OFF, g, S, E2); }
#endif
            { CtxHgIn CE{(GAS bf16*)(WSP(WS_Q)), (WS_V - WS_Q) / 2, (GAS bf16*)(WSP(WS_LF)), (WS_LB - WS_LF) / 2, (const GAS float*)(WSP(WS_LBV)) + (size_t)j * 2 * DM}; for (int rep = 0; rep <= REP_CTX; ++rep) ctx_gemm<128, 5, 1, 8>(F, Hb + (size_t)SEQ * DM, (const GAS bf16*)(WSP(WS_WIN)) + (size_t)j * 10240 * DM, DM, 128, CE); }
        } SEAM(base + 8);
        for (int rep = 0; rep <= REP_HG; ++rep) {
        for (int rep1 = 0; rep1 <= REP_R1; ++rep1) { if (IN(base + 9)) { phase_hg_r1(F, args); } SEAM(base + 9); }
        for (int rep2 = 0; rep2 <= REP_R2; ++rep2) { if (IN(base + 10)) { phase_hg_r2(F, args); } SEAM(base + 10); }
        }
        if (IN(base + 11)) { for (int rep = 0; rep <= REP_THIN; ++rep) phase_a4(F, args, AIN(23) + j * DM); } SEAM(base + 11);
        if (IN(base + 12)) {
            pg8::Gemm g{(gen_cbf)(Zb), (gen_cbf)((const GAS bf16*)(WSP(WS_WOUT)) + (size_t)j * DM * DM), SEQ, DM, DM}; pg8::StaticOrder S; S.init(SEQ, DM, F.G, PG_CID, WGM_OP);
            pg8::EpiBf16P E{Y1, DM};
            for (int rep = 0; rep <= REP_GEMM + REP_GOUT; ++rep)
            pg8::gemm_phase<pg8::EpiBf16P, pg8::StaticOrder, PG_ALIGN, PG_SP2>(F.lds + RING_OFF, g, S, E);
            if (CTXLIVE) { CtxPart CE{YP1}; for (int rep = 0; rep <= REP_CTX; ++rep) ctx_gemm<128, 4, 4, 4>(F, Zb + (size_t)SEQ * DM, (const GAS bf16*)(WSP(WS_WOUT)) + (size_t)j * DM * DM, DM, 32, CE); }
        } SEAM(base + 12);
        if (IN(base + 13)) { if (REP_RN) { thin_rn<1, 4, true>(F, args, Y1, YP1, (pair == 1 ? SEQ : MTOT), AIN(7) + l1 * DM, mod1, 2, AIN(8) + l1 * DM, mod1, 3, 4); } thin_rn<1, 4>(F, args, Y1, YP1, (pair == 1 ? SEQ : MTOT), AIN(7) + l1 * DM, mod1, 2, AIN(8) + l1 * DM, mod1, 3, 4); } SEAM(base + 13);
        if (IN(base + 14)) {
            pg8::Gemm g{(gen_cbf)(Hb), (gen_cbf)((const GAS bf16*)(WSP(WS_W1)) + (size_t)l1 * HID * DM), SEQ, HID, DM}; pg8::StaticOrder S; S.init(SEQ, HID, F.G, PG_CID, WGM_IN);
            pg8::EpiRelu2 E{(GAS bf16*)(WSP(WS_HID)), HID};
            for (int rep = 0; rep <= REP_GEMM + REP_GIN; ++rep)
            pg8::gemm_phase<pg8::EpiRelu2, pg8::StaticOrder, PG_ALIGN, PG_SP2>(F.lds + RING_OFF, g, S, E);
            if (CTXLIVE) { CtxRelu2 CE{(GAS bf16*)(WSP(WS_HID))}; for (int rep = 0; rep <= REP_CTX; ++rep) ctx_gemm<128, 4, 1, 4>(F, Hb + (size_t)SEQ * DM, (const GAS bf16*)(WSP(WS_W1)) + (size_t)l1 * HID * DM, DM, 128, CE); }
        } SEAM(base + 14);
        if (IN(base + 15)) {
            pg8::Gemm g{(gen_cbf)(HIDb), (gen_cbf)((const GAS bf16*)(WSP(WS_W2)) + (size_t)l1 * DM * HID), SEQ, DM, HID}; pg8::StaticOrder S; S.init(SEQ, DM, F.G, PG_CID, WGM_OUT);
            pg8::EpiBf16P E{Y2, DM};
            for (int rep = 0; rep <= REP_GEMM + REP_GOUT; ++rep)
            pg8::gemm_phase<pg8::EpiBf16P, pg8::StaticOrder, PG_ALIGN, PG_SP2>(F.lds + RING_OFF, g, S, E);
            if (CTXLIVE) { CtxPart CE{YP2}; for (int rep = 0; rep <= REP_CTX; ++rep) ctx_gemm<128, 4, 4, 4>(F, HIDb + (size_t)SEQ * HID, (const GAS bf16*)(WSP(WS_W2)) + (size_t)l1 * DM * HID, HID, 32, CE); }
        } SEAM(base + 15);
    }
__global__ void __launch_bounds__(NTHR, 2) mk_fwd(Args args) {
    extern __shared__ __attribute__((aligned(16))) unsigned char lds[];
    Frame F;
    F.lds = (LAS unsigned char*)lds;
    F.MISC = (volatile LAS unsigned*)(F.lds + MISC_OFF);
    F.tid = threadIdx.x; F.lane = F.tid & 63; F.wave = __builtin_amdgcn_readfirstlane(F.tid >> 6);
    F.G = gridDim.x; { const int bx = blockIdx.x; F.vcu = (F.G % 8 == 0) ? (bx % 8) * (F.G / 8) + bx / 8 : bx; }
    F.ws = (GAS unsigned char*)args.ws; F.out = (GAS float*)args.out;
    for (int u = F.tid; u < (LDS_BYTES - LDSCTL_OFF) / 4; u += NTHR) ((LAS unsigned*)(F.lds + LDSCTL_OFF))[u] = 0u;
    __syncthreads();
    gen_u32p barw = (gen_u32p)((GAS unsigned*)(WSP(WS_CTL)) + CW_BAR);
    XcdBarrier bar; bar.bar = barw; bar.x = 0; bar.st = nullptr;
    if (!MK_PER_PHASE) bar = xcd_barrier_post(barw, F.MISC + 8);
    if (IN(0)) { for (int rep = 0; rep <= REP_P0; ++rep) phase_p0(F, args); } SEAM(0);
    for (int rep = 0; rep < REP_BAR; ++rep) xcd_barrier(bar);
    if (IN(1)) { phase_p1(F, args); } SEAM(1);

    layer_pair<0>(F, args, bar);
    layer_pair<1>(F, args, bar);
    if (IN(34)) { thin_rn<2, 1>(F, args, Y2, nullptr, SEQ, AIN(9) + 3 * DM, MOD + (size_t)3 * 2 * NMOD, 5, nullptr, nullptr, 0, 0); }
#undef IN
#undef SEAM
}

extern "C" void kernel_launch(void* const* d_in, const int* in_sizes, int n_in, void* d_out, int out_size, void* d_ws, size_t ws_size, hipStream_t stream) {
    static int grid = 0;
    if (grid == 0) {
        if (n_in != 25 || out_size != SEQ * DM || ws_size < WS_END) { fprintf(stderr, "kernel_launch: unexpected shapes (n_in %d out %d ws %zu need %zu)\n", n_in, out_size, ws_size, (size_t)WS_END); grid = -1; return; }
        int dev = 0, cus = 0, per_cu = 0;
        if (hipGetDevice(&dev) != hipSuccess || hipDeviceGetAttribute(&cus, hipDeviceAttributeMultiprocessorCount, dev) != hipSuccess) { grid = -1; return; }
        if (hipFuncSetAttribute((const void*)mk_fwd, hipFuncAttributeMaxDynamicSharedMemorySize, LDS_BYTES) != hipSuccess) { fprintf(stderr, "kernel_launch: hipFuncSetAttribute failed\n"); grid = -1; return; }
        if (hipOccupancyMaxActiveBlocksPerMultiprocessor(&per_cu, (const void*)mk_fwd, NTHR, LDS_BYTES) != hipSuccess || per_cu < 1) { fprintf(stderr, "kernel_launch: occupancy query says %d\n", per_cu); (void)hipGetLastError(); }
        grid = cus;
    }
    if (grid < 0) return;
    if (hipMemsetAsync((char*)d_ws + WS_CTL, 0, CTL_ZERO_BYTES, stream) != hipSuccess) return;
    Args a{};
    for (int i = 0; i < 25; ++i) a.in[i] = (const float*)d_in[i];
    a.out = (float*)d_out; a.ws = (unsigned char*)d_ws;
#if MK_PER_PHASE
    for (int p = 0; p < NPHASES; ++p) {  a.ph_lo = p; a.ph_hi = p + 1; hipLaunchKernelGGL(mk_fwd, dim3(grid), dim3(NTHR), LDS_BYTES, stream, a); }
#else
    a.ph_lo = 0; a.ph_hi = NPHASES; hipLaunchKernelGGL(mk_fwd, dim3(grid), dim3(NTHR), LDS_BYTES, stream, a);
#endif
}
```

```cpp
#include <hip/hip_runtime.h>
#include <cstdio>
#include <cstdint>
#define GAS __attribute__((address_space(1)))
#ifndef PG_WGM
#define PG_WGM 8
#endif
namespace pg8 {
#define PG8_LAS __attribute__((address_space(3)))
typedef unsigned short bf16_t;
typedef short bf16x8 __attribute__((ext_vector_type(8)));
typedef float f32x4 __attribute__((ext_vector_type(4)));
typedef unsigned u32x4 __attribute__((ext_vector_type(4)));
constexpr int BM = 256, BK = 64, HALF = 128, HTB = HALF * BK * 2  , STAGE_BYTES = 8 * HTB, NXCD = 8, WGM = PG_WGM;

__host__ __device__ __forceinline__ int lds_byte(int r, int c) { const int st = (r >> 4) * 2 + (c >> 5), rr = r & 15, cc = c & 31, ob = rr * 64 + cc * 2; return st * 1024 + (ob ^ (((ob >> 9) & 1) << 5)); }
__host__ __device__ __forceinline__ void stage_rc(int b, int& R, int& C) { const int st = b / 1024, sb = b % 1024, swz = sb ^ (((sb >> 9) & 1) << 5); R = (st >> 1) * 16 + swz / 64; C = (st & 1) * 32 + (swz % 64) / 2; }
__host__ __device__ __forceinline__ int perm32(int rho) { const int n = rho >> 4, i = rho & 15; return 8 * (i >> 2) + 4 * n + (i & 3); }

struct Unit { int pm, pn; };
struct Gemm { const bf16_t* A; const bf16_t* Bt; int M, N, K; };

struct StaticOrder {
    int nM, nN, nwg, G, c, wgm;
    __host__ __device__ void init(int M, int N, int G_, int c_, int wgm_ = WGM) { nM = M / BM; nN = N / BM; nwg = nM * nN; G = G_; c = c_; wgm = wgm_; }
    __host__ __device__ bool next(int i, Unit& u) const {
        const long L = (long)i * G + c; if (L >= nwg) return false;
        int wgid = (int)L; { const int q = nwg / NXCD, r = nwg % NXCD, xcd = wgid % NXCD, off = wgid / NXCD; wgid = (xcd < r ? xcd * (q + 1) : r * (q + 1) + (xcd - r) * q) + off; }
        const int nig = wgm * nN, gid = wgid / nig, fm = gid * wgm, gsz = (nM - fm) < wgm ? (nM - fm) : wgm;
        u.pm = fm + ((wgid % nig) % gsz); u.pn = (wgid % nig) / gsz; return true;
    }
    __device__ __forceinline__ void a_ready(const Unit&) const {}
    __device__ __forceinline__ void done(const Unit&) const {}
};

__device__ __forceinline__ unsigned cvt_pk_bf16(float lo, float hi) { unsigned r; asm volatile("v_cvt_pk_bf16_f32 %0, %1, %2" : "=v"(r) : "v"(lo), "v"(hi)); return r; }
typedef float f32x2 __attribute__((ext_vector_type(2)));
#ifndef EPI_NT
#define EPI_NT 0
#endif
#if EPI_NT
#define EPI_ST(p, v) __builtin_nontemporal_store((v), (p))
#else
#define EPI_ST(p, v) (*(p) = (v))
#endif
__device__ __forceinline__ float sigmoid_f(float x) { return __builtin_amdgcn_rcpf(1.0f + __expf(-x)); }
__device__ __forceinline__ float silu_f(float x) { return x * sigmoid_f(x); }
__device__ __forceinline__ float logf_gate(float z, float lb, float  ) {
    const float e = __expf(-fabsf(z));
    const float r = __builtin_amdgcn_rcpf(1.0f + e);
    const float sg = z >= 0.f ? r : e * r;
    const float a = fminf(z, 0.0f) - __logf(1.0f + e);
    const float b = __logf(lb + (1.0f - lb) * sg);
    return lb > 0.0f ? b : a;
}

struct EpiF32 {
    static constexpr bool PERM = false, AFTER_DRAIN = false;
    GAS float* C; int ldc;
    __device__ __forceinline__ void operator()(const f32x4 (&acc)[2][2][4][2], const Unit& u, int wr, int wc, int fr, int fq) const {
        const int row0 = u.pm * BM + wr * 64 + fr, col0 = u.pn * BM + wc * 32 + 4 * fq;
#pragma unroll
        for (int ai = 0; ai < 2; ++ai)
#pragma unroll
            for (int m = 0; m < 4; ++m) { GAS float* rowp = C + (size_t)(row0 + ai * HALF + m * 16) * ldc + col0;
#pragma unroll
                for (int bj = 0; bj < 2; ++bj)
#pragma unroll
                    for (int n = 0; n < 2; ++n) *(GAS f32x4*)(rowp + bj * HALF + n * 16) = acc[ai][bj][m][n]; }
    }
};
struct EpiRelu2 {
    static constexpr bool PERM = true, AFTER_DRAIN = false;
    GAS bf16_t* O; int ldc;
    __device__ __forceinline__ void operator()(const f32x4 (&acc)[2][2][4][2], const Unit& u, int wr, int wc, int fr, int fq) const {
        const int row0 = u.pm * BM + wr * 64 + fr, col0 = u.pn * BM + wc * 32 + 8 * fq;
#pragma unroll
        for (int ai = 0; ai < 2; ++ai)
#pragma unroll
            for (int m = 0; m < 4; ++m) { GAS bf16_t* rowp = O + (size_t)(row0 + ai * HALF + m * 16) * ldc + col0;
#pragma unroll
                for (int bj = 0; bj < 2; ++bj) { f32x4 v0 = acc[ai][bj][m][0], v1 = acc[ai][bj][m][1];
#pragma unroll
                    for (int j = 0; j < 4; ++j) { const float a = fmaxf(v0[j], 0.f), b = fmaxf(v1[j], 0.f); v0[j] = a * a; v1[j] = b * b; }
                    u32x4 w; w.x = cvt_pk_bf16(v0[0], v0[1]); w.y = cvt_pk_bf16(v0[2], v0[3]); w.z = cvt_pk_bf16(v1[0], v1[1]); w.w = cvt_pk_bf16(v1[2], v1[3]);
                    EPI_ST((GAS u32x4*)(rowp + bj * HALF), w); } }
    }
};
struct EpiBf16P {
    static constexpr bool PERM = true, AFTER_DRAIN = false;
    GAS bf16_t* O; int ldc;
    __device__ __forceinline__ void operator()(const f32x4 (&acc)[2][2][4][2], const Unit& u, int wr, int wc, int fr, int fq) const {
        const int row0 = u.pm * BM + wr * 64 + fr, col0 = u.pn * BM + wc * 32 + 8 * fq;
#pragma unroll
        for (int ai = 0; ai < 2; ++ai)
#pragma unroll
            for (int m = 0; m < 4; ++m) { GAS bf16_t* rowp = O + (size_t)(row0 + ai * HALF + m * 16) * ldc + col0;
#pragma unroll
                for (int bj = 0; bj < 2; ++bj) { const f32x4 v0 = acc[ai][bj][m][0], v1 = acc[ai][bj][m][1];
                    u32x4 w; w.x = cvt_pk_bf16(v0[0], v0[1]); w.y = cvt_pk_bf16(v0[2], v0[3]); w.z = cvt_pk_bf16(v1[0], v1[1]); w.w = cvt_pk_bf16(v1[2], v1[3]);
                    EPI_ST((GAS u32x4*)(rowp + bj * HALF), w); } }
    }
};
struct EpiGlu {
    static constexpr bool PERM = true, AFTER_DRAIN = false;
    GAS bf16_t* O; int ldc;
    __device__ __forceinline__ void operator()(const f32x4 (&acc)[2][2][4][2], const Unit& u, int wr, int wc, int fr, int fq) const {
        const int row0 = u.pm * BM + wr * 64 + fr, col0 = u.pn * HALF + wc * 32 + 8 * fq;
#pragma unroll
        for (int ai = 0; ai < 2; ++ai)
#pragma unroll
            for (int m = 0; m < 4; ++m) { GAS bf16_t* rowp = O + (size_t)(row0 + ai * HALF + m * 16) * ldc + col0;
                f32x4 o0, o1;
#pragma unroll
                for (int j = 0; j < 4; ++j) { o0[j] = acc[ai][0][m][0][j] * sigmoid_f(acc[ai][1][m][0][j]); o1[j] = acc[ai][0][m][1][j] * sigmoid_f(acc[ai][1][m][1][j]); }
                u32x4 w; w.x = cvt_pk_bf16(o0[0], o0[1]); w.y = cvt_pk_bf16(o0[2], o0[3]); w.z = cvt_pk_bf16(o1[0], o1[1]); w.w = cvt_pk_bf16(o1[2], o1[3]);
                EPI_ST((GAS u32x4*)(rowp), w); }
    }
};
struct EpiHgIn {
    static constexpr bool PERM = true, AFTER_DRAIN = false;
    GAS bf16_t* Q; size_t hstride; GAS bf16_t* LF; size_t fstride; const GAS float* lbv;
    template <int BJ> __device__ __forceinline__ void gate_half(const f32x4 (&acc)[2][2][4][2], GAS bf16_t* O, const GAS float* lbp, int row0, int col0) const {
        const f32x4 lb0 = *(const GAS f32x4*)(lbp + BJ * HALF), lb1 = *(const GAS f32x4*)(lbp + BJ * HALF + 4);
#pragma unroll
        for (int ai = 0; ai < 2; ++ai)
#pragma unroll
            for (int m = 0; m < 4; ++m) { GAS bf16_t* rowp = O + (size_t)(row0 + ai * HALF + m * 16) * 2048 + col0 + BJ * HALF;
                f32x4 o0, o1;
#pragma unroll
                for (int j = 0; j < 4; ++j) { o0[j] = logf_gate(acc[ai][BJ][m][0][j], lb0[j], 0.f); o1[j] = logf_gate(acc[ai][BJ][m][1][j], lb1[j], 0.f); }
                u32x4 w; w.x = cvt_pk_bf16(o0[0], o0[1]); w.y = cvt_pk_bf16(o0[2], o0[3]); w.z = cvt_pk_bf16(o1[0], o1[1]); w.w = cvt_pk_bf16(o1[2], o1[3]);
                EPI_ST((GAS u32x4*)(rowp), w); }
    }
    __device__ __forceinline__ void operator()(const f32x4 (&acc)[2][2][4][2], const Unit& u, int wr, int wc, int fr, int fq) const {
        const int typ = u.pn >> 3, row0 = u.pm * BM + wr * 64 + fr, col0 = (u.pn & 7) * BM + wc * 32 + 8 * fq;
        if (typ == 2 || typ == 3) {
            GAS bf16_t* O = LF + (size_t)(typ - 2) * fstride;
            const GAS float* lbp = lbv + (typ == 2 ? 0 : 2048) + col0;
            gate_half<0>(acc, O, lbp, row0, col0); gate_half<1>(acc, O, lbp, row0, col0);
        } else {
            GAS bf16_t* O = Q + (size_t)((typ >> 2) * 2 + (typ & 1)) * hstride; const bool act = typ != 1;
#pragma unroll
            for (int ai = 0; ai < 2; ++ai)
#pragma unroll
                for (int m = 0; m < 4; ++m) { GAS bf16_t* rowp = O + (size_t)(row0 + ai * HALF + m * 16) * 2048 + col0;
#pragma unroll
                    for (int bj = 0; bj < 2; ++bj) { f32x4 v0 = acc[ai][bj][m][0], v1 = acc[ai][bj][m][1];
                        if (act) {
#pragma unroll
                            for (int j = 0; j < 4; ++j) { v0[j] = silu_f(v0[j]); v1[j] = silu_f(v1[j]); } }
                        u32x4 w; w.x = cvt_pk_bf16(v0[0], v0[1]); w.y = cvt_pk_bf16(v0[2], v0[3]); w.z = cvt_pk_bf16(v1[0], v1[1]); w.w = cvt_pk_bf16(v1[2], v1[3]);
                        EPI_ST((GAS u32x4*)(rowp + bj * HALF), w); } }
        }
    }
};
#ifndef PG_AUX_A
#define PG_AUX_A 0
#endif
#ifndef PG_AUX_B
#define PG_AUX_B 0
#endif
template <class Epi, class Sched, bool ALIGN_EPI = false, bool SP2 = false>
__device__ __forceinline__ void gemm_phase(PG8_LAS unsigned char* lds, const Gemm g, const Sched& S, const Epi& E) {
    int tid_ = threadIdx.x; asm volatile("" : "+v"(tid_));
    const int tid = tid_, wid = __builtin_amdgcn_readfirstlane(tid >> 6), lane = tid & 63, wr = wid >> 2, wc = wid & 3, fr = lane & 15, fq = lane >> 4;
    const int K = g.K, nt = K / BK;
    unsigned voffA[2], voffB[2];
#pragma unroll
    for (int i = 0; i < 2; ++i) { int R, C; stage_rc(tid * 16 + i * 8192, R, C); const int Rb = Epi::PERM ? ((R & ~31) + perm32(R & 31)) : R;
        voffA[i] = (unsigned)(R * K + C) * 2u; voffB[i] = (unsigned)(Rb * K + C) * 2u; }
    const size_t kstep = (size_t)(BK * 2);
    const size_t hstep = (size_t)HALF * K * 2;
    const size_t tstep = 2 * hstep;
    const unsigned ldsw = (unsigned)wid * 1024u;
    const int aoff = lds_byte(wr * 64 + fr, fq * 8), boff = lds_byte(wc * 32 + fr, fq * 8);
#define PG8_SA(b, h) (((b) * 2 + (h)) * HTB)
#define PG8_SB(b, h) ((4 + (b) * 2 + (h)) * HTB)
#define PG8_STAGE(bufoff, gbase, voff) do { _Pragma("unroll") for (int _i = 0; _i < 2; ++_i) \
        __builtin_amdgcn_global_load_lds((const unsigned*)((const char*)(gbase) + (voff)[_i]), (PG8_LAS unsigned*)(lds + (bufoff) + ldsw + _i * 8192), 16, 0, PG_AUX_B); } while (0)
#define PG8_STAGEA(bufoff, gbase, voff) do { _Pragma("unroll") for (int _i = 0; _i < 2; ++_i) \
        __builtin_amdgcn_global_load_lds((const unsigned*)((const char*)(gbase) + (voff)[_i]), (PG8_LAS unsigned*)(lds + (bufoff) + ldsw + _i * 8192), 16, 0, PG_AUX_A); } while (0)
#define PG8_LDA(dst, b, h) do { _Pragma("unroll") for (int m = 0; m < 4; ++m) _Pragma("unroll") for (int k = 0; k < 2; ++k) dst[m][k] = *(const PG8_LAS bf16x8*)(lds + PG8_SA(b, h) + aoff + m * 2048 + k * 1024); } while (0)
#define PG8_LDB(dst, b, h) do { _Pragma("unroll") for (int n = 0; n < 2; ++n) _Pragma("unroll") for (int k = 0; k < 2; ++k) dst[n][k] = *(const PG8_LAS bf16x8*)(lds + PG8_SB(b, h) + boff + n * 2048 + k * 1024); } while (0)
#define PG8_MMA(ai, bj, At, Bt) do { __builtin_amdgcn_s_setprio(1); _Pragma("unroll") for (int m = 0; m < 4; ++m) _Pragma("unroll") for (int n = 0; n < 2; ++n) _Pragma("unroll") for (int k = 0; k < 2; ++k) \
        acc[ai][bj][m][n] = __builtin_amdgcn_mfma_f32_16x16x32_bf16(Bt[n][k], At[m][k], acc[ai][bj][m][n], 0, 0, 0); __builtin_amdgcn_s_setprio(0); } while (0)
#define PG8_WAIT_V(n) asm volatile("s_waitcnt vmcnt(" #n ")" ::: "memory")
#define PG8_WAIT_L(n) asm volatile("s_waitcnt lgkmcnt(" #n ")" ::: "memory")
#define PG8_BAR __builtin_amdgcn_s_barrier()
#define PG8_SCHED __builtin_amdgcn_sched_barrier(0)
    Unit cur, nxt; int ui = 0;
    if (!S.next(0, cur)) return;
    f32x4 acc[2][2][4][2];
#pragma unroll
    for (int a = 0; a < 2; ++a)
#pragma unroll
        for (int b = 0; b < 2; ++b)
#pragma unroll
            for (int m = 0; m < 4; ++m)
#pragma unroll
                for (int n = 0; n < 2; ++n) acc[a][b][m][n] = (f32x4){0.f, 0.f, 0.f, 0.f};
    bf16x8 At[4][2], B0[2][2], B1[2][2];
    const char* cA = (const char*)g.A + (size_t)cur.pm * tstep; const char* cB = (const char*)g.Bt + (size_t)cur.pn * tstep;
    S.a_ready(cur);
    if constexpr (SP2) {
        PG8_STAGE(PG8_SB(0, 0), cB, voffB); PG8_STAGE(PG8_SB(0, 1), cB + hstep, voffB); PG8_STAGEA(PG8_SA(0, 0), cA, voffA); PG8_STAGEA(PG8_SA(0, 1), cA + hstep, voffA);
        if (wr == 1) PG8_BAR;
        PG8_WAIT_V(2); PG8_BAR;
        PG8_STAGE(PG8_SB(1, 0), cB + kstep, voffB); PG8_STAGEA(PG8_SA(1, 0), cA + kstep, voffA); PG8_STAGE(PG8_SB(1, 1), cB + hstep + kstep, voffB);
        PG8_WAIT_V(6); PG8_BAR;
    } else {
        PG8_STAGE(PG8_SB(0, 0), cB, voffB); PG8_STAGEA(PG8_SA(0, 0), cA, voffA); PG8_STAGE(PG8_SB(0, 1), cB + hstep, voffB); PG8_STAGEA(PG8_SA(0, 1), cA + hstep, voffA);
        if (wr == 1) PG8_BAR;
        PG8_WAIT_V(4); PG8_BAR;
        PG8_STAGE(PG8_SB(1, 0), cB + kstep, voffB); PG8_STAGEA(PG8_SA(1, 0), cA + kstep, voffA); PG8_STAGE(PG8_SB(1, 1), cB + hstep + kstep, voffB);
        PG8_WAIT_V(6); PG8_BAR;
    }
    for (;;) {
        const bool has_next = S.next(ui + 1, nxt);
        const char* nA = has_next ? (const char*)g.A + (size_t)nxt.pm * tstep : cA; const char* nB = has_next ? (const char*)g.Bt + (size_t)nxt.pn * tstep : cB;
        for (int t = 0; t < nt; t += 2) {
            const bool last = (t == nt - 2);
            const char* a1 = cA + (size_t)(t + 1) * kstep;
            const char* a2 = last ? nA : cA + (size_t)(t + 2) * kstep; const char* b2 = last ? nB : cB + (size_t)(t + 2) * kstep;
            const char* a3 = a2 + kstep; const char* b3 = b2 + kstep;
            if (last && has_next) S.a_ready(nxt);
            if constexpr (SP2) {
            PG8_LDB(B0, 0, 0); PG8_LDB(B1, 0, 1); PG8_SCHED; PG8_LDA(At, 0, 0); PG8_STAGEA(PG8_SA(1, 1), a1 + hstep, voffA);
            PG8_WAIT_V(8); PG8_WAIT_L(0); PG8_BAR; PG8_MMA(0, 0, At, B0); PG8_MMA(0, 1, At, B1); PG8_BAR; PG8_SCHED;
            PG8_LDA(At, 0, 1); PG8_STAGE(PG8_SB(0, 0), b2, voffB); PG8_STAGE(PG8_SB(0, 1), b2 + hstep, voffB); PG8_STAGEA(PG8_SA(0, 0), a2, voffA);
            PG8_WAIT_V(8); PG8_WAIT_L(0); PG8_BAR; PG8_MMA(1, 0, At, B0); PG8_MMA(1, 1, At, B1); PG8_BAR; PG8_SCHED;
            PG8_LDB(B0, 1, 0); PG8_LDB(B1, 1, 1); PG8_SCHED; PG8_LDA(At, 1, 0); PG8_STAGEA(PG8_SA(0, 1), a2 + hstep, voffA);
            PG8_WAIT_V(8); PG8_WAIT_L(0); PG8_BAR; PG8_MMA(0, 0, At, B0); PG8_MMA(0, 1, At, B1); PG8_BAR; PG8_SCHED;
            PG8_LDA(At, 1, 1); PG8_STAGE(PG8_SB(1, 0), b3, voffB); PG8_STAGE(PG8_SB(1, 1), b3 + hstep, voffB); PG8_STAGEA(PG8_SA(1, 0), a3, voffA);
            PG8_WAIT_V(8); PG8_WAIT_L(0); PG8_BAR; PG8_MMA(1, 0, At, B0); PG8_MMA(1, 1, At, B1); PG8_BAR; PG8_SCHED;
            } else {
            PG8_LDB(B0, 0, 0); PG8_SCHED; PG8_LDA(At, 0, 0); PG8_STAGEA(PG8_SA(1, 1), a1 + hstep, voffA);
            PG8_WAIT_L(8); PG8_BAR; PG8_WAIT_L(0); PG8_MMA(0, 0, At, B0); PG8_BAR; PG8_SCHED;
            PG8_LDB(B1, 0, 1); PG8_STAGE(PG8_SB(0, 0), b2, voffB);
            PG8_BAR; PG8_WAIT_L(0); PG8_MMA(0, 1, At, B1); PG8_BAR;
            PG8_LDA(At, 0, 1); PG8_STAGEA(PG8_SA(0, 0), a2, voffA);
            PG8_BAR; PG8_WAIT_L(0); PG8_MMA(1, 0, At, B0); PG8_BAR; PG8_SCHED;
            PG8_STAGE(PG8_SB(0, 1), b2 + hstep, voffB);
            PG8_WAIT_V(6); PG8_BAR; PG8_MMA(1, 1, At, B1); PG8_BAR;
            PG8_LDB(B0, 1, 0); PG8_SCHED; PG8_LDA(At, 1, 0); PG8_STAGEA(PG8_SA(0, 1), a2 + hstep, voffA);
            PG8_WAIT_L(8); PG8_BAR; PG8_WAIT_L(0); PG8_MMA(0, 0, At, B0); PG8_BAR; PG8_SCHED;
            PG8_LDB(B1, 1, 1); PG8_STAGE(PG8_SB(1, 0), b3, voffB);
            PG8_BAR; PG8_WAIT_L(0); PG8_MMA(0, 1, At, B1); PG8_BAR;
            PG8_LDA(At, 1, 1); PG8_STAGEA(PG8_SA(1, 0), a3, voffA);
            PG8_BAR; PG8_WAIT_L(0); PG8_MMA(1, 0, At, B0); PG8_BAR; PG8_SCHED;
            PG8_STAGE(PG8_SB(1, 1), b3 + hstep, voffB);
            PG8_WAIT_V(6); PG8_BAR; PG8_MMA(1, 1, At, B1); PG8_BAR;
            }
        }
        if constexpr (ALIGN_EPI) { if (wr == 0) PG8_BAR; }
        if constexpr (!Epi::AFTER_DRAIN) { E(acc, cur, wr, wc, fr, fq); S.done(cur); }
        if (!has_next) break;
#pragma unroll
        for (int a = 0; a < 2; ++a)
#pragma unroll
            for (int b = 0; b < 2; ++b)
#pragma unroll
                for (int m = 0; m < 4; ++m)
#pragma unroll
                    for (int n = 0; n < 2; ++n) acc[a][b][m][n] = (f32x4){0.f, 0.f, 0.f, 0.f};
        cur = nxt; cA = nA; cB = nB; ++ui;
        if constexpr (ALIGN_EPI) { if (wr == 1) PG8_BAR; }
    }
    PG8_WAIT_V(0);
    if constexpr (!ALIGN_EPI) { if (wr == 0) PG8_BAR; }
    PG8_BAR;
    if constexpr (Epi::AFTER_DRAIN) { E.fused(acc, cur, wr, wc, fr, fq, lds, wid, lane); S.done(cur); }
#undef PG8_SA
#undef PG8_SB
#undef PG8_STAGE
#undef PG8_STAGEA
#undef PG8_LDA
#undef PG8_LDB
#undef PG8_MMA
#undef PG8_WAIT_V
#undef PG8_WAIT_L
#undef PG8_BAR
#undef PG8_SCHED
}
}
constexpr int DM = 2048, SEQ = 8192, CTXL = 256, MTOT = SEQ + CTXL, HID = 8192, NMOD = 6 * DM;
constexpr int NWAVES = 8, NTHR = 512;
constexpr float NEPS = 1e-6f;
#ifndef MK_PER_PHASE
#define MK_PER_PHASE 0
#endif
constexpr int NPHASES = 35;
#ifndef PG_CID
#define PG_CID ((int)((blockIdx.x >> 5) + 8 * (blockIdx.x & 31)))
#endif
#ifndef PG_ALIGN
#define PG_ALIGN true
#endif
#ifndef PG_SP2
#define PG_SP2 true
#endif
#ifndef REP_P0
#define REP_P0 0
#endif
#ifndef REP_S5
#define REP_S5 0
#endif
#ifndef REP_HG
#define REP_HG 0
#endif
#ifndef REP_GEMM
#define REP_GEMM 0
#endif
#ifndef REP_BAR
#define REP_BAR 0
#endif
#ifndef REP_R1
#define REP_R1 0
#endif
#ifndef REP_R2
#define REP_R2 0
#endif
#ifndef REP_GGLU
#define REP_GGLU 0
#endif
#ifndef REP_GIN
#define REP_GIN 0
#endif
#ifndef REP_GOUT
#define REP_GOUT 0
#endif
#ifndef REP_GHG
#define REP_GHG 0
#endif
#ifndef WGM_GLU
#define WGM_GLU 2
#endif
#ifndef WGM_IN
#define WGM_IN 2
#endif
#ifndef WGM_OUT
#define WGM_OUT 2
#endif
#ifndef WGM_HG
#define WGM_HG 2
#endif
#ifndef WGM_OP
#define WGM_OP 2
#endif
#ifndef REP_RN
#define REP_RN 0
#endif
#ifndef REP_CTX
#define REP_CTX 0
#endif
#ifndef REP_THIN
#define REP_THIN 0
#endif

constexpr size_t MiB = 1u << 20;
constexpr size_t WS_CTL = 0, CTL_ZERO_BYTES = 1 * MiB;
constexpr size_t WS_MOD = 1 * MiB;
constexpr size_t WS_LBV = 2 * MiB;
constexpr size_t WS_PART = 3 * MiB;
constexpr size_t WS_W1 = 16 * MiB;
constexpr size_t WS_W2 = WS_W1 + 128 * MiB;
constexpr size_t WS_WGLU = WS_W2 + 128 * MiB;
constexpr size_t WS_WIN = WS_WGLU + 32 * MiB;
constexpr size_t WS_WOUT = WS_WIN + 80 * MiB;
constexpr size_t WS_X = WS_WOUT + 16 * MiB;
constexpr size_t WS_H = WS_X + 66 * MiB;
constexpr size_t WS_Z = WS_H + 33 * MiB;
constexpr size_t WS_Y1 = WS_Z + 33 * MiB;
constexpr size_t WS_Y2 = WS_Y1 + 66 * MiB;
constexpr size_t WS_HID = WS_Y2 + 66 * MiB;
constexpr size_t WS_Q = WS_HID + 132 * MiB;
constexpr size_t WS_V = WS_Q + 33 * MiB;
constexpr size_t WS_SG = WS_V + 33 * MiB;
constexpr size_t WS_LF = WS_SG + 33 * MiB;
constexpr size_t WS_LB = WS_LF + 66 * MiB;
constexpr size_t WS_OF = WS_LB + 66 * MiB;
constexpr size_t WS_OB = WS_OF + 66 * MiB;
constexpr size_t WS_REC = WS_OB + 66 * MiB;
constexpr size_t WS_SEGS = WS_REC + 224 * MiB;
constexpr size_t WS_SEGD = WS_SEGS + 16 * MiB;
constexpr size_t WS_YP1 = WS_SEGD + 1 * MiB;
constexpr size_t WS_YP2 = WS_YP1 + 8 * MiB;
constexpr size_t WS_END = WS_YP2 + 8 * MiB;
constexpr int CW_BAR = 4096;

constexpr int RING_OFF = 0, RING_BYTES = 135168;
constexpr int LDSCTL_OFF = RING_BYTES, MISC_OFF = LDSCTL_OFF + 320;
constexpr int LDS_BYTES = 147456;

#define LAS __attribute__((address_space(3)))
typedef unsigned short bf16;
typedef unsigned v4u __attribute__((ext_vector_type(4)));
typedef unsigned v2u __attribute__((ext_vector_type(2)));
typedef float f32x4 __attribute__((ext_vector_type(4)));
typedef short bf16x8 __attribute__((ext_vector_type(8)));
#define LDS_WAIT() asm volatile("s_waitcnt lgkmcnt(0)" ::: "memory")
#define VM_WAIT() asm volatile("s_waitcnt vmcnt(0)" ::: "memory")
__device__ __forceinline__ unsigned f2bf(float f) { unsigned u = __builtin_bit_cast(unsigned, f); return (u + 0x7fffu + ((u >> 16) & 1u)) >> 16; }
__device__ __forceinline__ unsigned pk2(float lo, float hi) { return f2bf(lo) | (f2bf(hi) << 16); }
__device__ __forceinline__ float bflo(unsigned w) { return __builtin_bit_cast(float, w << 16); }
__device__ __forceinline__ float bfhi(unsigned w) { return __builtin_bit_cast(float, w & 0xffff0000u); }
typedef float f32x2 __attribute__((ext_vector_type(2)));
typedef __bf16 bf16x2n __attribute__((ext_vector_type(2)));
__device__ __forceinline__ unsigned pkbf(float lo, float hi) { f32x2 v = {lo, hi}; return __builtin_bit_cast(unsigned, __builtin_convertvector(v, bf16x2n)); }
__device__ __forceinline__ float bf1(bf16 b) { return __builtin_bit_cast(float, ((unsigned)b) << 16); }

#define XB_TMO      128
#define XB_XCNT(j)  (256  + 64 * (j))
#define XB_XSUB(j)  (1280 + 64 * (j))
#define XB_XGEN(j)  (2304 + 64 * (j))
#define XB_TOP      3328
#define XB_TOPGEN   3392
#define XCD_BAR_WORDS 3456
#define XB_SPIN_CAP (1u << 18)

__device__ __forceinline__ unsigned xb_ld(unsigned* p)              { return __hip_atomic_load(p, __ATOMIC_RELAXED, __HIP_MEMORY_SCOPE_AGENT); }
__device__ __forceinline__ unsigned xb_add(unsigned* p, unsigned v) { return __hip_atomic_fetch_add(p, v, __ATOMIC_RELAXED, __HIP_MEMORY_SCOPE_AGENT); }
__device__ __forceinline__ unsigned xb_xcc_id() { return (unsigned)__builtin_amdgcn_s_getreg((3 << 11) | 20) & 0xFu; }
#define XB_SPIN(cond, bar) do { unsigned _sp = 0; while (cond) { __builtin_amdgcn_s_sleep(1); \
    if ((++_sp & 255u) == 0u) { if (xb_ld(&(bar)[XB_TMO])) break; if (_sp > XB_SPIN_CAP) { atomicAdd(&(bar)[XB_TMO], 1u); break; } } } } while (0)

struct XcdBarrier {
    unsigned* bar; unsigned x;
    volatile LAS unsigned* st;
};

__device__ __forceinline__ XcdBarrier xcd_barrier_post(unsigned* bar, volatile LAS unsigned* st) {
    XcdBarrier b; b.bar = bar; b.x = xb_xcc_id(); b.st = st;
    if (threadIdx.x == 0) (void)xb_add(&bar[XB_XCNT(b.x)], 1u);
    return b;
}
__device__ __forceinline__ void xcd_barrier_complete(unsigned* bar, unsigned x, unsigned& nloc, unsigned& nx) {
    const unsigned G = gridDim.x * gridDim.y * gridDim.z;
    unsigned sum, cnt, mine, sp = 0u;
    for (;;) {
        sum = 0u; cnt = 0u; mine = 0u;
#pragma unroll
        for (unsigned j = 0; j < 16; ++j) { const unsigned c = xb_ld(&bar[XB_XCNT(j)]); sum += c; cnt += (c > 0u) ? 1u : 0u; mine = (j == x) ? c : mine; }
        if (sum == G) break;
        __builtin_amdgcn_s_sleep(1);
        if ((++sp & 255u) == 0u) { if (xb_ld(&bar[XB_TMO])) break; if (sp > XB_SPIN_CAP) { atomicAdd(&bar[XB_TMO], 1u); break; } }
    }
    nloc = mine > 0u ? mine : 1u; nx = cnt > 0u ? cnt : 1u;
}

__device__ __forceinline__ void xcd_barrier(const XcdBarrier& b) {
    asm volatile("s_waitcnt vmcnt(0)" ::: "memory");
    __syncthreads();
    if (threadIdx.x == 0) {
        unsigned* bar = b.bar;
        __builtin_amdgcn_s_waitcnt(0);
        unsigned nloc = b.st[0], nx = b.st[1];
        if (nloc == 0u) { xcd_barrier_complete(bar, b.x, nloc, nx); b.st[0] = nloc; b.st[1] = nx; }
        const unsigned old = xb_add(&bar[XB_XSUB(b.x)], 1u);
        const unsigned gen = old / nloc;
        if (old + 1u == (gen + 1u) * nloc) {
            __builtin_amdgcn_fence(__ATOMIC_RELEASE, "agent");
            asm volatile("s_waitcnt vmcnt(0)" ::: "memory");
            const unsigned og = xb_add(&bar[XB_TOP], 1u);
            const unsigned tg = og / nx;
            if (og + 1u == (tg + 1u) * nx) xb_add(&bar[XB_TOPGEN], 1u);
            else XB_SPIN(xb_ld(&bar[XB_TOPGEN]) == tg, bar);
            __builtin_amdgcn_fence(__ATOMIC_ACQUIRE, "agent");
            xb_add(&bar[XB_XGEN(b.x)], 1u);
            asm volatile("s_waitcnt vmcnt(0)" ::: "memory");
        } else {
            XB_SPIN(xb_ld(&bar[XB_XGEN(b.x)]) == gen, bar);
            __builtin_amdgcn_fence(__ATOMIC_ACQUIRE, "agent");
            asm volatile("s_waitcnt vmcnt(0)" ::: "memory");
        }
    }
    __syncthreads();
}

typedef const unsigned short* gen_cbf; typedef unsigned* gen_u32p;
struct Args { const float* in[25]; float* out; unsigned char* ws; int ph_lo, ph_hi; };
template <class T> __device__ __forceinline__ GAS T* opq(T* p) { GAS T* g = (GAS T*)p; asm volatile("" : "+s"(g)); return g; }
template <class T> __device__ __forceinline__ GAS T* opq(GAS T* g) { asm volatile("" : "+s"(g)); return g; }
__device__ __forceinline__ int opqv(int v) { asm volatile("" : "+v"(v)); return v; }
#define AIN(k) opq(args.in[k])
#define WSP(off) (opq(F.ws) + (off))
struct Frame {
    LAS unsigned char* lds;
    volatile LAS unsigned* MISC;
    int tid, lane, wave, vcu, G;
    GAS unsigned char* ws;
    GAS float* out;
};
__device__ __forceinline__ int opqs(int v) { asm volatile("" : "+s"(v)); return v; }
__device__ __forceinline__ void relane(Frame& F) { F.lane = opqv(F.lane); F.tid = opqv(F.tid); F.wave = opqs(F.wave); F.vcu = opqs(F.vcu);
    unsigned lb = (unsigned)(size_t)F.lds; asm volatile("" : "+s"(lb)); F.lds = (LAS unsigned char*)(size_t)lb; }
__device__ __forceinline__ float xshfl(float v, int lane, int o) { return __builtin_bit_cast(float, __builtin_amdgcn_ds_bpermute((lane ^ o) << 2, __builtin_bit_cast(int, v))); }
__device__ __forceinline__ float wave_sum(float v, int lane) {
#pragma unroll
    for (int o = 1; o < 64; o <<= 1) v += xshfl(v, lane, o);
    return v;
}

__device__ __forceinline__ void p0_transpose_item(const GAS float* W, int K, int N, GAS bf16* WT, int k0, int n0, int dst_row0, LAS unsigned char* scr, int lane) {
    const int n4 = (lane & 15) * 4, kp = lane >> 4;
    const GAS float* src = W + (size_t)(k0 + 2 * kp) * N + n0 + n4;
    f32x4 v[16];
#pragma unroll
    for (int i = 0; i < 8; ++i) { v[2 * i] = *(const GAS f32x4*)(src + (size_t)(8 * i) * N); v[2 * i + 1] = *(const GAS f32x4*)(src + (size_t)(8 * i + 1) * N); }
#pragma unroll
    for (int i = 0; i < 8; ++i) {
#pragma unroll
        for (int e = 0; e < 4; ++e) *(LAS unsigned*)(scr + (n4 + e) * 144 + (8 * i + 2 * kp) * 2) = pkbf(v[2 * i][e], v[2 * i + 1][e]);
    }
    LDS_WAIT(); asm volatile("" ::: "memory");
    const int c = lane & 7, nr = lane >> 3;
#pragma unroll
    for (int j = 0; j < 8; ++j) { const int n = nr + 8 * j; const v4u o = *(const LAS v4u*)(scr + n * 144 + c * 16);
        *(GAS v4u*)(WT + (size_t)(dst_row0 + n) * K + k0 + 8 * c) = o; }
    LDS_WAIT(); asm volatile("" ::: "memory");
}
__device__ __forceinline__ void phase_p0(Frame& F, const Args& args) {
    relane(F);
    LAS unsigned char* scr = F.lds + RING_OFF + F.wave * 9216;
    const int gw = F.vcu * NWAVES + F.wave, NGW = F.G * NWAVES;
    constexpr int I_W1 = (DM / 64) * (HID / 64);
    constexpr int I_W2 = (HID / 64) * (DM / 64);
    constexpr int I_GLU = (DM / 64) * (4096 / 64);
    constexpr int I_IN = (DM / 64) * (10240 / 64);
    constexpr int I_OUT = (DM / 64) * (DM / 64);
    constexpr int T_W1 = 4 * I_W1, T_W2 = 4 * I_W2, T_GLU = 2 * I_GLU, T_IN = 2 * I_IN, T_OUT = 2 * I_OUT;
    constexpr int NITEMS = T_W1 + T_W2 + T_GLU + T_IN + T_OUT;
    for (int it = gw; it < NITEMS; it += NGW) {
        int r = it;
        if (r < T_W1) { const int l = r / I_W1, q = r % I_W1, nblk = HID / 64, qg = q >> 3, qw = q & 3, qk = (q >> 2) & 1, kb = 2 * (qg / (nblk / 4)) + qk, nb = 4 * (qg % (nblk / 4)) + qw;
            p0_transpose_item(AIN(10) + (size_t)l * DM * HID, DM, HID, (GAS bf16*)(WSP(WS_W1)) + (size_t)l * HID * DM, 64 * kb, 64 * nb, 64 * nb, scr, F.lane); continue; } r -= T_W1;
        if (r < T_W2) { const int l = r / I_W2, q = r % I_W2, nblk = DM / 64, qg = q >> 3, qw = q & 3, qk = (q >> 2) & 1, kb = 2 * (qg / (nblk / 4)) + qk, nb = 4 * (qg % (nblk / 4)) + qw;
            p0_transpose_item(AIN(11) + (size_t)l * HID * DM, HID, DM, (GAS bf16*)(WSP(WS_W2)) + (size_t)l * DM * HID, 64 * kb, 64 * nb, 64 * nb, scr, F.lane); continue; } r -= T_W2;
        if (r < T_GLU) { const int l = r / I_GLU, q = r % I_GLU, nblk = 4096 / 64, qg = q >> 3, qw = q & 3, qk = (q >> 2) & 1, kb = 2 * (qg / (nblk / 4)) + qk, nb = 4 * (qg % (nblk / 4)) + qw, n0 = 64 * nb;
            const int c = n0 & 2047, dst = 256 * (c >> 7) + (n0 >= 2048 ? 128 : 0) + (c & 127);
            p0_transpose_item(AIN(20) + (size_t)l * DM * 4096, DM, 4096, (GAS bf16*)(WSP(WS_WGLU)) + (size_t)l * 4096 * DM, 64 * kb, n0, dst, scr, F.lane); continue; } r -= T_GLU;
        if (r < T_IN) { const int l = r / I_IN, q = r % I_IN, nblk = 10240 / 64, qg = q >> 3, qw = q & 3, qk = (q >> 2) & 1, kb = 2 * (qg / (nblk / 4)) + qk, nb = 4 * (qg % (nblk / 4)) + qw;
            p0_transpose_item(AIN(21) + (size_t)l * DM * 10240, DM, 10240, (GAS bf16*)(WSP(WS_WIN)) + (size_t)l * 10240 * DM, 64 * kb, 64 * nb, 64 * nb, scr, F.lane); continue; } r -= T_IN;
        { const int l = r / I_OUT, q = r % I_OUT, nblk = DM / 64, qg = q >> 3, qw = q & 3, qk = (q >> 2) & 1, kb = 2 * (qg / (nblk / 4)) + qk, nb = 4 * (qg % (nblk / 4)) + qw;
            p0_transpose_item(AIN(24) + (size_t)l * DM * DM, DM, DM, (GAS bf16*)(WSP(WS_WOUT)) + (size_t)l * DM * DM, 64 * kb, 64 * nb, 64 * nb, scr, F.lane); }
    }
    __syncthreads();
    LAS float* sc = (LAS float*)(F.lds + RING_OFF);
    for (int i = F.tid; i < 2 * DM; i += NTHR) { const float v = i < DM ? AIN(1)[i] : AIN(3)[i - DM]; sc[i] = v / (1.0f + __expf(-v)); }
    __syncthreads();
    LAS float* red = sc + 2 * DM;
    GAS float* PART = (GAS float*)(WSP(WS_PART));
    for (int it = F.vcu; it < 4 * 16 * 12; it += F.G) {
        const int l = it / 192, q = it % 192, kc = q / 12, cb = q % 12;
        const int c4 = F.tid & 255, rh = F.tid >> 8, col = cb * 1024 + c4 * 4;
        const GAS float* wp = AIN(4) + ((size_t)l * DM + kc * 128 + rh * 64) * NMOD + col;
        f32x4 a0 = {0.f, 0.f, 0.f, 0.f}, a1 = {0.f, 0.f, 0.f, 0.f};
#pragma unroll 8
        for (int k = 0; k < 64; ++k) { const f32x4 w = *(const GAS f32x4*)(wp + (size_t)k * NMOD); const float s0 = sc[kc * 128 + rh * 64 + k], s1 = sc[DM + kc * 128 + rh * 64 + k];
            a0 += w * s0; a1 += w * s1; }
        if (rh == 1) { *(LAS f32x4*)(red + c4 * 8) = a0; *(LAS f32x4*)(red + c4 * 8 + 4) = a1; }
        __syncthreads();
        if (rh == 0) { a0 += *(LAS f32x4*)(red + c4 * 8); a1 += *(LAS f32x4*)(red + c4 * 8 + 4);
            GAS float* o = PART + ((size_t)(l * 16 + kc) * 2) * NMOD + col;
            *(GAS f32x4*)o = a0; *(GAS f32x4*)(o + NMOD) = a1; }
        __syncthreads();
    }
}
__device__ __forceinline__ void phase_p1(Frame& F, const Args& args) {
    relane(F);
    const GAS float* PART = (const GAS float*)(WSP(WS_PART)); GAS float* MOD = (GAS float*)(WSP(WS_MOD)); GAS float* LBV = (GAS float*)(WSP(WS_LBV));
    const int gt = F.vcu * NTHR + F.tid, NT = F.G * NTHR;
    for (int i = gt; i < 4 * 2 * NMOD; i += NT) { const int l = i / (2 * NMOD), r = i % (2 * NMOD), w = r / NMOD, col = r % NMOD;
        float s = AIN(5)[l * NMOD + col];
#pragma unroll
        for (int kc = 0; kc < 16; ++kc) s += PART[((size_t)(l * 16 + kc) * 2 + w) * NMOD + col];
        MOD[i] = s; }
    for (int i = gt; i < 2 * 2 * DM; i += NT) { const int j = i / (2 * DM), r = i % (2 * DM), d = r / DM, col = r % DM;
        const float r0 = AIN(22)[(d * 2 + 0) * DM + col], r1 = AIN(22)[(d * 2 + 1) * DM + col];
        const float mx = fmaxf(r0, r1), e0 = expf(r0 - mx), e1 = expf(r1 - mx), w0 = e0 / (e0 + e1), w1 = e1 / (e0 + e1);
        LBV[i] = (j == 0) ? (w0 - w0) : ((w0 + w1) - w0); }
}

#define THIN_ROW_BODY(PG, PGP, PPRE, PSH, PSC, LD4, YV) do { \
        if (MODE != 0) { float s_ = 0.f; \
            _Pragma("unroll") for (int j = 0; j < 8; ++j) { const f32x4 yv_ = YV(j); s_ += (yv_.x * yv_.x + yv_.y * yv_.y) + (yv_.z * yv_.z + yv_.w * yv_.w); } \
            const float rs_ = 1.0f / sqrtf(wave_sum(s_, ln_) * (1.0f / DM) + NEPS); \
            _Pragma("unroll") for (int j = 0; j < 8; ++j) { const f32x4 g_ = LD4(PG, j), gp_ = LD4(PGP, j); x[j] += g_ * ((YV(j) * rs_) * gp_); if (j & 1) asm volatile("" ::: "memory"); } } \
        if (MODE == 2) { _Pragma("unroll") for (int j = 0; j < 8; ++j) *(GAS f32x4*)(F.out + (size_t)r * DM + 4 * ln_ + 256 * j) = x[j]; } \
        else { _Pragma("unroll") for (int j = 0; j < 8; ++j) { v2u xo_; xo_.x = pkbf(x[j].x, x[j].y); xo_.y = pkbf(x[j].z, x[j].w); *(GAS v2u*)(Xo + (size_t)r * DM + 4 * ln_ + 256 * j) = xo_; } \
            float s_ = 0.f; \
            _Pragma("unroll") for (int j = 0; j < 8; ++j) s_ += (x[j].x * x[j].x + x[j].y * x[j].y) + (x[j].z * x[j].z + x[j].w * x[j].w); \
            const float rs_ = 1.0f / sqrtf(wave_sum(s_, ln_) * (1.0f / DM) + NEPS); \
            _Pragma("unroll") for (int j = 0; j < 8; ++j) { const f32x4 gp_ = LD4(PPRE, j), sh_ = LD4(PSH, j), sc_ = LD4(PSC, j); \
                const f32x4 h_ = ((x[j] * rs_) * gp_) * (sc_ + 1.0f) + sh_; v2u o_; o_.x = pkbf(h_.x, h_.y); o_.y = pkbf(h_.z, h_.w); \
                if (HGM) *(GAS v2u*)(H + ((size_t)((ln_ >> 2) + 16 * j) * MTOT + r) * 16 + 4 * (ln_ & 3)) = o_; else *(GAS v2u*)(H + (size_t)r * DM + 4 * ln_ + 256 * j) = o_; if (j & 1) asm volatile("" ::: "memory"); } } } while (0)
#define THIN_YF(j) (y[j])
#define THIN_YP(j) ((f32x4){bflo(yp[j].x), bfhi(yp[j].x), bflo(yp[j].y), bfhi(yp[j].y)})
#define THIN_LDG(P, j) (*(const GAS f32x4*)((P) + 4 * ln_ + 256 * (j)))
#define THIN_LDL(P, j) (*(const LAS f32x4*)((P) + 4 * ln_ + 256 * (j)))
template <int MODE, int CP, bool DRY = false, bool HGM = false>
__device__ __forceinline__ void thin_rn(Frame& F, const Args& args, const GAS bf16* Y  , const GAS float* Yc  , int nrows_, const GAS float* gpost, const GAS float* modp  , int gate_chunk,
                                        const GAS float* gpre, const GAS float* modh  , int sh_chunk, int sc_chunk) {
    relane(F);
    GAS bf16* X = (GAS bf16*)(WSP(WS_X)); GAS bf16* H = (GAS bf16*)(WSP(WS_H)); GAS bf16* Xo = DRY ? (GAS bf16*)(WSP(WS_REC)) : X;
    const int gw = F.vcu * NWAVES + F.wave, NGW = F.G * NWAVES, nrows = (MODE == 2) ? SEQ : nrows_;
    LAS float* PL = (LAS float*)(F.lds + RING_OFF);
    for (int i = F.tid; i < DM / 4; i += NTHR) {
        if (MODE != 0) { *(LAS f32x4*)(PL + 4 * i) = *(const GAS f32x4*)(modp + gate_chunk * DM + 4 * i); *(LAS f32x4*)(PL + DM + 4 * i) = *(const GAS f32x4*)(gpost + 4 * i); }
        if (MODE != 2) { *(LAS f32x4*)(PL + 2 * DM + 4 * i) = *(const GAS f32x4*)(gpre + 4 * i); *(LAS f32x4*)(PL + 3 * DM + 4 * i) = *(const GAS f32x4*)(modh + sh_chunk * DM + 4 * i); *(LAS f32x4*)(PL + 4 * DM + 4 * i) = *(const GAS f32x4*)(modh + sc_chunk * DM + 4 * i); }
    }
    __syncthreads();
    {
        f32x4 xn[8]; v2u xq[8], yn[8];
        const GAS float* xb0 = AIN(0);
#define THIN_PREF(rr) do { const int ln_ = opqv(F.lane); const int rc_ = (rr) < SEQ ? (rr) : SEQ - 1; if (MODE == 0) { _Pragma("unroll") for (int j = 0; j < 8; ++j) xn[j] = *(const GAS f32x4*)(xb0 + (size_t)rc_ * DM + 4 * ln_ + 256 * j); } \
            else { _Pragma("unroll") for (int j = 0; j < 8; ++j) xq[j] = *(const GAS v2u*)(X + (size_t)rc_ * DM + 4 * ln_ + 256 * j); } \
            if (MODE != 0) { _Pragma("unroll") for (int j = 0; j < 8; ++j) yn[j] = *(const GAS v2u*)(Y + (size_t)rc_ * DM + 4 * ln_ + 256 * j); } } while (0)
        THIN_PREF(gw);
        for (int r = gw; r < SEQ; r += NGW) {
            const int ln_ = opqv(F.lane);
            LAS float* PLr = PL + opqv(0);
            f32x4 x[8]; v2u yp[8];
#pragma unroll
            for (int j = 0; j < 8; ++j) { if (MODE == 0) x[j] = xn[j]; else { x[j] = (f32x4){bflo(xq[j].x), bfhi(xq[j].x), bflo(xq[j].y), bfhi(xq[j].y)}; yp[j] = yn[j]; } }
            THIN_PREF(r + NGW);
            THIN_ROW_BODY(PLr, PLr + DM, PLr + 2 * DM, PLr + 3 * DM, PLr + 4 * DM, THIN_LDL, THIN_YP);
        }
#undef THIN_PREF
    }
    for (int r = SEQ + gw; r < nrows; r += NGW) {
        const int ln_ = opqv(F.lane);
        f32x4 x[8], y[8];
#pragma unroll
        for (int j = 0; j < 8; ++j) { if (MODE == 0) x[j] = *(const GAS f32x4*)(AIN(2) + (size_t)(r - SEQ) * DM + 4 * ln_ + 256 * j);
            else { const v2u t = *(const GAS v2u*)(X + (size_t)r * DM + 4 * ln_ + 256 * j); x[j] = (f32x4){bflo(t.x), bfhi(t.x), bflo(t.y), bfhi(t.y)}; } }
        if (MODE != 0) {
#pragma unroll
            for (int j = 0; j < 8; ++j) y[j] = *(const GAS f32x4*)(Yc + (size_t)(r - SEQ) * DM + 4 * ln_ + 256 * j);
#pragma unroll
            for (int k = 1; k < CP; ++k) { asm volatile("" ::: "memory");
#pragma unroll
                for (int j = 0; j < 8; ++j) y[j] += *(const GAS f32x4*)(Yc + ((size_t)k * CTXL + (r - SEQ)) * DM + 4 * ln_ + 256 * j); }
        }
        const GAS float* gt = modp + NMOD + gate_chunk * DM; const GAS float* shp = modh + NMOD + sh_chunk * DM; const GAS float* scp = modh + NMOD + sc_chunk * DM;
        THIN_ROW_BODY(gt, gpost, gpre, shp, scp, THIN_LDG, THIN_YF);
    }
}
__device__ __forceinline__ float gelu_tanh(float x) { const float u = 1.5957691216f * (x + 0.044715f * x * x * x); return x / (1.0f + __expf(-u)); }
__device__ __forceinline__ void phase_a2(Frame& F, const Args& args) {
    relane(F);
    const GAS bf16* yf = (const GAS bf16*)(WSP(WS_OF)); const GAS bf16* yb = (const GAS bf16*)(WSP(WS_OB)); GAS bf16* z = (GAS bf16*)(WSP(WS_Z));
    LAS unsigned char* L = F.lds + RING_OFF;
    const int lane = F.lane, wave = F.wave, rl = lane >> 1, hf = lane & 1, rr = lane >> 4, c16 = lane & 15;
    int it = 0;
    for (int u = F.vcu; u < (MTOT / 32) * 16; u += F.G, ++it) {
        const int rb = u >> 4, gb = u & 15, g = gb * 8 + wave, r0 = rb * 32;
        const size_t off = ((size_t)g * MTOT + r0 + rl) * 16 + 8 * hf;
        const v4u a = *(const GAS v4u*)(yf + off), b = *(const GAS v4u*)(yb + off); v4u o;
#pragma unroll
        for (int j = 0; j < 4; ++j) { const float lo = gelu_tanh(bflo(a[j]) + bflo(b[j])), hi = gelu_tanh(bfhi(a[j]) + bfhi(b[j])); o[j] = pkbf(lo, hi); }
        LAS unsigned char* T = L + (it & 1) * (32 * 272);
        *(LAS v4u*)(T + rl * 272 + wave * 32 + hf * 16) = o;
        __syncthreads();
        const v4u w = *(const LAS v4u*)(T + (4 * wave + rr) * 272 + c16 * 16);
        *(GAS v4u*)(z + (size_t)(r0 + 4 * wave + rr) * DM + gb * 128 + c16 * 8) = w;
    }
    __syncthreads();
}
__device__ __forceinline__ void phase_a4(Frame& F, const Args& args, const GAS float* onorm) {
    relane(F);
    const GAS bf16* OFp = (const GAS bf16*)(WSP(WS_OF)); const GAS bf16* OBp = (const GAS bf16*)(WSP(WS_OB)); const GAS bf16* SG = (const GAS bf16*)(WSP(WS_SG)); GAS bf16* Z = (GAS bf16*)(WSP(WS_Z));
    const int gw = F.vcu * NWAVES + F.wave, NGW = F.G * NWAVES;
    for (int r = gw; r < MTOT; r += NGW) {
#pragma unroll
        for (int j = 0; j < 8; ++j) { const size_t off = (size_t)r * DM + 4 * F.lane + 256 * j;
            const v2u a = *(const GAS v2u*)(OFp + off), b = *(const GAS v2u*)(OBp + off);
            const f32x4 o = {bflo(a.x) + bflo(b.x), bfhi(a.x) + bfhi(b.x), bflo(a.y) + bflo(b.y), bfhi(a.y) + bfhi(b.y)};
            float s = (o.x * o.x + o.y * o.y) + (o.z * o.z + o.w * o.w);
#pragma unroll
            for (int d = 1; d < 32; d <<= 1) s += xshfl(s, F.lane, d);
            const float rs = 1.0f / sqrtf(s * (1.0f / 128.0f) + NEPS);
            const f32x4 gn = *(const GAS f32x4*)(onorm + 4 * F.lane + 256 * j); const v2u sg = *(const GAS v2u*)(SG + off);
            v2u w; w.x = pkbf(o.x * rs * gn.x * bflo(sg.x), o.y * rs * gn.y * bfhi(sg.x)); w.y = pkbf(o.z * rs * gn.z * bflo(sg.y), o.w * rs * gn.w * bfhi(sg.y));
            *(GAS v2u*)(Z + off) = w; }
    }
}

constexpr int S5_W8 = 0, S5_FB = 32768, S5_V8 = 32768, S5_T8 = 65536, S5_PAR = 98304;
constexpr int S5P_LAMP = 0, S5P_BB = 4608, S5P_CM = 4608 + 8192, S5P_L72 = 4608 + 16384, S5P_DSK = S5P_L72 + 512;
constexpr int S5_NSTEP = 9, S5_SLEN = 72;
__device__ __forceinline__ f32x2 cmul(f32x2 a, f32x2 b) { return (f32x2){a.x * b.x - a.y * b.y, a.x * b.y + a.y * b.x}; }
__device__ __forceinline__ int s5_row(int pos, int d) { if (pos < CTXL) return SEQ + (d ? CTXL - 1 - pos : pos); const int r = pos - CTXL; return d ? SEQ - 1 - r : r; }

__device__ __forceinline__ void phase_s5(Frame& F, const Args& args, int j) {
    relane(F);
    LAS unsigned char* L = F.lds + RING_OFF;
    LAS f32x2* LAMP = (LAS f32x2*)(L + S5_PAR + S5P_LAMP); LAS f32x2* BB = (LAS f32x2*)(L + S5_PAR + S5P_BB); LAS f32x2* CM = (LAS f32x2*)(L + S5_PAR + S5P_CM);
    LAS f32x2* L72 = (LAS f32x2*)(L + S5_PAR + S5P_L72); LAS float* DSK = (LAS float*)(L + S5_PAR + S5P_DSK);
    LAS f32x2* FB = (LAS f32x2*)(L + S5_FB);
    const int tid = F.tid, lane = F.lane, wave = F.wave, nl = lane & 15, q = lane >> 4;
    for (int it = F.vcu; it < 256; it += F.G) {
        const int g = it >> 1, d = it & 1, pi = (j * 2 + d) * 128 + g;
        const GAS bf16* H = (const GAS bf16*)(WSP(WS_H)) + (size_t)g * MTOT * 16;
        GAS bf16* Yo = (GAS bf16*)(opq(F.ws) + (d == 0 ? WS_OF : WS_OB)) + (size_t)g * MTOT * 16;
        if (tid < 64) {
            const int p = tid;
            const float dt = expf(AIN(14)[pi]); const float ar = AIN(12)[pi * 64 + p], ai = AIN(13)[pi * 64 + p];
            const float xr = ar * dt, yi = ai * dt;
            float tt = yi * 0.15915494309189535f; tt -= rintf(tt); const float ang = tt * 6.283185307179586f;
            const float cs = cosf(ang), sn = sinf(ang), ex = expf(xr), em1 = expm1f(xr), sh = sinf(0.5f * ang);
            const f32x2 lam1 = {ex * cs, ex * sn};
            const float nr = em1 * cs - 2.0f * sh * sh, ni = ex * sn;
            const float den = 1.0f / (ar * ar + ai * ai);
            const f32x2 kap = {(nr * ar + ni * ai) * den, (ni * ar - nr * ai) * den};
            f32x2 z = {1.0f, 0.0f};
#pragma unroll
            for (int k = 0; k < 9; ++k) { LAMP[k * 64 + p] = z; if (k < 8) z = cmul(z, lam1); }
            f32x2 z72 = z;
#pragma unroll
            for (int k = 0; k < 8; ++k) z72 = cmul(z72, z);
            L72[p] = z72;
#pragma unroll
            for (int h = 0; h < 16; ++h) { const f32x2 b = {AIN(15)[((size_t)pi * 64 + p) * 16 + h], AIN(16)[((size_t)pi * 64 + p) * 16 + h]}; BB[p * 16 + h] = cmul(kap, b); }
        }
        for (int i = tid; i < 1024; i += NTHR) { CM[i] = (f32x2){AIN(17)[(size_t)pi * 1024 + i], AIN(18)[(size_t)pi * 1024 + i]}; }
        if (tid < 16) DSK[tid] = (d == 0) ? AIN(19)[j * DM + g * 16 + tid] : 0.0f;
        __syncthreads();
#pragma unroll
        for (int i = 0; i < 4; ++i) {
            const int f = (tid >> 6) + 8 * i, mb = f >> 2, ks = f & 3, p = 16 * (mb >> 1) + nl, part = mb & 1, jj = 2 * ks + (q >> 1), h0 = 8 * (q & 1);
            const f32x2 lp = LAMP[(7 - jj) * 64 + p];
            float v[8];
#pragma unroll
            for (int e = 0; e < 8; ++e) { const f32x2 z = cmul(lp, BB[p * 16 + h0 + e]); v[e] = part ? z.y : z.x; }
            v4u o; o.x = pkbf(v[0], v[1]); o.y = pkbf(v[2], v[3]); o.z = pkbf(v[4], v[5]); o.w = pkbf(v[6], v[7]);
            *(LAS v4u*)(L + S5_W8 + (f * 64 + lane) * 16) = o;
        }
        __syncthreads();
        const int n = 16 * wave + nl, pos0 = S5_SLEN * n;
#define S5_LOADU(U, b) do { _Pragma("unroll") for (int ks = 0; ks < 4; ++ks) { int pos = pos0 + 8 * (b) + 2 * ks + (q >> 1); asm volatile("" : "+v"(pos)); const bool ok = pos < MTOT; \
            const int row = s5_row(ok ? pos : 0, d); v4u w = *(const GAS v4u*)(H + (size_t)row * 16 + 8 * (q & 1)); if (!ok) w = (v4u){0u, 0u, 0u, 0u}; U[ks] = __builtin_bit_cast(bf16x8, w); } } while (0)
#define S5_AFRAG(base, f) (*(const LAS bf16x8*)(L + (base) + (f) * 1024 + lofs))
#define S5_MFMA(a, b, c) __builtin_amdgcn_mfma_f32_16x16x32_bf16((a), (b), (c), 0, 0, 0)
#define S5_UPDATE() do { _Pragma("unroll") for (int t = 0; t < 4; ++t) { const LAS f32x4* lp_ = (const LAS f32x4*)(L + S5_PAR + S5P_LAMP + (8 * 64 + 16 * t) * 8 + zofs + q * 32); const f32x4 la_ = lp_[0], lb_ = lp_[1]; \
            const float l8r_[4] = {la_[0], la_[2], lb_[0], lb_[2]}, l8i_[4] = {la_[1], la_[3], lb_[1], lb_[3]}; \
            _Pragma("unroll") for (int r = 0; r < 4; ++r) { \
            const float nr_ = l8r_[r] * Sre[t][r] - l8i_[r] * Sim[t][r] + acc[2 * t][r], ni_ = l8r_[r] * Sim[t][r] + l8i_[r] * Sre[t][r] + acc[2 * t + 1][r]; Sre[t][r] = nr_; Sim[t][r] = ni_; } } } while (0)
        f32x4 Sre[4], Sim[4];
#pragma unroll
        for (int t = 0; t < 4; ++t) { Sre[t] = (f32x4){0.f, 0.f, 0.f, 0.f}; Sim[t] = (f32x4){0.f, 0.f, 0.f, 0.f}; }
        {
            bf16x8 U[4]; S5_LOADU(U, 0);
            for (int b = 0; b < S5_NSTEP; ++b) {
                int lofs = lane * 16; asm volatile("" : "+v"(lofs)); int zofs = 0; asm volatile("" : "+v"(zofs));
                bf16x8 Un[4];
                if (b + 1 < S5_NSTEP) S5_LOADU(Un, b + 1); else { _Pragma("unroll") for (int ks = 0; ks < 4; ++ks) Un[ks] = U[ks]; }
                f32x4 acc[8];
#pragma unroll
                for (int mb = 0; mb < 8; ++mb) { acc[mb] = (f32x4){0.f, 0.f, 0.f, 0.f};
#pragma unroll
                    for (int ks = 0; ks < 4; ++ks) acc[mb] = S5_MFMA(S5_AFRAG(S5_W8, mb * 4 + ks), U[ks], acc[mb]);
                    if (mb & 1) asm volatile("" ::: "memory"); }
                S5_UPDATE();
#pragma unroll
                for (int ks = 0; ks < 4; ++ks) U[ks] = Un[ks];
            }
        }
#pragma unroll
        for (int t = 0; t < 4; ++t) { LAS f32x4* o = (LAS f32x4*)(FB + n * 64 + 16 * t + 4 * q);
            o[0] = (f32x4){Sre[t][0], Sim[t][0], Sre[t][1], Sim[t][1]}; o[1] = (f32x4){Sre[t][2], Sim[t][2], Sre[t][3], Sim[t][3]}; }
        __syncthreads();
        if (wave == 0) {
            const f32x2 l72 = L72[lane]; f32x2 I = {0.f, 0.f};
            for (int n0 = 0; n0 < 128; n0 += 8) {
                f32x2 fv[8];
#pragma unroll
                for (int k = 0; k < 8; ++k) fv[k] = FB[(n0 + k) * 64 + lane];
#pragma unroll
                for (int k = 0; k < 8; ++k) { FB[(n0 + k) * 64 + lane] = I; I = cmul(l72, I) + fv[k]; }
            }
        }
        __syncthreads();
#pragma unroll
        for (int t = 0; t < 4; ++t) { const LAS f32x4* o = (const LAS f32x4*)(FB + n * 64 + 16 * t + 4 * q); const f32x4 a = o[0], b = o[1];
            Sre[t] = (f32x4){a[0], a[2], b[0], b[2]}; Sim[t] = (f32x4){a[1], a[3], b[1], b[3]}; }
        __syncthreads();
#pragma unroll
        for (int i = 0; i < 4; ++i) {
            const int f = (tid >> 6) + 8 * i, im = f >> 2, ks = f & 3, h = nl;
            float v[8];
#pragma unroll
            for (int e = 0; e < 4; ++e) { const int p = 16 * ks + 4 * q + e; const f32x2 z = cmul(CM[h * 64 + p], LAMP[(im + 1) * 64 + p]); v[e] = z.x; v[4 + e] = -z.y; }
            v4u o; o.x = pkbf(v[0], v[1]); o.y = pkbf(v[2], v[3]); o.z = pkbf(v[4], v[5]); o.w = pkbf(v[6], v[7]);
            *(LAS v4u*)(L + S5_V8 + (f * 64 + lane) * 16) = o;
        }
        {
            const int lag = tid >> 6, h = (tid >> 2) & 15, hq = tid & 3;
            float v[4] = {0.f, 0.f, 0.f, 0.f};
#pragma unroll 4
            for (int p = 0; p < 64; ++p) { const f32x2 cl = cmul(CM[h * 64 + p], LAMP[lag * 64 + p]);
                const LAS f32x4* bp = (const LAS f32x4*)(BB + p * 16 + 4 * hq); const f32x4 b0 = bp[0], b1 = bp[1];
                v[0] += cl.x * b0[0] - cl.y * b0[1]; v[1] += cl.x * b0[2] - cl.y * b0[3]; v[2] += cl.x * b1[0] - cl.y * b1[1]; v[3] += cl.x * b1[2] - cl.y * b1[3]; }
            if (lag == 0) {
#pragma unroll
                for (int e = 0; e < 4; ++e) if (4 * hq + e == h) v[e] += DSK[h];
            }
            v2u o; o.x = pkbf(v[0], v[1]); o.y = pkbf(v[2], v[3]);
            const int q0 = hq >> 1, eo = 4 * (hq & 1);
            *(LAS v2u*)(L + S5_T8 + (lag * 64 + h + 16 * q0) * 16 + eo * 2) = o;
            if (lag < 7) *(LAS v2u*)(L + S5_T8 + ((lag + 1) * 64 + h + 16 * (2 + q0)) * 16 + eo * 2) = o;
            if (lag == 0) *(LAS v2u*)(L + S5_T8 + (h + 16 * (2 + q0)) * 16 + eo * 2) = (v2u){0u, 0u};
        }
        __syncthreads();
        {
            bf16x8 T8r[8];
#pragma unroll
            for (int f = 0; f < 8; ++f) T8r[f] = *(const LAS bf16x8*)(L + S5_T8 + (f * 64 + lane) * 16);
            bf16x8 U[4]; S5_LOADU(U, 0);
            for (int b = 0; b < S5_NSTEP; ++b) {
                int lofs = lane * 16; asm volatile("" : "+v"(lofs)); int zofs = 0; asm volatile("" : "+v"(zofs));
                bf16x8 Un[4];
                if (b + 1 < S5_NSTEP) S5_LOADU(Un, b + 1); else { _Pragma("unroll") for (int ks = 0; ks < 4; ++ks) Un[ks] = U[ks]; }
                bf16x8 BS[4];
#pragma unroll
                for (int ks = 0; ks < 4; ++ks) { v4u w; w.x = pkbf(Sre[ks][0], Sre[ks][1]); w.y = pkbf(Sre[ks][2], Sre[ks][3]); w.z = pkbf(Sim[ks][0], Sim[ks][1]); w.w = pkbf(Sim[ks][2], Sim[ks][3]); BS[ks] = __builtin_bit_cast(bf16x8, w); }
#pragma unroll
                for (int mb = 0; mb < 8; ++mb) {
                    f32x4 y = {0.f, 0.f, 0.f, 0.f};
#pragma unroll
                    for (int ks = 0; ks < 4; ++ks) if (2 * ks <= mb) y = S5_MFMA(T8r[mb - 2 * ks], U[ks], y);
#pragma unroll
                    for (int ks = 0; ks < 4; ++ks) y = S5_MFMA(S5_AFRAG(S5_V8, mb * 4 + ks), BS[ks], y);
                    asm volatile("" ::: "memory");
                    int pos = pos0 + 8 * b + mb; asm volatile("" : "+v"(pos));
                    if (pos < MTOT) { v2u o; o.x = pkbf(y[0], y[1]); o.y = pkbf(y[2], y[3]); *(GAS v2u*)(Yo + (size_t)s5_row(pos, d) * 16 + 4 * q) = o; }
                }
                f32x4 acc[8];
#pragma unroll
                for (int mb = 0; mb < 8; ++mb) { acc[mb] = (f32x4){0.f, 0.f, 0.f, 0.f};
#pragma unroll
                    for (int ks = 0; ks < 4; ++ks) acc[mb] = S5_MFMA(S5_AFRAG(S5_W8, mb * 4 + ks), U[ks], acc[mb]);
                    if (mb & 1) asm volatile("" ::: "memory"); }
                S5_UPDATE();
#pragma unroll
                for (int ks = 0; ks < 4; ++ks) U[ks] = Un[ks];
            }
        }
        __syncthreads();
#undef S5_LOADU
#undef S5_AFRAG
#undef S5_MFMA
#undef S5_UPDATE
    }
}
constexpr int HG_QP = 272;
constexpr int HG_KP = 64;
constexpr int HGR_QB = 0, HGR_KE = 8704, HGR_VT = HGR_KE + 128 * HG_KP, HGR_SC = HGR_VT + 128 * HG_KP, HGR_DEC = HGR_SC + 2048;
constexpr int HGL1_KB = 110592  , HGL1_TOT = 128000  ;
constexpr int HGL_RECB = 0  , HGL_OB = 110592  ;
constexpr int HG_OP = 272;
constexpr int HG_NCH = 33, HG_NCHT = 264;
__device__ __forceinline__ int hg_row(int p, int d) { if (p < CTXL) return SEQ + (d ? CTXL - 1 - p : p); int n = p - CTXL; if (d) n = SEQ - 1 - n; return (n & 127) * 64 + (n >> 7); }
#define HG_MFMA(a, b, c) __builtin_amdgcn_mfma_f32_16x16x32_bf16((a), (b), (c), 0, 0, 0)
#define HG_STATE_STEP(RB, vt) do { _Pragma("unroll") for (int mb = 0; mb < 8; ++mb) { \
        const bf16x8 a_ = *(const LAS bf16x8*)(L + (RB) + HGR_KE + (16 * mb + r16) * HG_KP + qd * 16 + zofs); \
        const f32x4 u_ = HG_MFMA(a_, vt, ((f32x4){0.f, 0.f, 0.f, 0.f})); \
        const f32x4 dc_ = *(const LAS f32x4*)(L + (RB) + HGR_DEC + (16 * mb + 4 * qd) * 4 + zofs); S[mb] = dc_ * S[mb] + u_; } } while (0)

constexpr int HGP_REC = HGR_DEC + 512;
constexpr int HGP_KB = 2 * HGP_REC, HGP_TOT = HGP_KB + 2 * 8704, HGP_OB = HGP_TOT + 4096, HGP_END = HGP_OB + 2 * 32 * HG_OP;
static_assert(HGP_END <= RING_BYTES, "HGRN pass LDS");
template <bool FULL>
__device__ __forceinline__ void hg_pass(Frame& F, const Args& args) {
    relane(F);
    LAS unsigned char* L = F.lds + RING_OFF;
    const int wave = F.wave;
    LAS float* TOTS = (LAS float*)(L + HGP_TOT);
#define HG_TIDS() int tid = F.tid; asm volatile("" : "+v"(tid)); const int lane = tid & 63, r16 = lane & 15, qd = lane >> 4, kk = tid & 127, sq = tid >> 7, kl = kk & 31, pcol = (kk & ~31) + 8 * ((kl >> 2) & 3) + 4 * (kl >> 4) + (kl & 3); (void)r16; (void)qd; (void)pcol; (void)lane
    for (int it = F.vcu; it < 256; it += F.G) {
        const int hd = it >> 4, d = (it >> 3) & 1, sg = it & 7, hdd = hd * 2 + d;
        const GAS bf16* LG = (const GAS bf16*)(opq(F.ws) + (d ? WS_LB : WS_LF)) + hd * 128;
        const GAS bf16* Qp = (const GAS bf16*)(WSP(WS_Q)) + hd * 128; const GAS bf16* Vp = (const GAS bf16*)(WSP(WS_V)) + hd * 128;
        GAS bf16* O = (GAS bf16*)(opq(F.ws) + (d ? WS_OB : WS_OF)) + hd * 128;
        f32x4 S[8];
#pragma unroll
        for (int mb = 0; mb < 8; ++mb) S[mb] = (f32x4){0.f, 0.f, 0.f, 0.f};
        if (FULL) { HG_TIDS();
            f32x4 P[8], fv[8], dv[8];
#pragma unroll
            for (int mb = 0; mb < 8; ++mb) P[mb] = (f32x4){1.f, 1.f, 1.f, 1.f};
#define HG_SLOAD(s2_) do { const int sc_ = (s2_) >= 0 ? (s2_) : 0; const GAS f32x4* sp_ = (const GAS f32x4*)(opq(F.ws) + WS_SEGS) + ((size_t)((hdd * 8 + sc_) * 8 + wave) * 8) * 64 + lane; \
                const GAS float* dp_ = (const GAS float*)(opq(F.ws) + WS_SEGD) + (hdd * 8 + sc_) * 128 + 4 * qd; \
                _Pragma("unroll") for (int mb = 0; mb < 8; ++mb) { fv[mb] = sp_[mb * 64]; dv[mb] = *(const GAS f32x4*)(dp_ + 16 * mb); } } while (0)
            HG_SLOAD(sg - 1);
            for (int s2 = sg - 1; s2 >= 0; --s2) {
                f32x4 fc[8], dc[8];
#pragma unroll
                for (int mb = 0; mb < 8; ++mb) { fc[mb] = fv[mb]; dc[mb] = dv[mb]; }
                HG_SLOAD(s2 - 1);
#pragma unroll
                for (int mb = 0; mb < 8; ++mb) { S[mb] += P[mb] * fc[mb]; P[mb] *= dc[mb]; }
            }
#undef HG_SLOAD
        }
        float dsum = 0.f;
        float lf[2][8]; unsigned qv[2][8];
#define HG_INLOAD(cp) do { _Pragma("unroll") for (int h = 0; h < 2; ++h) { int c_ = 2 * (cp) + h; c_ = c_ < HG_NCH ? c_ : HG_NCH - 1; int p0_ = (sg * HG_NCH + c_) * 32 + 8 * sq; asm volatile("" : "+v"(p0_)); \
              \
            const int row0_ = hg_row(p0_, d), step_ = (p0_ < CTXL ? 1 : 64) * (d ? -1 : 1); unsigned off_ = (unsigned)row0_ * DM + kk; const int dstep_ = step_ * DM; \
            _Pragma("unroll") for (int i = 0; i < 8; ++i) { lf[h][i] = bf1(LG[off_]); qv[h][i] = (FULL ? (unsigned)Qp[off_] : 0u) | ((unsigned)Vp[off_] << 16); off_ += dstep_; } } } while (0)
#define HG_OSTORE(c, h) do { int p_ = (sg * HG_NCH + (c)) * 32 + (tid >> 4); asm volatile("" : "+v"(p_)); const v4u o_ = *(const LAS v4u*)(L + HGP_OB + (h) * (32 * HG_OP) + (tid >> 4) * HG_OP + (tid & 15) * 16); \
            *(GAS v4u*)(O + (size_t)hg_row(p_, d) * DM + 8 * (tid & 15)) = o_; } while (0)
        { HG_TIDS(); HG_INLOAD(0); }
        for (int cp = 0; cp < (HG_NCH + 1) / 2; ++cp) {
            HG_TIDS();
            int zofs = 0; asm volatile("" : "+v"(zofs));
            float cs[2][8];
#pragma unroll
            for (int h = 0; h < 2; ++h) { float run = 0.f;
#pragma unroll
                for (int i = 0; i < 8; ++i) { run += lf[h][i]; cs[h][i] = run; }
                TOTS[(h * 4 + sq) * 128 + kk] = run; }
            __syncthreads();
            if (FULL && cp > 0) { HG_OSTORE(2 * cp - 2, 0); HG_OSTORE(2 * cp - 1, 1); }
#pragma unroll
            for (int h = 0; h < 2; ++h) {
                const int RB = h * HGP_REC, KB = HGP_KB + h * (32 * HG_QP);
                const float t0 = TOTS[(h * 4 + 0) * 128 + kk], t1 = TOTS[(h * 4 + 1) * 128 + kk], t2 = TOTS[(h * 4 + 2) * 128 + kk], t3 = TOTS[(h * 4 + 3) * 128 + kk];
                const float offc = (sq > 0 ? t0 : 0.f) + (sq > 1 ? t1 : 0.f) + (sq > 2 ? t2 : 0.f), tot = (t0 + t1) + (t2 + t3), dec = __expf(tot);
                float ke[8];
#pragma unroll
                for (int i = 0; i < 8; ++i) { const float cum = cs[h][i] + offc, kv = 1.0f - __expf(i ? cs[h][i] - cs[h][i - 1] : cs[h][0]);
                    const float kb = kv * __expf(-cum); ke[i] = kb * dec;
                    if (FULL) { const float qb = bflo(qv[h][i]) * __expf(cum);
                        *(LAS bf16*)(L + RB + HGR_QB + (8 * sq + i) * HG_QP + pcol * 2) = (bf16)(pkbf(qb, 0.f) & 0xffffu);
                        *(LAS bf16*)(L + KB + (8 * sq + i) * HG_QP + pcol * 2) = (bf16)(pkbf(kb, 0.f) & 0xffffu); } }
                { v4u o; o.x = pkbf(ke[0], ke[1]); o.y = pkbf(ke[2], ke[3]); o.z = pkbf(ke[4], ke[5]); o.w = pkbf(ke[6], ke[7]);
                  *(LAS v4u*)(L + RB + HGR_KE + kk * HG_KP + sq * 16) = o;
                  v4u w; w.x = (qv[h][0] >> 16) | (qv[h][1] & 0xffff0000u); w.y = (qv[h][2] >> 16) | (qv[h][3] & 0xffff0000u); w.z = (qv[h][4] >> 16) | (qv[h][5] & 0xffff0000u); w.w = (qv[h][6] >> 16) | (qv[h][7] & 0xffff0000u);
                  *(LAS v4u*)(L + RB + HGR_VT + kk * HG_KP + sq * 16) = w; }
                if (sq == 0) { *(LAS float*)(L + RB + HGR_DEC + kk * 4) = dec; if (!FULL && 2 * cp + h < HG_NCH) dsum += tot; }
            }
            HG_INLOAD(cp + 1);
            __syncthreads();
            if (FULL) {
                const int h = wave >> 2, w4 = wave & 3, mblk = w4 >> 1, nblk = w4 & 1; const int RB = h * HGP_REC, KB = HGP_KB + h * (32 * HG_QP);
                f32x4 acc = {0.f, 0.f, 0.f, 0.f};
#pragma unroll
                for (int ks = 0; ks < 4; ++ks) { const bf16x8 a = *(const LAS bf16x8*)(L + RB + HGR_QB + (16 * mblk + r16) * HG_QP + (32 * ks + 8 * qd) * 2 + zofs);
                    const bf16x8 b = *(const LAS bf16x8*)(L + KB + (16 * nblk + r16) * HG_QP + (32 * ks + 8 * qd) * 2 + zofs); acc = HG_MFMA(a, b, acc); }
#pragma unroll
                for (int r = 0; r < 4; ++r) { const int cc = 16 * mblk + 4 * qd + r, ss = 16 * nblk + r16; const float v = ss <= cc ? acc[r] : 0.f;
                    *(LAS bf16*)(L + RB + HGR_SC + (cc * 32 + ss) * 2) = (bf16)(pkbf(v, 0.f) & 0xffffu); }
                __syncthreads();
            }
#pragma unroll
            for (int h = 0; h < 2; ++h) if (2 * cp + h < HG_NCH) { const int RB = h * HGP_REC;
                const bf16x8 vt = *(const LAS bf16x8*)(L + RB + HGR_VT + (16 * wave + r16) * HG_KP + qd * 16 + zofs);
                if (FULL) {
                    bf16x8 BS[4];
#pragma unroll
                    for (int ks = 0; ks < 4; ++ks) { v4u w; w.x = pkbf(S[2 * ks][0], S[2 * ks][1]); w.y = pkbf(S[2 * ks][2], S[2 * ks][3]); w.z = pkbf(S[2 * ks + 1][0], S[2 * ks + 1][1]); w.w = pkbf(S[2 * ks + 1][2], S[2 * ks + 1][3]);
                        BS[ks] = __builtin_bit_cast(bf16x8, w); }
#pragma unroll
                    for (int mblk = 0; mblk < 2; ++mblk) {
                        f32x4 o = {0.f, 0.f, 0.f, 0.f};
                        { const bf16x8 a = *(const LAS bf16x8*)(L + RB + HGR_SC + (16 * mblk + r16) * 64 + qd * 16 + zofs); o = HG_MFMA(a, vt, o); }
#pragma unroll
                        for (int ks = 0; ks < 4; ++ks) { const bf16x8 a = *(const LAS bf16x8*)(L + RB + HGR_QB + (16 * mblk + r16) * HG_QP + (32 * ks + 8 * qd) * 2 + zofs); o = HG_MFMA(a, BS[ks], o); }
#pragma unroll
                        for (int r = 0; r < 4; ++r) *(LAS bf16*)(L + HGP_OB + h * (32 * HG_OP) + (16 * mblk + 4 * qd + r) * HG_OP + (16 * wave + r16) * 2) = (bf16)(pkbf(o[r], 0.f) & 0xffffu);
                    }
                }
                HG_STATE_STEP(RB, vt); }
        }
        __syncthreads();
        if (FULL) { HG_TIDS(); HG_OSTORE(HG_NCH - 1, 0); }
        else { HG_TIDS(); GAS f32x4* sp = (GAS f32x4*)(opq(F.ws) + WS_SEGS) + ((size_t)((hdd * 8 + sg) * 8 + wave) * 8) * 64 + lane;
#pragma unroll
          for (int mb = 0; mb < 8; ++mb) sp[mb * 64] = S[mb];
          if (sq == 0) ((GAS float*)(opq(F.ws) + WS_SEGD))[(hdd * 8 + sg) * 128 + kk] = __expf(dsum); }
        __syncthreads();
#undef HG_INLOAD
#undef HG_OSTORE
    }
#undef HG_TIDS
}
__device__ __forceinline__ void phase_hg_r1(Frame& F, const Args& args) { hg_pass<false>(F, args); }
__device__ __forceinline__ void phase_hg_r2(Frame& F, const Args& args) { hg_pass<true>(F, args); }
template <int MT, int NB, int KS, int WR, class Epi>
__device__ __forceinline__ void ctx_gemm(Frame& F, const GAS bf16* A, const GAS bf16* Bt, int K, int ncolt, const Epi& E) {
    constexpr int WC = 8 / WR, MB = MT / (16 * WR), NBW = NB / WC, RT = 256 / MT, PITCH = 144, APIECES = MT * 8, BPIECES = NB * 16 * 8, NA = (APIECES + NTHR - 1) / NTHR, NBL = (BPIECES + NTHR - 1) / NTHR;
    constexpr int ABYTES = MT * PITCH, BBYTES = NB * 16 * PITCH, BUF = ABYTES + BBYTES;
    static_assert(3 * BUF <= RING_BYTES && NB % WC == 0 && MT % (16 * WR) == 0, "ctx_gemm geometry");
    relane(F);
    LAS unsigned char* L = F.lds + RING_OFF;
    const int tid = F.tid, lane = F.lane, wave = F.wave, r16 = lane & 15, qd = lane >> 4, wr = wave / WC, wc = wave % WC;
    const int units = RT * ncolt * KS, klen = K / KS, nkt = klen / 64;
    for (int u = F.vcu; u < units; u += F.G) {
        const int ks = u % KS, t = u / KS, rt = t % RT, ct = t / RT;
        const int rowb = rt * MT;
        const GAS bf16* ga[NA]; const GAS bf16* gb[NBL]; int la[NA], lb[NBL]; bool oka[NA], okb[NBL];
#pragma unroll
        for (int j = 0; j < NA; ++j) { const int i = tid + NTHR * j, row = i >> 3, ch = i & 7; oka[j] = i < APIECES; const int rr = oka[j] ? row : 0; ga[j] = A + (size_t)(rowb + rr) * K + ks * klen + 8 * ch; la[j] = rr * PITCH + ch * 16; }
#pragma unroll
        for (int j = 0; j < NBL; ++j) { const int i = tid + NTHR * j, row = i >> 3, ch = i & 7; okb[j] = i < BPIECES; const int rr = okb[j] ? row : 0;
            gb[j] = Bt + (size_t)E.brow(ct, rr >> 4, rr & 15) * K + ks * klen + 8 * ch; lb[j] = ABYTES + rr * PITCH + ch * 16; }
        v4u ra[2][NA], rb[2][NBL];
#define CG_LOAD(P, kt) do { _Pragma("unroll") for (int j = 0; j < NA; ++j) ra[P][j] = *(const GAS v4u*)(ga[j] + (kt) * 64); _Pragma("unroll") for (int j = 0; j < NBL; ++j) rb[P][j] = *(const GAS v4u*)(gb[j] + (kt) * 64); } while (0)
#define CG_STORE(P, bo) do { _Pragma("unroll") for (int j = 0; j < NA; ++j) if (oka[j]) *(LAS v4u*)(L + (bo) + la[j]) = ra[P][j]; _Pragma("unroll") for (int j = 0; j < NBL; ++j) if (okb[j]) *(LAS v4u*)(L + (bo) + lb[j]) = rb[P][j]; } while (0)
#define CG_COMPUTE(bo) do { _Pragma("unroll") for (int k2 = 0; k2 < 2; ++k2) { bf16x8 a[MB], b[NBW]; \
            _Pragma("unroll") for (int mb = 0; mb < MB; ++mb) a[mb] = *(const LAS bf16x8*)(L + (bo) + (wr * (MT / WR) + 16 * mb + r16) * PITCH + (4 * k2 + qd) * 16); \
            _Pragma("unroll") for (int nb = 0; nb < NBW; ++nb) b[nb] = *(const LAS bf16x8*)(L + (bo) + ABYTES + (16 * (wc + WC * nb) + r16) * PITCH + (4 * k2 + qd) * 16); \
            _Pragma("unroll") for (int mb = 0; mb < MB; ++mb) _Pragma("unroll") for (int nb = 0; nb < NBW; ++nb) acc[mb][nb] = __builtin_amdgcn_mfma_f32_16x16x32_bf16(a[mb], b[nb], acc[mb][nb], 0, 0, 0); } } while (0)
        f32x4 acc[MB][NBW];
#pragma unroll
        for (int mb = 0; mb < MB; ++mb)
#pragma unroll
            for (int nb = 0; nb < NBW; ++nb) acc[mb][nb] = (f32x4){0.f, 0.f, 0.f, 0.f};
        CG_LOAD(0, 0); CG_LOAD(1, 1); CG_STORE(0, 0);
        __syncthreads();
        for (int kt = 0; kt < nkt; kt += 2) {
            { const int b0 = (kt % 3) * BUF, b1 = ((kt + 1) % 3) * BUF;
              if (kt + 2 < nkt) CG_LOAD(0, kt + 2);
              CG_COMPUTE(b0);
              CG_STORE(1, b1);
              __syncthreads(); }
            { const int b1 = ((kt + 1) % 3) * BUF, b2 = ((kt + 2) % 3) * BUF;
              if (kt + 3 < nkt) CG_LOAD(1, kt + 3);
              CG_COMPUTE(b1);
              if (kt + 2 < nkt) CG_STORE(0, b2);
              __syncthreads(); }
        }
#undef CG_LOAD
#undef CG_STORE
#undef CG_COMPUTE
        const int row0 = rowb + wr * (MT / WR);
#pragma unroll
        for (int mb = 0; mb < MB; ++mb) E.store(acc[mb], row0 + 16 * mb + 4 * qd, ct, ks, r16, wc);
    }
}
struct CtxRelu2 {
    GAS bf16* O;
    __device__ __forceinline__ int brow(int ct, int nb, int r) const { return 64 * ct + 16 * nb + r; }
    __device__ __forceinline__ void store(const f32x4 (&acc)[2], int row, int ct, int ks, int r, int wc) const {
#pragma unroll
        for (int t = 0; t < 2; ++t)
#pragma unroll
            for (int g = 0; g < 4; ++g) { const float v = fmaxf(acc[t][g], 0.f); O[(size_t)(SEQ + row + g) * HID + 64 * ct + 16 * (wc + 2 * t) + r] = (bf16)(pkbf(v * v, 0.f) & 0xffffu); }
    }
};
struct CtxGlu {
    GAS float* Y;
    __device__ __forceinline__ int brow(int ct, int nb, int r) const { const int c = 32 * ct + 16 * (nb & 1) + r; return 256 * (c >> 7) + (c & 127) + 128 * (nb >> 1); }
    __device__ __forceinline__ void store(const f32x4 (&acc)[2], int row, int ct, int ks, int r, int wc) const {
#pragma unroll
        for (int g = 0; g < 4; ++g) Y[(size_t)(row + g) * DM + 32 * ct + 16 * wc + r] = acc[0][g] * pg8::sigmoid_f(acc[1][g]);
    }
};
struct CtxPart {
    GAS float* YP;
    __device__ __forceinline__ int brow(int ct, int nb, int r) const { return 64 * ct + 16 * nb + r; }
    __device__ __forceinline__ void store(const f32x4 (&acc)[2], int row, int ct, int ks, int r, int wc) const {
#pragma unroll
        for (int t = 0; t < 2; ++t)
#pragma unroll
            for (int g = 0; g < 4; ++g) YP[((size_t)ks * CTXL + row + g) * DM + 64 * ct + 16 * (wc + 2 * t) + r] = acc[t][g];
    }
};
struct CtxHgIn {
    GAS bf16* Q; size_t hstride; GAS bf16* LF; size_t fstride; const GAS float* lbv;
    __device__ __forceinline__ int brow(int ct, int nb, int r) const { return 80 * ct + 16 * nb + r; }
    __device__ __forceinline__ void store(const f32x4 (&acc)[5], int row, int ct, int ks, int r, int  ) const {
#pragma unroll
        for (int nb = 0; nb < 5; ++nb) { const int col = 80 * ct + 16 * nb + r, typ = col >> 11, cc = col & 2047;
            if (typ == 2 || typ == 3) { const float lb = lbv[(typ - 2) * 2048 + cc], llb = lb > 0.f ? logf(lb) : 0.f; GAS bf16* O = LF + (size_t)(typ - 2) * fstride;
#pragma unroll
                for (int g = 0; g < 4; ++g) O[(size_t)(SEQ + row + g) * DM + cc] = (bf16)(pkbf(pg8::logf_gate(acc[nb][g], lb, llb), 0.f) & 0xffffu);
            } else { GAS bf16* O = Q + (size_t)((typ >> 2) * 2 + (typ & 1)) * hstride;
#pragma unroll
                for (int g = 0; g < 4; ++g) { const float v = acc[nb][g], w = typ == 1 ? v : pg8::silu_f(v); O[(size_t)(SEQ + row + g) * DM + cc] = (bf16)(pkbf(w, 0.f) & 0xffffu); } }
        }
    }
};

#if MK_PER_PHASE
#define IN(k) (args.ph_lo <= (k) && (k) < args.ph_hi)
#else
#define IN(k) true
#endif
#define SEAM(k) do { if (IN(k) && IN((k) + 1)) { if (!MK_PER_PHASE) xcd_barrier(bar); } } while (0)
#define MOD ((const GAS float*)(WSP(WS_MOD)))
#define Hb ((const GAS bf16*)(WSP(WS_H)))
#define Zb ((const GAS bf16*)(WSP(WS_Z)))
#define HIDb ((const GAS bf16*)(WSP(WS_HID)))
#define Y1 ((GAS bf16*)(WSP(WS_Y1)))
#define Y2 ((GAS bf16*)(WSP(WS_Y2)))
#define YP1 ((GAS float*)(WSP(WS_YP1)))
#define YP2 ((GAS float*)(WSP(WS_YP2)))
#define CTXLIVE (pair == 0)

template <int pair>
__device__ __forceinline__ void layer_pair(Frame& F, const Args& args, const XcdBarrier& bar) {
        const int base = 2 + 16 * pair, l0 = 2 * pair, l1 = l0 + 1, j = pair;
        relane(F); F.ws = opq(F.ws);
#define mod0 (MOD + (size_t)l0 * 2 * NMOD)
#define mod1 (MOD + (size_t)l1 * 2 * NMOD)
#define modp (MOD + (size_t)(l0 - 1) * 2 * NMOD)
        if (IN(base + 0)) {
            if (pair == 0) thin_rn<0, 1, false, true>(F, args, nullptr, nullptr, MTOT, nullptr, nullptr, 0, AIN(6) + l0 * DM, mod0, 0, 1);
            else { if (REP_RN) { thin_rn<1, 4, true, true>(F, args, Y2, YP2, MTOT, AIN(9) + (l0 - 1) * DM, modp, 5, AIN(6) + l0 * DM, mod0, 0, 1); } thin_rn<1, 4, false, true>(F, args, Y2, YP2, MTOT, AIN(9) + (l0 - 1) * DM, modp, 5, AIN(6) + l0 * DM, mod0, 0, 1); }
        } SEAM(base + 0);
        if (IN(base + 1)) {
            for (int rep = 0; rep <= REP_S5; ++rep) phase_s5(F, args, j);
        } SEAM(base + 1);
        if (IN(base + 2)) { for (int rep = 0; rep <= REP_THIN; ++rep) phase_a2(F, args); } SEAM(base + 2);
        if (IN(base + 3)) {
            pg8::Gemm g{(gen_cbf)(Zb), (gen_cbf)((const GAS bf16*)(WSP(WS_WGLU)) + (size_t)j * 4096 * DM), SEQ, 4096, DM}; pg8::StaticOrder S; S.init(SEQ, 4096, F.G, PG_CID, WGM_GLU);
            pg8::EpiGlu E{Y1, DM};
            for (int rep = 0; rep <= REP_GEMM + REP_GGLU; ++rep)
            pg8::gemm_phase<pg8::EpiGlu, pg8::StaticOrder, PG_ALIGN, PG_SP2>(F.lds + RING_OFF, g, S, E);
            { CtxGlu CE{YP1}; for (int rep = 0; rep <= REP_CTX; ++rep) ctx_gemm<64, 4, 1, 4>(F, Zb + (size_t)SEQ * DM, (const GAS bf16*)(WSP(WS_WGLU)) + (size_t)j * 4096 * DM, DM, 64, CE); }
        } SEAM(base + 3);
        if (IN(base + 4)) { if (REP_RN) { thin_rn<1, 1, true>(F, args, Y1, YP1, MTOT, AIN(7) + l0 * DM, mod0, 2, AIN(8) + l0 * DM, mod0, 3, 4); } thin_rn<1, 1>(F, args, Y1, YP1, MTOT, AIN(7) + l0 * DM, mod0, 2, AIN(8) + l0 * DM, mod0, 3, 4); } SEAM(base + 4);
        if (IN(base + 5)) {
            pg8::Gemm g{(gen_cbf)(Hb), (gen_cbf)((const GAS bf16*)(WSP(WS_W1)) + (size_t)l0 * HID * DM), SEQ, HID, DM}; pg8::StaticOrder S; S.init(SEQ, HID, F.G, PG_CID, WGM_IN);
            pg8::EpiRelu2 E{(GAS bf16*)(WSP(WS_HID)), HID};
            for (int rep = 0; rep <= REP_GEMM + REP_GIN; ++rep)
            pg8::gemm_phase<pg8::EpiRelu2, pg8::StaticOrder, PG_ALIGN, PG_SP2>(F.lds + RING_OFF, g, S, E);
            { CtxRelu2 CE{(GAS bf16*)(WSP(WS_HID))}; for (int rep = 0; rep <= REP_CTX; ++rep) ctx_gemm<128, 4, 1, 4>(F, Hb + (size_t)SEQ * DM, (const GAS bf16*)(WSP(WS_W1)) + (size_t)l0 * HID * DM, DM, 128, CE); }
        } SEAM(base + 5);
        if (IN(base + 6)) {
            pg8::Gemm g{(gen_cbf)(HIDb), (gen_cbf)((const GAS bf16*)(WSP(WS_W2)) + (size_t)l0 * DM * HID), SEQ, DM, HID}; pg8::StaticOrder S; S.init(SEQ, DM, F.G, PG_CID, WGM_OUT);
            pg8::EpiBf16P E{Y2, DM};
            for (int rep = 0; rep <= REP_GEMM + REP_GOUT; ++rep)
            pg8::gemm_phase<pg8::EpiBf16P, pg8::StaticOrder, PG_ALIGN, PG_SP2>(F.lds + RING_OFF, g, S, E);
            { CtxPart CE{YP2}; for (int rep = 0; rep <= REP_CTX; ++rep) ctx_gemm<128, 4, 4, 4>(F, HIDb + (size_t)SEQ * HID, (const GAS bf16*)(WSP(WS_W2)) + (size_t)l0 * DM * HID, HID, 32, CE); }
        } SEAM(base + 6);
        if (IN(base + 7)) { if (REP_RN) { thin_rn<1, 4, true>(F, args, Y2, YP2, MTOT, AIN(9) + l0 * DM, mod0, 5, AIN(6) + l1 * DM, mod1, 0, 1); } thin_rn<1, 4>(F, args, Y2, YP2, MTOT, AIN(9) + l0 * DM, mod0, 5, AIN(6) + l1 * DM, mod1, 0, 1); } SEAM(base + 7);
        if (IN(base + 8)) {
            pg8::Gemm g{(gen_cbf)(Hb), (gen_cbf)((const GAS bf16*)(WSP(WS_WIN)) + (size_t)j * 10240 * DM), SEQ, 10240, DM}; pg8::StaticOrder S; S.init(SEQ, 10240, F.G, PG_CID, WGM_HG);
            pg8::EpiHgIn E{(GAS bf16*)(WSP(WS_Q)), (WS_V - WS_Q) / 2, (GAS bf16*)(WSP(WS_LF)), (WS_LB - WS_LF) / 2, (const GAS float*)(WSP(WS_LBV)) + (size_t)j * 2 * DM};
            static_assert(WS_SG - WS_V == WS_V - WS_Q, "Q|V|SG equally spaced");
            for (int rep = 0; rep <= REP_GEMM + REP_GHG; ++rep)
            pg8::gemm_phase<pg8::EpiHgIn, pg8::StaticOrder, PG_ALIGN, PG_SP2>(F.lds + RING_OFF, g, S, E);
#if defined(REP_GHG_CHEAP)
            { pg8::EpiBf16P E2{(GAS bf16*)(WSP(WS_REC)), 10240}; pg8::gemm_phase<pg8::EpiBf16P, pg8::StaticOrder, PG_ALIGN, PG_SP2>(F.lds + RING_OFF, g, S, E2); }
#endif
            { CtxHgIn CE{(GAS bf16*)(WSP(WS_Q)), (WS_V - WS_Q) / 2, (GAS bf16*)(WSP(WS_LF)), (WS_LB - WS_LF) / 2, (const GAS float*)(WSP(WS_LBV)) + (size_t)j * 2 * DM}; for (int rep = 0; rep <= REP_CTX; ++rep) ctx_gemm<128, 5, 1, 8>(F, Hb + (size_t)SEQ * DM, (const GAS bf16*)(WSP(WS_WIN)) + (size_t)j * 10240 * DM, DM, 128, CE); }
        } SEAM(base + 8);
        for (int rep = 0; rep <= REP_HG; ++rep) {
        for (int rep1 = 0; rep1 <= REP_R1; ++rep1) { if (IN(base + 9)) { phase_hg_r1(F, args); } SEAM(base + 9); }
        for (int rep2 = 0; rep2 <= REP_R2; ++rep2) { if (IN(base + 10)) { phase_hg_r2(F, args); } SEAM(base + 10); }
        }
        if (IN(base + 11)) { for (int rep = 0; rep <= REP_THIN; ++rep) phase_a4(F, args, AIN(23) + j * DM); } SEAM(base + 11);
        if (IN(base + 12)) {
            pg8::Gemm g{(gen_cbf)(Zb), (gen_cbf)((const GAS bf16*)(WSP(WS_WOUT)) + (size_t)j * DM * DM), SEQ, DM, DM}; pg8::StaticOrder S; S.init(SEQ, DM, F.G, PG_CID, WGM_OP);
            pg8::EpiBf16P E{Y1, DM};
            for (int rep = 0; rep <= REP_GEMM + REP_GOUT; ++rep)
            pg8::gemm_phase<pg8::EpiBf16P, pg8::StaticOrder, PG_ALIGN, PG_SP2>(F.lds + RING_OFF, g, S, E);
            if (CTXLIVE) { CtxPart CE{YP1}; for (int rep = 0; rep <= REP_CTX; ++rep) ctx_gemm<128, 4, 4, 4>(F, Zb + (size_t)SEQ * DM, (const GAS bf16*)(WSP(WS_WOUT)) + (size_t)j * DM * DM, DM, 32, CE); }
        } SEAM(base + 12);
        if (IN(base + 13)) { if (REP_RN) { thin_rn<1, 4, true>(F, args, Y1, YP1, (pair == 1 ? SEQ : MTOT), AIN(7) + l1 * DM, mod1, 2, AIN(8) + l1 * DM, mod1, 3, 4); } thin_rn<1, 4>(F, args, Y1, YP1, (pair == 1 ? SEQ : MTOT), AIN(7) + l1 * DM, mod1, 2, AIN(8) + l1 * DM, mod1, 3, 4); } SEAM(base + 13);
        if (IN(base + 14)) {
            pg8::Gemm g{(gen_cbf)(Hb), (gen_cbf)((const GAS bf16*)(WSP(WS_W1)) + (size_t)l1 * HID * DM), SEQ, HID, DM}; pg8::StaticOrder S; S.init(SEQ, HID, F.G, PG_CID, WGM_IN);
            pg8::EpiRelu2 E{(GAS bf16*)(WSP(WS_HID)), HID};
            for (int rep = 0; rep <= REP_GEMM + REP_GIN; ++rep)
            pg8::gemm_phase<pg8::EpiRelu2, pg8::StaticOrder, PG_ALIGN, PG_SP2>(F.lds + RING_OFF, g, S, E);
            if (CTXLIVE) { CtxRelu2 CE{(GAS bf16*)(WSP(WS_HID))}; for (int rep = 0; rep <= REP_CTX; ++rep) ctx_gemm<128, 4, 1, 4>(F, Hb + (size_t)SEQ * DM, (const GAS bf16*)(WSP(WS_W1)) + (size_t)l1 * HID * DM, DM, 128, CE); }
        } SEAM(base + 14);
        if (IN(base + 15)) {
            pg8::Gemm g{(gen_cbf)(HIDb), (gen_cbf)((const GAS bf16*)(WSP(WS_W2)) + (size_t)l1 * DM * HID), SEQ, DM, HID}; pg8::StaticOrder S; S.init(SEQ, DM, F.G, PG_CID, WGM_OUT);
            pg8::EpiBf16P E{Y2, DM};
            for (int rep = 0; rep <= REP_GEMM + REP_GOUT; ++rep)
            pg8::gemm_phase<pg8::EpiBf16P, pg8::StaticOrder, PG_ALIGN, PG_SP2>(F.lds + RING_OFF, g, S, E);
            if (CTXLIVE) { CtxPart CE{YP2}; for (int rep = 0; rep <= REP_CTX; ++rep) ctx_gemm<128, 4, 4, 4>(F, HIDb + (size_t)SEQ * HID, (const GAS bf16*)(WSP(WS_W2)) + (size_t)l1 * DM * HID, HID, 32, CE); }
        } SEAM(base + 15);
    }
__global__ void __launch_bounds__(NTHR, 2) mk_fwd(Args args) {
    extern __shared__ __attribute__((aligned(16))) unsigned char lds[];
    Frame F;
    F.lds = (LAS unsigned char*)lds;
    F.MISC = (volatile LAS unsigned*)(F.lds + MISC_OFF);
    F.tid = threadIdx.x; F.lane = F.tid & 63; F.wave = __builtin_amdgcn_readfirstlane(F.tid >> 6);
    F.G = gridDim.x; { const int bx = blockIdx.x; F.vcu = (F.G % 8 == 0) ? (bx % 8) * (F.G / 8) + bx / 8 : bx; }
    F.ws = (GAS unsigned char*)args.ws; F.out = (GAS float*)args.out;
    for (int u = F.tid; u < (LDS_BYTES - LDSCTL_OFF) / 4; u += NTHR) ((LAS unsigned*)(F.lds + LDSCTL_OFF))[u] = 0u;
    __syncthreads();
    gen_u32p barw = (gen_u32p)((GAS unsigned*)(WSP(WS_CTL)) + CW_BAR);
    XcdBarrier bar; bar.bar = barw; bar.x = 0; bar.st = nullptr;
    if (!MK_PER_PHASE) bar = xcd_barrier_post(barw, F.MISC + 8);
    if (IN(0)) { for (int rep = 0; rep <= REP_P0; ++rep) phase_p0(F, args); } SEAM(0);
    for (int rep = 0; rep < REP_BAR; ++rep) xcd_barrier(bar);
    if (IN(1)) { phase_p1(F, args); } SEAM(1);

    layer_pair<0>(F, args, bar);
    layer_pair<1>(F, args, bar);
    if (IN(34)) { thin_rn<2, 1>(F, args, Y2, nullptr, SEQ, AIN(9) + 3 * DM, MOD + (size_t)3 * 2 * NMOD, 5, nullptr, nullptr, 0, 0); }
#undef IN
#undef SEAM
}

extern "C" void kernel_launch(void* const* d_in, const int* in_sizes, int n_in, void* d_out, int out_size, void* d_ws, size_t ws_size, hipStream_t stream) {
    static int grid = 0;
    if (grid == 0) {
        if (n_in != 25 || out_size != SEQ * DM || ws_size < WS_END) { fprintf(stderr, "kernel_launch: unexpected shapes (n_in %d out %d ws %zu need %zu)\n", n_in, out_size, ws_size, (size_t)WS_END); grid = -1; return; }
        int dev = 0, cus = 0, per_cu = 0;
        if (hipGetDevice(&dev) != hipSuccess || hipDeviceGetAttribute(&cus, hipDeviceAttributeMultiprocessorCount, dev) != hipSuccess) { grid = -1; return; }
        if (hipFuncSetAttribute((const void*)mk_fwd, hipFuncAttributeMaxDynamicSharedMemorySize, LDS_BYTES) != hipSuccess) { fprintf(stderr, "kernel_launch: hipFuncSetAttribute failed\n"); grid = -1; return; }
        if (hipOccupancyMaxActiveBlocksPerMultiprocessor(&per_cu, (const void*)mk_fwd, NTHR, LDS_BYTES) != hipSuccess || per_cu < 1) { fprintf(stderr, "kernel_launch: occupancy query says %d\n", per_cu); (void)hipGetLastError(); }
        grid = cus;
    }
    if (grid < 0) return;
    if (hipMemsetAsync((char*)d_ws + WS_CTL, 0, CTL_ZERO_BYTES, stream) != hipSuccess) return;
    Args a{};
    for (int i = 0; i < 25; ++i) a.in[i] = (const float*)d_in[i];
    a.out = (float*)d_out; a.ws = (unsigned char*)d_ws;
#if MK_PER_PHASE
    for (int p = 0; p < NPHASES; ++p) {  a.ph_lo = p; a.ph_hi = p + 1; hipLaunchKernelGGL(mk_fwd, dim3(grid), dim3(NTHR), LDS_BYTES, stream, a); }
#else
    a.ph_lo = 0; a.ph_hi = NPHASES; hipLaunchKernelGGL(mk_fwd, dim3(grid), dim3(NTHR), LDS_BYTES, stream, a);
#endif
}
```

```cpp
#include <hip/hip_runtime.h>
#include <cstdio>
#include <cstdint>
#define GAS __attribute__((address_space(1)))
#ifndef PG_WGM
#define PG_WGM 8
#endif
namespace pg8 {
#define PG8_LAS __attribute__((address_space(3)))
typedef unsigned short bf16_t;
typedef short bf16x8 __attribute__((ext_vector_type(8)));
typedef float f32x4 __attribute__((ext_vector_type(4)));
typedef unsigned u32x4 __attribute__((ext_vector_type(4)));
constexpr int BM = 256, BK = 64, HALF = 128, HTB = HALF * BK * 2  , STAGE_BYTES = 8 * HTB, NXCD = 8, WGM = PG_WGM;

__host__ __device__ __forceinline__ int lds_byte(int r, int c) { const int st = (r >> 4) * 2 + (c >> 5), rr = r & 15, cc = c & 31, ob = rr * 64 + cc * 2; return st * 1024 + (ob ^ (((ob >> 9) & 1) << 5)); }
__host__ __device__ __forceinline__ void stage_rc(int b, int& R, int& C) { const int st = b / 1024, sb = b % 1024, swz = sb ^ (((sb >> 9) & 1) << 5); R = (st >> 1) * 16 + swz / 64; C = (st & 1) * 32 + (swz % 64) / 2; }
__host__ __device__ __forceinline__ int perm32(int rho) { const int n = rho >> 4, i = rho & 15; return 8 * (i >> 2) + 4 * n + (i & 3); }

struct Unit { int pm, pn; };
struct Gemm { const bf16_t* A; const bf16_t* Bt; int M, N, K; };

struct StaticOrder {
    int nM, nN, nwg, G, c, wgm;
    __host__ __device__ void init(int M, int N, int G_, int c_, int wgm_ = WGM) { nM = M / BM; nN = N / BM; nwg = nM * nN; G = G_; c = c_; wgm = wgm_; }
    __host__ __device__ bool next(int i, Unit& u) const {
        const long L = (long)i * G + c; if (L >= nwg) return false;
        int wgid = (int)L; { const int q = nwg / NXCD, r = nwg % NXCD, xcd = wgid % NXCD, off = wgid / NXCD; wgid = (xcd < r ? xcd * (q + 1) : r * (q + 1) + (xcd - r) * q) + off; }
        const int nig = wgm * nN, gid = wgid / nig, fm = gid * wgm, gsz = (nM - fm) < wgm ? (nM - fm) : wgm;
        u.pm = fm + ((wgid % nig) % gsz); u.pn = (wgid % nig) / gsz; return true;
    }
    __device__ __forceinline__ void a_ready(const Unit&) const {}
    __device__ __forceinline__ void done(const Unit&) const {}
};

__device__ __forceinline__ unsigned cvt_pk_bf16(float lo, float hi) { unsigned r; asm volatile("v_cvt_pk_bf16_f32 %0, %1, %2" : "=v"(r) : "v"(lo), "v"(hi)); return r; }
typedef float f32x2 __attribute__((ext_vector_type(2)));
#ifndef EPI_NT
#define EPI_NT 0
#endif
#if EPI_NT
#define EPI_ST(p, v) __builtin_nontemporal_store((v), (p))
#else
#define EPI_ST(p, v) (*(p) = (v))
#endif
__device__ __forceinline__ float sigmoid_f(float x) { return __builtin_amdgcn_rcpf(1.0f + __expf(-x)); }
__device__ __forceinline__ float silu_f(float x) { return x * sigmoid_f(x); }
__device__ __forceinline__ float logf_gate(float z, float lb, float  ) {
    const float e = __expf(-fabsf(z));
    const float r = __builtin_amdgcn_rcpf(1.0f + e);
    const float sg = z >= 0.f ? r : e * r;
    const float a = fminf(z, 0.0f) - __logf(1.0f + e);
    const float b = __logf(lb + (1.0f - lb) * sg);
    return lb > 0.0f ? b : a;
}

struct EpiF32 {
    static constexpr bool PERM = false, AFTER_DRAIN = false;
    GAS float* C; int ldc;
    __device__ __forceinline__ void operator()(const f32x4 (&acc)[2][2][4][2], const Unit& u, int wr, int wc, int fr, int fq) const {
        const int row0 = u.pm * BM + wr * 64 + fr, col0 = u.pn * BM + wc * 32 + 4 * fq;
#pragma unroll
        for (int ai = 0; ai < 2; ++ai)
#pragma unroll
            for (int m = 0; m < 4; ++m) { GAS float* rowp = C + (size_t)(row0 + ai * HALF + m * 16) * ldc + col0;
#pragma unroll
                for (int bj = 0; bj < 2; ++bj)
#pragma unroll
                    for (int n = 0; n < 2; ++n) *(GAS f32x4*)(rowp + bj * HALF + n * 16) = acc[ai][bj][m][n]; }
    }
};
struct EpiRelu2 {
    static constexpr bool PERM = true, AFTER_DRAIN = false;
    GAS bf16_t* O; int ldc;
    __device__ __forceinline__ void operator()(const f32x4 (&acc)[2][2][4][2], const Unit& u, int wr, int wc, int fr, int fq) const {
        const int row0 = u.pm * BM + wr * 64 + fr, col0 = u.pn * BM + wc * 32 + 8 * fq;
#pragma unroll
        for (int ai = 0; ai < 2; ++ai)
#pragma unroll
            for (int m = 0; m < 4; ++m) { GAS bf16_t* rowp = O + (size_t)(row0 + ai * HALF + m * 16) * ldc + col0;
#pragma unroll
                for (int bj = 0; bj < 2; ++bj) { f32x4 v0 = acc[ai][bj][m][0], v1 = acc[ai][bj][m][1];
#pragma unroll
                    for (int j = 0; j < 4; ++j) { const float a = fmaxf(v0[j], 0.f), b = fmaxf(v1[j], 0.f); v0[j] = a * a; v1[j] = b * b; }
                    u32x4 w; w.x = cvt_pk_bf16(v0[0], v0[1]); w.y = cvt_pk_bf16(v0[2], v0[3]); w.z = cvt_pk_bf16(v1[0], v1[1]); w.w = cvt_pk_bf16(v1[2], v1[3]);
                    EPI_ST((GAS u32x4*)(rowp + bj * HALF), w); } }
    }
};
struct EpiBf16P {
    static constexpr bool PERM = true, AFTER_DRAIN = false;
    GAS bf16_t* O; int ldc;
    __device__ __forceinline__ void operator()(const f32x4 (&acc)[2][2][4][2], const Unit& u, int wr, int wc, int fr, int fq) const {
        const int row0 = u.pm * BM + wr * 64 + fr, col0 = u.pn * BM + wc * 32 + 8 * fq;
#pragma unroll
        for (int ai = 0; ai < 2; ++ai)
#pragma unroll
            for (int m = 0; m < 4; ++m) { GAS bf16_t* rowp = O + (size_t)(row0 + ai * HALF + m * 16) * ldc + col0;
#pragma unroll
                for (int bj = 0; bj < 2; ++bj) { const f32x4 v0 = acc[ai][bj][m][0], v1 = acc[ai][bj][m][1];
                    u32x4 w; w.x = cvt_pk_bf16(v0[0], v0[1]); w.y = cvt_pk_bf16(v0[2], v0[3]); w.z = cvt_pk_bf16(v1[0], v1[1]); w.w = cvt_pk_bf16(v1[2], v1[3]);
                    EPI_ST((GAS u32x4*)(rowp + bj * HALF), w); } }
    }
};
struct EpiGlu {
    static constexpr bool PERM = true, AFTER_DRAIN = false;
    GAS bf16_t* O; int ldc;
    __device__ __forceinline__ void operator()(const f32x4 (&acc)[2][2][4][2], const Unit& u, int wr, int wc, int fr, int fq) const {
        const int row0 = u.pm * BM + wr * 64 + fr, col0 = u.pn * HALF + wc * 32 + 8 * fq;
#pragma unroll
        for (int ai = 0; ai < 2; ++ai)
#pragma unroll
            for (int m = 0; m < 4; ++m) { GAS bf16_t* rowp = O + (size_t)(row0 + ai * HALF + m * 16) * ldc + col0;
                f32x4 o0, o1;
#pragma unroll
                for (int j = 0; j < 4; ++j) { o0[j] = acc[ai][0][m][0][j] * sigmoid_f(acc[ai][1][m][0][j]); o1[j] = acc[ai][0][m][1][j] * sigmoid_f(acc[ai][1][m][1][j]); }
                u32x4 w; w.x = cvt_pk_bf16(o0[0], o0[1]); w.y = cvt_pk_bf16(o0[2], o0[3]); w.z = cvt_pk_bf16(o1[0], o1[1]); w.w = cvt_pk_bf16(o1[2], o1[3]);
                EPI_ST((GAS u32x4*)(rowp), w); }
    }
};
struct EpiHgIn {
    static constexpr bool PERM = true, AFTER_DRAIN = false;
    GAS bf16_t* Q; size_t hstride; GAS bf16_t* LF; size_t fstride; const GAS float* lbv;
    template <int BJ> __device__ __forceinline__ void gate_half(const f32x4 (&acc)[2][2][4][2], GAS bf16_t* O, const GAS float* lbp, int row0, int col0) const {
        const f32x4 lb0 = *(const GAS f32x4*)(lbp + BJ * HALF), lb1 = *(const GAS f32x4*)(lbp + BJ * HALF + 4);
#pragma unroll
        for (int ai = 0; ai < 2; ++ai)
#pragma unroll
            for (int m = 0; m < 4; ++m) { GAS bf16_t* rowp = O + (size_t)(row0 + ai * HALF + m * 16) * 2048 + col0 + BJ * HALF;
                f32x4 o0, o1;
#pragma unroll
                for (int j = 0; j < 4; ++j) { o0[j] = logf_gate(acc[ai][BJ][m][0][j], lb0[j], 0.f); o1[j] = logf_gate(acc[ai][BJ][m][1][j], lb1[j], 0.f); }
                u32x4 w; w.x = cvt_pk_bf16(o0[0], o0[1]); w.y = cvt_pk_bf16(o0[2], o0[3]); w.z = cvt_pk_bf16(o1[0], o1[1]); w.w = cvt_pk_bf16(o1[2], o1[3]);
                EPI_ST((GAS u32x4*)(rowp), w); }
    }
    __device__ __forceinline__ void operator()(const f32x4 (&acc)[2][2][4][2], const Unit& u, int wr, int wc, int fr, int fq) const {
        const int typ = u.pn >> 3, row0 = u.pm * BM + wr * 64 + fr, col0 = (u.pn & 7) * BM + wc * 32 + 8 * fq;
        if (typ == 2 || typ == 3) {
            GAS bf16_t* O = LF + (size_t)(typ - 2) * fstride;
            const GAS float* lbp = lbv + (typ == 2 ? 0 : 2048) + col0;
            gate_half<0>(acc, O, lbp, row0, col0); gate_half<1>(acc, O, lbp, row0, col0);
        } else {
            GAS bf16_t* O = Q + (size_t)((typ >> 2) * 2 + (typ & 1)) * hstride; const bool act = typ != 1;
#pragma unroll
            for (int ai = 0; ai < 2; ++ai)
#pragma unroll
                for (int m = 0; m < 4; ++m) { GAS bf16_t* rowp = O + (size_t)(row0 + ai * HALF + m * 16) * 2048 + col0;
#pragma unroll
                    for (int bj = 0; bj < 2; ++bj) { f32x4 v0 = acc[ai][bj][m][0], v1 = acc[ai][bj][m][1];
                        if (act) {
#pragma unroll
                            for (int j = 0; j < 4; ++j) { v0[j] = silu_f(v0[j]); v1[j] = silu_f(v1[j]); } }
                        u32x4 w; w.x = cvt_pk_bf16(v0[0], v0[1]); w.y = cvt_pk_bf16(v0[2], v0[3]); w.z = cvt_pk_bf16(v1[0], v1[1]); w.w = cvt_pk_bf16(v1[2], v1[3]);
                        EPI_ST((GAS u32x4*)(rowp + bj * HALF), w); } }
        }
    }
};
#ifndef PG_AUX_A
#define PG_AUX_A 0
#endif
#ifndef PG_AUX_B
#define PG_AUX_B 0
#endif
template <class Epi, class Sched, bool ALIGN_EPI = false, bool SP2 = false>
__device__ __forceinline__ void gemm_phase(PG8_LAS unsigned char* lds, const Gemm g, const Sched& S, const Epi& E) {
    int tid_ = threadIdx.x; asm volatile("" : "+v"(tid_));
    const int tid = tid_, wid = __builtin_amdgcn_readfirstlane(tid >> 6), lane = tid & 63, wr = wid >> 2, wc = wid & 3, fr = lane & 15, fq = lane >> 4;
    const int K = g.K, nt = K / BK;
    unsigned voffA[2], voffB[2];
#pragma unroll
    for (int i = 0; i < 2; ++i) { int R, C; stage_rc(tid * 16 + i * 8192, R, C); const int Rb = Epi::PERM ? ((R & ~31) + perm32(R & 31)) : R;
        voffA[i] = (unsigned)(R * K + C) * 2u; voffB[i] = (unsigned)(Rb * K + C) * 2u; }
    const size_t kstep = (size_t)(BK * 2);
    const size_t hstep = (size_t)HALF * K * 2;
    const size_t tstep = 2 * hstep;
    const unsigned ldsw = (unsigned)wid * 1024u;
    const int aoff = lds_byte(wr * 64 + fr, fq * 8), boff = lds_byte(wc * 32 + fr, fq * 8);
#define PG8_SA(b, h) (((b) * 2 + (h)) * HTB)
#define PG8_SB(b, h) ((4 + (b) * 2 + (h)) * HTB)
#define PG8_STAGE(bufoff, gbase, voff) do { _Pragma("unroll") for (int _i = 0; _i < 2; ++_i) \
        __builtin_amdgcn_global_load_lds((const unsigned*)((const char*)(gbase) + (voff)[_i]), (PG8_LAS unsigned*)(lds + (bufoff) + ldsw + _i * 8192), 16, 0, PG_AUX_B); } while (0)
#define PG8_STAGEA(bufoff, gbase, voff) do { _Pragma("unroll") for (int _i = 0; _i < 2; ++_i) \
        __builtin_amdgcn_global_load_lds((const unsigned*)((const char*)(gbase) + (voff)[_i]), (PG8_LAS unsigned*)(lds + (bufoff) + ldsw + _i * 8192), 16, 0, PG_AUX_A); } while (0)
#define PG8_LDA(dst, b, h) do { _Pragma("unroll") for (int m = 0; m < 4; ++m) _Pragma("unroll") for (int k = 0; k < 2; ++k) dst[m][k] = *(const PG8_LAS bf16x8*)(lds + PG8_SA(b, h) + aoff + m * 2048 + k * 1024); } while (0)
#define PG8_LDB(dst, b, h) do { _Pragma("unroll") for (int n = 0; n < 2; ++n) _Pragma("unroll") for (int k = 0; k < 2; ++k) dst[n][k] = *(const PG8_LAS bf16x8*)(lds + PG8_SB(b, h) + boff + n * 2048 + k * 1024); } while (0)
#define PG8_MMA(ai, bj, At, Bt) do { __builtin_amdgcn_s_setprio(1); _Pragma("unroll") for (int m = 0; m < 4; ++m) _Pragma("unroll") for (int n = 0; n < 2; ++n) _Pragma("unroll") for (int k = 0; k < 2; ++k) \
        acc[ai][bj][m][n] = __builtin_amdgcn_mfma_f32_16x16x32_bf16(Bt[n][k], At[m][k], acc[ai][bj][m][n], 0, 0, 0); __builtin_amdgcn_s_setprio(0); } while (0)
#define PG8_WAIT_V(n) asm volatile("s_waitcnt vmcnt(" #n ")" ::: "memory")
#define PG8_WAIT_L(n) asm volatile("s_waitcnt lgkmcnt(" #n ")" ::: "memory")
#define PG8_BAR __builtin_amdgcn_s_barrier()
#define PG8_SCHED __builtin_amdgcn_sched_barrier(0)
    Unit cur, nxt; int ui = 0;
    if (!S.next(0, cur)) return;
    f32x4 acc[2][2][4][2];
#pragma unroll
    for (int a = 0; a < 2; ++a)
#pragma unroll
        for (int b = 0; b < 2; ++b)
#pragma unroll
            for (int m = 0; m < 4; ++m)
#pragma unroll
                for (int n = 0; n < 2; ++n) acc[a][b][m][n] = (f32x4){0.f, 0.f, 0.f, 0.f};
    bf16x8 At[4][2], B0[2][2], B1[2][2];
    const char* cA = (const char*)g.A + (size_t)cur.pm * tstep; const char* cB = (const char*)g.Bt + (size_t)cur.pn * tstep;
    S.a_ready(cur);
    if constexpr (SP2) {
        PG8_STAGE(PG8_SB(0, 0), cB, voffB); PG8_STAGE(PG8_SB(0, 1), cB + hstep, voffB); PG8_STAGEA(PG8_SA(0, 0), cA, voffA); PG8_STAGEA(PG8_SA(0, 1), cA + hstep, voffA);
        if (wr == 1) PG8_BAR;
        PG8_WAIT_V(2); PG8_BAR;
        PG8_STAGE(PG8_SB(1, 0), cB + kstep, voffB); PG8_STAGEA(PG8_SA(1, 0), cA + kstep, voffA); PG8_STAGE(PG8_SB(1, 1), cB + hstep + kstep, voffB);
        PG8_WAIT_V(6); PG8_BAR;
    } else {
        PG8_STAGE(PG8_SB(0, 0), cB, voffB); PG8_STAGEA(PG8_SA(0, 0), cA, voffA); PG8_STAGE(PG8_SB(0, 1), cB + hstep, voffB); PG8_STAGEA(PG8_SA(0, 1), cA + hstep, voffA);
        if (wr == 1) PG8_BAR;
        PG8_WAIT_V(4); PG8_BAR;
        PG8_STAGE(PG8_SB(1, 0), cB + kstep, voffB); PG8_STAGEA(PG8_SA(1, 0), cA + kstep, voffA); PG8_STAGE(PG8_SB(1, 1), cB + hstep + kstep, voffB);
        PG8_WAIT_V(6); PG8_BAR;
    }
    for (;;) {
        const bool has_next = S.next(ui + 1, nxt);
        const char* nA = has_next ? (const char*)g.A + (size_t)nxt.pm * tstep : cA; const char* nB = has_next ? (const char*)g.Bt + (size_t)nxt.pn * tstep : cB;
        for (int t = 0; t < nt; t += 2) {
            const bool last = (t == nt - 2);
            const char* a1 = cA + (size_t)(t + 1) * kstep;
            const char* a2 = last ? nA : cA + (size_t)(t + 2) * kstep; const char* b2 = last ? nB : cB + (size_t)(t + 2) * kstep;
            const char* a3 = a2 + kstep; const char* b3 = b2 + kstep;
            if (last && has_next) S.a_ready(nxt);
            if constexpr (SP2) {
            PG8_LDB(B0, 0, 0); PG8_LDB(B1, 0, 1); PG8_SCHED; PG8_LDA(At, 0, 0); PG8_STAGEA(PG8_SA(1, 1), a1 + hstep, voffA);
            PG8_WAIT_V(8); PG8_WAIT_L(0); PG8_BAR; PG8_MMA(0, 0, At, B0); PG8_MMA(0, 1, At, B1); PG8_BAR; PG8_SCHED;
            PG8_LDA(At, 0, 1); PG8_STAGE(PG8_SB(0, 0), b2, voffB); PG8_STAGE(PG8_SB(0, 1), b2 + hstep, voffB); PG8_STAGEA(PG8_SA(0, 0), a2, voffA);
            PG8_WAIT_V(8); PG8_WAIT_L(0); PG8_BAR; PG8_MMA(1, 0, At, B0); PG8_MMA(1, 1, At, B1); PG8_BAR; PG8_SCHED;
            PG8_LDB(B0, 1, 0); PG8_LDB(B1, 1, 1); PG8_SCHED; PG8_LDA(At, 1, 0); PG8_STAGEA(PG8_SA(0, 1), a2 + hstep, voffA);
            PG8_WAIT_V(8); PG8_WAIT_L(0); PG8_BAR; PG8_MMA(0, 0, At, B0); PG8_MMA(0, 1, At, B1); PG8_BAR; PG8_SCHED;
            PG8_LDA(At, 1, 1); PG8_STAGE(PG8_SB(1, 0), b3, voffB); PG8_STAGE(PG8_SB(1, 1), b3 + hstep, voffB); PG8_STAGEA(PG8_SA(1, 0), a3, voffA);
            PG8_WAIT_V(8); PG8_WAIT_L(0); PG8_BAR; PG8_MMA(1, 0, At, B0); PG8_MMA(1, 1, At, B1); PG8_BAR; PG8_SCHED;
            } else {
            PG8_LDB(B0, 0, 0); PG8_SCHED; PG8_LDA(At, 0, 0); PG8_STAGEA(PG8_SA(1, 1), a1 + hstep, voffA);
            PG8_WAIT_L(8); PG8_BAR; PG8_WAIT_L(0); PG8_MMA(0, 0, At, B0); PG8_BAR; PG8_SCHED;
            PG8_LDB(B1, 0, 1); PG8_STAGE(PG8_SB(0, 0), b2, voffB);
            PG8_BAR; PG8_WAIT_L(0); PG8_MMA(0, 1, At, B1); PG8_BAR;
            PG8_LDA(At, 0, 1); PG8_STAGEA(PG8_SA(0, 0), a2, voffA);
            PG8_BAR; PG8_WAIT_L(0); PG8_MMA(1, 0, At, B0); PG8_BAR; PG8_SCHED;
            PG8_STAGE(PG8_SB(0, 1), b2 + hstep, voffB);
            PG8_WAIT_V(6); PG8_BAR; PG8_MMA(1, 1, At, B1); PG8_BAR;
            PG8_LDB(B0, 1, 0); PG8_SCHED; PG8_LDA(At, 1, 0); PG8_STAGEA(PG8_SA(0, 1), a2 + hstep, voffA);
            PG8_WAIT_L(8); PG8_BAR; PG8_WAIT_L(0); PG8_MMA(0, 0, At, B0); PG8_BAR; PG8_SCHED;
            PG8_LDB(B1, 1, 1); PG8_STAGE(PG8_SB(1, 0), b3, voffB);
            PG8_BAR; PG8_WAIT_L(0); PG8_MMA(0, 1, At, B1); PG8_BAR;
            PG8_LDA(At, 1, 1); PG8_STAGEA(PG8_SA(1, 0), a3, voffA);
            PG8_BAR; PG8_WAIT_L(0); PG8_MMA(1, 0, At, B0); PG8_BAR; PG8_SCHED;
            PG8_STAGE(PG8_SB(1, 1), b3 + hstep, voffB);
            PG8_WAIT_V(6); PG8_BAR; PG8_MMA(1, 1, At, B1); PG8_BAR;
            }
        }
        if constexpr (ALIGN_EPI) { if (wr == 0) PG8_BAR; }
        if constexpr (!Epi::AFTER_DRAIN) { E(acc, cur, wr, wc, fr, fq); S.done(cur); }
        if (!has_next) break;
#pragma unroll
        for (int a = 0; a < 2; ++a)
#pragma unroll
            for (int b = 0; b < 2; ++b)
#pragma unroll
                for (int m = 0; m < 4; ++m)
#pragma unroll
                    for (int n = 0; n < 2; ++n) acc[a][b][m][n] = (f32x4){0.f, 0.f, 0.f, 0.f};
        cur = nxt; cA = nA; cB = nB; ++ui;
        if constexpr (ALIGN_EPI) { if (wr == 1) PG8_BAR; }
    }
    PG8_WAIT_V(0);
    if constexpr (!ALIGN_EPI) { if (wr == 0) PG8_BAR; }
    PG8_BAR;
    if constexpr (Epi::AFTER_DRAIN) { E.fused(acc, cur, wr, wc, fr, fq, lds, wid, lane); S.done(cur); }
#undef PG8_SA
#undef PG8_SB
#undef PG8_STAGE
#undef PG8_STAGEA
#undef PG8_LDA
#undef PG8_LDB
#undef PG8_MMA
#undef PG8_WAIT_V
#undef PG8_WAIT_L
#undef PG8_BAR
#undef PG8_SCHED
}
}
constexpr int DM = 2048, SEQ = 8192, CTXL = 256, MTOT = SEQ + CTXL, HID = 8192, NMOD = 6 * DM;
constexpr int NWAVES = 8, NTHR = 512;
constexpr float NEPS = 1e-6f;
#ifndef MK_PER_PHASE
#define MK_PER_PHASE 0
#endif
constexpr int NPHASES = 35;
#ifndef PG_CID
#define PG_CID ((int)((blockIdx.x >> 5) + 8 * (blockIdx.x & 31)))
#endif
#ifndef PG_ALIGN
#define PG_ALIGN true
#endif
#ifndef PG_SP2
#define PG_SP2 true
#endif
#ifndef REP_P0
#define REP_P0 0
#endif
#ifndef REP_S5
#define REP_S5 0
#endif
#ifndef REP_HG
#define REP_HG 0
#endif
#ifndef REP_GEMM
#define REP_GEMM 0
#endif
#ifndef REP_BAR
#define REP_BAR 0
#endif
#ifndef REP_R1
#define REP_R1 0
#endif
#ifndef REP_R2
#define REP_R2 0
#endif
#ifndef REP_GGLU
#define REP_GGLU 0
#endif
#ifndef REP_GIN
#define REP_GIN 0
#endif
#ifndef REP_GOUT
#define REP_GOUT 0
#endif
#ifndef REP_GHG
#define REP_GHG 0
#endif
#ifndef WGM_GLU
#define WGM_GLU 2
#endif
#ifndef WGM_IN
#define WGM_IN 2
#endif
#ifndef WGM_OUT
#define WGM_OUT 2
#endif
#ifndef WGM_HG
#define WGM_HG 2
#endif
#ifndef WGM_OP
#define WGM_OP 2
#endif
#ifndef REP_RN
#define REP_RN 0
#endif
#ifndef REP_CTX
#define REP_CTX 0
#endif
#ifndef REP_THIN
#define REP_THIN 0
#endif

constexpr size_t MiB = 1u << 20;
constexpr size_t WS_CTL = 0, CTL_ZERO_BYTES = 1 * MiB;
constexpr size_t WS_MOD = 1 * MiB;
constexpr size_t WS_LBV = 2 * MiB;
constexpr size_t WS_PART = 3 * MiB;
constexpr size_t WS_W1 = 16 * MiB;
constexpr size_t WS_W2 = WS_W1 + 128 * MiB;
constexpr size_t WS_WGLU = WS_W2 + 128 * MiB;
constexpr size_t WS_WIN = WS_WGLU + 32 * MiB;
constexpr size_t WS_WOUT = WS_WIN + 80 * MiB;
constexpr size_t WS_X = WS_WOUT + 16 * MiB;
constexpr size_t WS_H = WS_X + 66 * MiB;
constexpr size_t WS_Z = WS_H + 33 * MiB;
constexpr size_t WS_Y1 = WS_Z + 33 * MiB;
constexpr size_t WS_Y2 = WS_Y1 + 66 * MiB;
constexpr size_t WS_HID = WS_Y2 + 66 * MiB;
constexpr size_t WS_Q = WS_HID + 132 * MiB;
constexpr size_t WS_V = WS_Q + 33 * MiB;
constexpr size_t WS_SG = WS_V + 33 * MiB;
constexpr size_t WS_LF = WS_SG + 33 * MiB;
constexpr size_t WS_LB = WS_LF + 66 * MiB;
constexpr size_t WS_OF = WS_LB + 66 * MiB;
constexpr size_t WS_OB = WS_OF + 66 * MiB;
constexpr size_t WS_REC = WS_OB + 66 * MiB;
constexpr size_t WS_SEGS = WS_REC + 224 * MiB;
constexpr size_t WS_SEGD = WS_SEGS + 16 * MiB;
constexpr size_t WS_YP1 = WS_SEGD + 1 * MiB;
constexpr size_t WS_YP2 = WS_YP1 + 8 * MiB;
constexpr size_t WS_END = WS_YP2 + 8 * MiB;
constexpr int CW_BAR = 4096;

constexpr int RING_OFF = 0, RING_BYTES = 135168;
constexpr int LDSCTL_OFF = RING_BYTES, MISC_OFF = LDSCTL_OFF + 320;
constexpr int LDS_BYTES = 147456;

#define LAS __attribute__((address_space(3)))
typedef unsigned short bf16;
typedef unsigned v4u __attribute__((ext_vector_type(4)));
typedef unsigned v2u __attribute__((ext_vector_type(2)));
typedef float f32x4 __attribute__((ext_vector_type(4)));
typedef short bf16x8 __attribute__((ext_vector_type(8)));
#define LDS_WAIT() asm volatile("s_waitcnt lgkmcnt(0)" ::: "memory")
#define VM_WAIT() asm volatile("s_waitcnt vmcnt(0)" ::: "memory")
__device__ __forceinline__ unsigned f2bf(float f) { unsigned u = __builtin_bit_cast(unsigned, f); return (u + 0x7fffu + ((u >> 16) & 1u)) >> 16; }
__device__ __forceinline__ unsigned pk2(float lo, float hi) { return f2bf(lo) | (f2bf(hi) << 16); }
__device__ __forceinline__ float bflo(unsigned w) { return __builtin_bit_cast(float, w << 16); }
__device__ __forceinline__ float bfhi(unsigned w) { return __builtin_bit_cast(float, w & 0xffff0000u); }
typedef float f32x2 __attribute__((ext_vector_type(2)));
typedef __bf16 bf16x2n __attribute__((ext_vector_type(2)));
__device__ __forceinline__ unsigned pkbf(float lo, float hi) { f32x2 v = {lo, hi}; return __builtin_bit_cast(unsigned, __builtin_convertvector(v, bf16x2n)); }
__device__ __forceinline__ float bf1(bf16 b) { return __builtin_bit_cast(float, ((unsigned)b) << 16); }

#define XB_TMO      128
#define XB_XCNT(j)  (256  + 64 * (j))
#define XB_XSUB(j)  (1280 + 64 * (j))
#define XB_XGEN(j)  (2304 + 64 * (j))
#define XB_TOP      3328
#define XB_TOPGEN   3392
#define XCD_BAR_WORDS 3456
#define XB_SPIN_CAP (1u << 18)

__device__ __forceinline__ unsigned xb_ld(unsigned* p)              { return __hip_atomic_load(p, __ATOMIC_RELAXED, __HIP_MEMORY_SCOPE_AGENT); }
__device__ __forceinline__ unsigned xb_add(unsigned* p, unsigned v) { return __hip_atomic_fetch_add(p, v, __ATOMIC_RELAXED, __HIP_MEMORY_SCOPE_AGENT); }
__device__ __forceinline__ unsigned xb_xcc_id() { return (unsigned)__builtin_amdgcn_s_getreg((3 << 11) | 20) & 0xFu; }
#define XB_SPIN(cond, bar) do { unsigned _sp = 0; while (cond) { __builtin_amdgcn_s_sleep(1); \
    if ((++_sp & 255u) == 0u) { if (xb_ld(&(bar)[XB_TMO])) break; if (_sp > XB_SPIN_CAP) { atomicAdd(&(bar)[XB_TMO], 1u); break; } } } } while (0)

struct XcdBarrier {
    unsigned* bar; unsigned x;
    volatile LAS unsigned* st;
};

__device__ __forceinline__ XcdBarrier xcd_barrier_post(unsigned* bar, volatile LAS unsigned* st) {
    XcdBarrier b; b.bar = bar; b.x = xb_xcc_id(); b.st = st;
    if (threadIdx.x == 0) (void)xb_add(&bar[XB_XCNT(b.x)], 1u);
    return b;
}
__device__ __forceinline__ void xcd_barrier_complete(unsigned* bar, unsigned x, unsigned& nloc, unsigned& nx) {
    const unsigned G = gridDim.x * gridDim.y * gridDim.z;
    unsigned sum, cnt, mine, sp = 0u;
    for (;;) {
        sum = 0u; cnt = 0u; mine = 0u;
#pragma unroll
        for (unsigned j = 0; j < 16; ++j) { const unsigned c = xb_ld(&bar[XB_XCNT(j)]); sum += c; cnt += (c > 0u) ? 1u : 0u; mine = (j == x) ? c : mine; }
        if (sum == G) break;
        __builtin_amdgcn_s_sleep(1);
        if ((++sp & 255u) == 0u) { if (xb_ld(&bar[XB_TMO])) break; if (sp > XB_SPIN_CAP) { atomicAdd(&bar[XB_TMO], 1u); break; } }
    }
    nloc = mine > 0u ? mine : 1u; nx = cnt > 0u ? cnt : 1u;
}

__device__ __forceinline__ void xcd_barrier(const XcdBarrier& b) {
    asm volatile("s_waitcnt vmcnt(0)" ::: "memory");
    __syncthreads();
    if (threadIdx.x == 0) {
        unsigned* bar = b.bar;
        __builtin_amdgcn_s_waitcnt(0);
        unsigned nloc = b.st[0], nx = b.st[1];
        if (nloc == 0u) { xcd_barrier_complete(bar, b.x, nloc, nx); b.st[0] = nloc; b.st[1] = nx; }
        const unsigned old = xb_add(&bar[XB_XSUB(b.x)], 1u);
        const unsigned gen = old / nloc;
        if (old + 1u == (gen + 1u) * nloc) {
            __builtin_amdgcn_fence(__ATOMIC_RELEASE, "agent");
            asm volatile("s_waitcnt vmcnt(0)" ::: "memory");
            const unsigned og = xb_add(&bar[XB_TOP], 1u);
            const unsigned tg = og / nx;
            if (og + 1u == (tg + 1u) * nx) xb_add(&bar[XB_TOPGEN], 1u);
            else XB_SPIN(xb_ld(&bar[XB_TOPGEN]) == tg, bar);
            __builtin_amdgcn_fence(__ATOMIC_ACQUIRE, "agent");
            xb_add(&bar[XB_XGEN(b.x)], 1u);
            asm volatile("s_waitcnt vmcnt(0)" ::: "memory");
        } else {
            XB_SPIN(xb_ld(&bar[XB_XGEN(b.x)]) == gen, bar);
            __builtin_amdgcn_fence(__ATOMIC_ACQUIRE, "agent");
            asm volatile("s_waitcnt vmcnt(0)" ::: "memory");
        }
    }
    __syncthreads();
}

typedef const unsigned short* gen_cbf; typedef unsigned* gen_u32p;
struct Args { const float* in[25]; float* out; unsigned char* ws; int ph_lo, ph_hi; };
template <class T> __device__ __forceinline__ GAS T* opq(T* p) { GAS T* g = (GAS T*)p; asm volatile("" : "+s"(g)); return g; }
template <class T> __device__ __forceinline__ GAS T* opq(GAS T* g) { asm volatile("" : "+s"(g)); return g; }
__device__ __forceinline__ int opqv(int v) { asm volatile("" : "+v"(v)); return v; }
#define AIN(k) opq(args.in[k])
#define WSP(off) (opq(F.ws) + (off))
struct Frame {
    LAS unsigned char* lds;
    volatile LAS unsigned* MISC;
    int tid, lane, wave, vcu, G;
    GAS unsigned char* ws;
    GAS float* out;
};
__device__ __forceinline__ int opqs(int v) { asm volatile("" : "+s"(v)); return v; }
__device__ __forceinline__ void relane(Frame& F) { F.lane = opqv(F.lane); F.tid = opqv(F.tid); F.wave = opqs(F.wave); F.vcu = opqs(F.vcu);
    unsigned lb = (unsigned)(size_t)F.lds; asm volatile("" : "+s"(lb)); F.lds = (LAS unsigned char*)(size_t)lb; }
__device__ __forceinline__ float xshfl(float v, int lane, int o) { return __builtin_bit_cast(float, __builtin_amdgcn_ds_bpermute((lane ^ o) << 2, __builtin_bit_cast(int, v))); }
__device__ __forceinline__ float wave_sum(float v, int lane) {
#pragma unroll
    for (int o = 1; o < 64; o <<= 1) v += xshfl(v, lane, o);
    return v;
}

__device__ __forceinline__ void p0_transpose_item(const GAS float* W, int K, int N, GAS bf16* WT, int k0, int n0, int dst_row0, LAS unsigned char* scr, int lane) {
    const int n4 = (lane & 15) * 4, kp = lane >> 4;
    const GAS float* src = W + (size_t)(k0 + 2 * kp) * N + n0 + n4;
    f32x4 v[16];
#pragma unroll
    for (int i = 0; i < 8; ++i) { v[2 * i] = *(const GAS f32x4*)(src + (size_t)(8 * i) * N); v[2 * i + 1] = *(const GAS f32x4*)(src + (size_t)(8 * i + 1) * N); }
#pragma unroll
    for (int i = 0; i < 8; ++i) {
#pragma unroll
        for (int e = 0; e < 4; ++e) *(LAS unsigned*)(scr + (n4 + e) * 144 + (8 * i + 2 * kp) * 2) = pkbf(v[2 * i][e], v[2 * i + 1][e]);
    }
    LDS_WAIT(); asm volatile("" ::: "memory");
    const int c = lane & 7, nr = lane >> 3;
#pragma unroll
    for (int j = 0; j < 8; ++j) { const int n = nr + 8 * j; const v4u o = *(const LAS v4u*)(scr + n * 144 + c * 16);
        *(GAS v4u*)(WT + (size_t)(dst_row0 + n) * K + k0 + 8 * c) = o; }
    LDS_WAIT(); asm volatile("" ::: "memory");
}
__device__ __forceinline__ void phase_p0(Frame& F, const Args& args) {
    relane(F);
    LAS unsigned char* scr = F.lds + RING_OFF + F.wave * 9216;
    const int gw = F.vcu * NWAVES + F.wave, NGW = F.G * NWAVES;
    constexpr int I_W1 = (DM / 64) * (HID / 64);
    constexpr int I_W2 = (HID / 64) * (DM / 64);
    constexpr int I_GLU = (DM / 64) * (4096 / 64);
    constexpr int I_IN = (DM / 64) * (10240 / 64);
    constexpr int I_OUT = (DM / 64) * (DM / 64);
    constexpr int T_W1 = 4 * I_W1, T_W2 = 4 * I_W2, T_GLU = 2 * I_GLU, T_IN = 2 * I_IN, T_OUT = 2 * I_OUT;
    constexpr int NITEMS = T_W1 + T_W2 + T_GLU + T_IN + T_OUT;
    for (int it = gw; it < NITEMS; it += NGW) {
        int r = it;
        if (r < T_W1) { const int l = r / I_W1, q = r % I_W1, nblk = HID / 64, qg = q >> 3, qw = q & 3, qk = (q >> 2) & 1, kb = 2 * (qg / (nblk / 4)) + qk, nb = 4 * (qg % (nblk / 4)) + qw;
            p0_transpose_item(AIN(10) + (size_t)l * DM * HID, DM, HID, (GAS bf16*)(WSP(WS_W1)) + (size_t)l * HID * DM, 64 * kb, 64 * nb, 64 * nb, scr, F.lane); continue; } r -= T_W1;
        if (r < T_W2) { const int l = r / I_W2, q = r % I_W2, nblk = DM / 64, qg = q >> 3, qw = q & 3, qk = (q >> 2) & 1, kb = 2 * (qg / (nblk / 4)) + qk, nb = 4 * (qg % (nblk / 4)) + qw;
            p0_transpose_item(AIN(11) + (size_t)l * HID * DM, HID, DM, (GAS bf16*)(WSP(WS_W2)) + (size_t)l * DM * HID, 64 * kb, 64 * nb, 64 * nb, scr, F.lane); continue; } r -= T_W2;
        if (r < T_GLU) { const int l = r / I_GLU, q = r % I_GLU, nblk = 4096 / 64, qg = q >> 3, qw = q & 3, qk = (q >> 2) & 1, kb = 2 * (qg / (nblk / 4)) + qk, nb = 4 * (qg % (nblk / 4)) + qw, n0 = 64 * nb;
            const int c = n0 & 2047, dst = 256 * (c >> 7) + (n0 >= 2048 ? 128 : 0) + (c & 127);
            p0_transpose_item(AIN(20) + (size_t)l * DM * 4096, DM, 4096, (GAS bf16*)(WSP(WS_WGLU)) + (size_t)l * 4096 * DM, 64 * kb, n0, dst, scr, F.lane); continue; } r -= T_GLU;
        if (r < T_IN) { const int l = r / I_IN, q = r % I_IN, nblk = 10240 / 64, qg = q >> 3, qw = q & 3, qk = (q >> 2) & 1, kb = 2 * (qg / (nblk / 4)) + qk, nb = 4 * (qg % (nblk / 4)) + qw;
            p0_transpose_item(AIN(21) + (size_t)l * DM * 10240, DM, 10240, (GAS bf16*)(WSP(WS_WIN)) + (size_t)l * 10240 * DM, 64 * kb, 64 * nb, 64 * nb, scr, F.lane); continue; } r -= T_IN;
        { const int l = r / I_OUT, q = r % I_OUT, nblk = DM / 64, qg = q >> 3, qw = q & 3, qk = (q >> 2) & 1, kb = 2 * (qg / (nblk / 4)) + qk, nb = 4 * (qg % (nblk / 4)) + qw;
            p0_transpose_item(AIN(24) + (size_t)l * DM * DM, DM, DM, (GAS bf16*)(WSP(WS_WOUT)) + (size_t)l * DM * DM, 64 * kb, 64 * nb, 64 * nb, scr, F.lane); }
    }
    __syncthreads();
    LAS float* sc = (LAS float*)(F.lds + RING_OFF);
    for (int i = F.tid; i < 2 * DM; i += NTHR) { const float v = i < DM ? AIN(1)[i] : AIN(3)[i - DM]; sc[i] = v / (1.0f + __expf(-v)); }
    __syncthreads();
    LAS float* red = sc + 2 * DM;
    GAS float* PART = (GAS float*)(WSP(WS_PART));
    for (int it = F.vcu; it < 4 * 16 * 12; it += F.G) {
        const int l = it / 192, q = it % 192, kc = q / 12, cb = q % 12;
        const int c4 = F.tid & 255, rh = F.tid >> 8, col = cb * 1024 + c4 * 4;
        const GAS float* wp = AIN(4) + ((size_t)l * DM + kc * 128 + rh * 64) * NMOD + col;
        f32x4 a0 = {0.f, 0.f, 0.f, 0.f}, a1 = {0.f, 0.f, 0.f, 0.f};
#pragma unroll 8
        for (int k = 0; k < 64; ++k) { const f32x4 w = *(const GAS f32x4*)(wp + (size_t)k * NMOD); const float s0 = sc[kc * 128 + rh * 64 + k], s1 = sc[DM + kc * 128 + rh * 64 + k];
            a0 += w * s0; a1 += w * s1; }
        if (rh == 1) { *(LAS f32x4*)(red + c4 * 8) = a0; *(LAS f32x4*)(red + c4 * 8 + 4) = a1; }
        __syncthreads();
        if (rh == 0) { a0 += *(LAS f32x4*)(red + c4 * 8); a1 += *(LAS f32x4*)(red + c4 * 8 + 4);
            GAS float* o = PART + ((size_t)(l * 16 + kc) * 2) * NMOD + col;
            *(GAS f32x4*)o = a0; *(GAS f32x4*)(o + NMOD) = a1; }
        __syncthreads();
    }
}
__device__ __forceinline__ void phase_p1(Frame& F, const Args& args) {
    relane(F);
    const GAS float* PART = (const GAS float*)(WSP(WS_PART)); GAS float* MOD = (GAS float*)(WSP(WS_MOD)); GAS float* LBV = (GAS float*)(WSP(WS_LBV));
    const int gt = F.vcu * NTHR + F.tid, NT = F.G * NTHR;
    for (int i = gt; i < 4 * 2 * NMOD; i += NT) { const int l = i / (2 * NMOD), r = i % (2 * NMOD), w = r / NMOD, col = r % NMOD;
        float s = AIN(5)[l * NMOD + col];
#pragma unroll
        for (int kc = 0; kc < 16; ++kc) s += PART[((size_t)(l * 16 + kc) * 2 + w) * NMOD + col];
        MOD[i] = s; }
    for (int i = gt; i < 2 * 2 * DM; i += NT) { const int j = i / (2 * DM), r = i % (2 * DM), d = r / DM, col = r % DM;
        const float r0 = AIN(22)[(d * 2 + 0) * DM + col], r1 = AIN(22)[(d * 2 + 1) * DM + col];
        const float mx = fmaxf(r0, r1), e0 = expf(r0 - mx), e1 = expf(r1 - mx), w0 = e0 / (e0 + e1), w1 = e1 / (e0 + e1);
        LBV[i] = (j == 0) ? (w0 - w0) : ((w0 + w1) - w0); }
}

#define THIN_ROW_BODY(PG, PGP, PPRE, PSH, PSC, LD4, YV) do { \
        if (MODE != 0) { float s_ = 0.f; \
            _Pragma("unroll") for (int j = 0; j < 8; ++j) { const f32x4 yv_ = YV(j); s_ += (yv_.x * yv_.x + yv_.y * yv_.y) + (yv_.z * yv_.z + yv_.w * yv_.w); } \
            const float rs_ = 1.0f / sqrtf(wave_sum(s_, ln_) * (1.0f / DM) + NEPS); \
            _Pragma("unroll") for (int j = 0; j < 8; ++j) { const f32x4 g_ = LD4(PG, j), gp_ = LD4(PGP, j); x[j] += g_ * ((YV(j) * rs_) * gp_); if (j & 1) asm volatile("" ::: "memory"); } } \
        if (MODE == 2) { _Pragma("unroll") for (int j = 0; j < 8; ++j) *(GAS f32x4*)(F.out + (size_t)r * DM + 4 * ln_ + 256 * j) = x[j]; } \
        else { _Pragma("unroll") for (int j = 0; j < 8; ++j) { v2u xo_; xo_.x = pkbf(x[j].x, x[j].y); xo_.y = pkbf(x[j].z, x[j].w); *(GAS v2u*)(Xo + (size_t)r * DM + 4 * ln_ + 256 * j) = xo_; } \
            float s_ = 0.f; \
            _Pragma("unroll") for (int j = 0; j < 8; ++j) s_ += (x[j].x * x[j].x + x[j].y * x[j].y) + (x[j].z * x[j].z + x[j].w * x[j].w); \
            const float rs_ = 1.0f / sqrtf(wave_sum(s_, ln_) * (1.0f / DM) + NEPS); \
            _Pragma("unroll") for (int j = 0; j < 8; ++j) { const f32x4 gp_ = LD4(PPRE, j), sh_ = LD4(PSH, j), sc_ = LD4(PSC, j); \
                const f32x4 h_ = ((x[j] * rs_) * gp_) * (sc_ + 1.0f) + sh_; v2u o_; o_.x = pkbf(h_.x, h_.y); o_.y = pkbf(h_.z, h_.w); \
                if (HGM) *(GAS v2u*)(H + ((size_t)((ln_ >> 2) + 16 * j) * MTOT + r) * 16 + 4 * (ln_ & 3)) = o_; else *(GAS v2u*)(H + (size_t)r * DM + 4 * ln_ + 256 * j) = o_; if (j & 1) asm volatile("" ::: "memory"); } } } while (0)
#define THIN_YF(j) (y[j])
#define THIN_YP(j) ((f32x4){bflo(yp[j].x), bfhi(yp[j].x), bflo(yp[j].y), bfhi(yp[j].y)})
#define THIN_LDG(P, j) (*(const GAS f32x4*)((P) + 4 * ln_ + 256 * (j)))
#define THIN_LDL(P, j) (*(const LAS f32x4*)((P) + 4 * ln_ + 256 * (j)))
template <int MODE, int CP, bool DRY = false, bool HGM = false>
__device__ __forceinline__ void thin_rn(Frame& F, const Args& args, const GAS bf16* Y  , const GAS float* Yc  , int nrows_, const GAS float* gpost, const GAS float* modp  , int gate_chunk,
                                        const GAS float* gpre, const GAS float* modh  , int sh_chunk, int sc_chunk) {
    relane(F);
    GAS bf16* X = (GAS bf16*)(WSP(WS_X)); GAS bf16* H = (GAS bf16*)(WSP(WS_H)); GAS bf16* Xo = DRY ? (GAS bf16*)(WSP(WS_REC)) : X;
    const int gw = F.vcu * NWAVES + F.wave, NGW = F.G * NWAVES, nrows = (MODE == 2) ? SEQ : nrows_;
    LAS float* PL = (LAS float*)(F.lds + RING_OFF);
    for (int i = F.tid; i < DM / 4; i += NTHR) {
        if (MODE != 0) { *(LAS f32x4*)(PL + 4 * i) = *(const GAS f32x4*)(modp + gate_chunk * DM + 4 * i); *(LAS f32x4*)(PL + DM + 4 * i) = *(const GAS f32x4*)(gpost + 4 * i); }
        if (MODE != 2) { *(LAS f32x4*)(PL + 2 * DM + 4 * i) = *(const GAS f32x4*)(gpre + 4 * i); *(LAS f32x4*)(PL + 3 * DM + 4 * i) = *(const GAS f32x4*)(modh + sh_chunk * DM + 4 * i); *(LAS f32x4*)(PL + 4 * DM + 4 * i) = *(const GAS f32x4*)(modh + sc_chunk * DM + 4 * i); }
    }
    __syncthreads();
    {
        f32x4 xn[8]; v2u xq[8], yn[8];
        const GAS float* xb0 = AIN(0);
#define THIN_PREF(rr) do { const int ln_ = opqv(F.lane); const int rc_ = (rr) < SEQ ? (rr) : SEQ - 1; if (MODE == 0) { _Pragma("unroll") for (int j = 0; j < 8; ++j) xn[j] = *(const GAS f32x4*)(xb0 + (size_t)rc_ * DM + 4 * ln_ + 256 * j); } \
            else { _Pragma("unroll") for (int j = 0; j < 8; ++j) xq[j] = *(const GAS v2u*)(X + (size_t)rc_ * DM + 4 * ln_ + 256 * j); } \
            if (MODE != 0) { _Pragma("unroll") for (int j = 0; j < 8; ++j) yn[j] = *(const GAS v2u*)(Y + (size_t)rc_ * DM + 4 * ln_ + 256 * j); } } while (0)
        THIN_PREF(gw);
        for (int r = gw; r < SEQ; r += NGW) {
            const int ln_ = opqv(F.lane);
            LAS float* PLr = PL + opqv(0);
            f32x4 x[8]; v2u yp[8];
#pragma unroll
            for (int j = 0; j < 8; ++j) { if (MODE == 0) x[j] = xn[j]; else { x[j] = (f32x4){bflo(xq[j].x), bfhi(xq[j].x), bflo(xq[j].y), bfhi(xq[j].y)}; yp[j] = yn[j]; } }
            THIN_PREF(r + NGW);
            THIN_ROW_BODY(PLr, PLr + DM, PLr + 2 * DM, PLr + 3 * DM, PLr + 4 * DM, THIN_LDL, THIN_YP);
        }
#undef THIN_PREF
    }
    for (int r = SEQ + gw; r < nrows; r += NGW) {
        const int ln_ = opqv(F.lane);
        f32x4 x[8], y[8];
#pragma unroll
        for (int j = 0; j < 8; ++j) { if (MODE == 0) x[j] = *(const GAS f32x4*)(AIN(2) + (size_t)(r - SEQ) * DM + 4 * ln_ + 256 * j);
            else { const v2u t = *(const GAS v2u*)(X + (size_t)r * DM + 4 * ln_ + 256 * j); x[j] = (f32x4){bflo(t.x), bfhi(t.x), bflo(t.y), bfhi(t.y)}; } }
        if (MODE != 0) {
#pragma unroll
            for (int j = 0; j < 8; ++j) y[j] = *(const GAS f32x4*)(Yc + (size_t)(r - SEQ) * DM + 4 * ln_ + 256 * j);
#pragma unroll
            for (int k = 1; k < CP; ++k) { asm volatile("" ::: "memory");
#pragma unroll
                for (int j = 0; j < 8; ++j) y[j] += *(const GAS f32x4*)(Yc + ((size_t)k * CTXL + (r - SEQ)) * DM + 4 * ln_ + 256 * j); }
        }
        const GAS float* gt = modp + NMOD + gate_chunk * DM; const GAS float* shp = modh + NMOD + sh_chunk * DM; const GAS float* scp = modh + NMOD + sc_chunk * DM;
        THIN_ROW_BODY(gt, gpost, gpre, shp, scp, THIN_LDG, THIN_YF);
    }
}
__device__ __forceinline__ float gelu_tanh(float x) { const float u = 1.5957691216f * (x + 0.044715f * x * x * x); return x / (1.0f + __expf(-u)); }
__device__ __forceinline__ void phase_a2(Frame& F, const Args& args) {
    relane(F);
    const GAS bf16* yf = (const GAS bf16*)(WSP(WS_OF)); const GAS bf16* yb = (const GAS bf16*)(WSP(WS_OB)); GAS bf16* z = (GAS bf16*)(WSP(WS_Z));
    LAS unsigned char* L = F.lds + RING_OFF;
    const int lane = F.lane, wave = F.wave, rl = lane >> 1, hf = lane & 1, rr = lane >> 4, c16 = lane & 15;
    int it = 0;
    for (int u = F.vcu; u < (MTOT / 32) * 16; u += F.G, ++it) {
        const int rb = u >> 4, gb = u & 15, g = gb * 8 + wave, r0 = rb * 32;
        const size_t off = ((size_t)g * MTOT + r0 + rl) * 16 + 8 * hf;
        const v4u a = *(const GAS v4u*)(yf + off), b = *(const GAS v4u*)(yb + off); v4u o;
#pragma unroll
        for (int j = 0; j < 4; ++j) { const float lo = gelu_tanh(bflo(a[j]) + bflo(b[j])), hi = gelu_tanh(bfhi(a[j]) + bfhi(b[j])); o[j] = pkbf(lo, hi); }
        LAS unsigned char* T = L + (it & 1) * (32 * 272);
        *(LAS v4u*)(T + rl * 272 + wave * 32 + hf * 16) = o;
        __syncthreads();
        const v4u w = *(const LAS v4u*)(T + (4 * wave + rr) * 272 + c16 * 16);
        *(GAS v4u*)(z + (size_t)(r0 + 4 * wave + rr) * DM + gb * 128 + c16 * 8) = w;
    }
    __syncthreads();
}
__device__ __forceinline__ void phase_a4(Frame& F, const Args& args, const GAS float* onorm) {
    relane(F);
    const GAS bf16* OFp = (const GAS bf16*)(WSP(WS_OF)); const GAS bf16* OBp = (const GAS bf16*)(WSP(WS_OB)); const GAS bf16* SG = (const GAS bf16*)(WSP(WS_SG)); GAS bf16* Z = (GAS bf16*)(WSP(WS_Z));
    const int gw = F.vcu * NWAVES + F.wave, NGW = F.G * NWAVES;
    f32x4 gn[8];
#pragma unroll
    for (int j = 0; j < 8; ++j) gn[j] = *(const GAS f32x4*)(onorm + 4 * F.lane + 256 * j);
    v2u an[8], bn[8], sn[8];
#define A4_PREF(rr) do { const int ln_ = opqv(F.lane); const int rc_ = (rr) < MTOT ? (rr) : MTOT - 1; _Pragma("unroll") for (int j = 0; j < 8; ++j) { const size_t off_ = (size_t)rc_ * DM + 4 * ln_ + 256 * j; \
        an[j] = *(const GAS v2u*)(OFp + off_); bn[j] = *(const GAS v2u*)(OBp + off_); sn[j] = *(const GAS v2u*)(SG + off_); } } while (0)
    A4_PREF(gw);
    for (int r = gw; r < MTOT; r += NGW) {
        const int ln_ = opqv(F.lane);
        v2u a[8], b[8], sg[8];
#pragma unroll
        for (int j = 0; j < 8; ++j) { a[j] = an[j]; b[j] = bn[j]; sg[j] = sn[j]; }
        A4_PREF(r + NGW);
#pragma unroll
        for (int j = 0; j < 8; ++j) { const size_t off = (size_t)r * DM + 4 * ln_ + 256 * j;
            const f32x4 o = {bflo(a[j].x) + bflo(b[j].x), bfhi(a[j].x) + bfhi(b[j].x), bflo(a[j].y) + bflo(b[j].y), bfhi(a[j].y) + bfhi(b[j].y)};
            float s = (o.x * o.x + o.y * o.y) + (o.z * o.z + o.w * o.w);
#pragma unroll
            for (int d = 1; d < 32; d <<= 1) s += xshfl(s, ln_, d);
            const float rs = 1.0f / sqrtf(s * (1.0f / 128.0f) + NEPS);
            v2u w; w.x = pkbf(o.x * rs * gn[j].x * bflo(sg[j].x), o.y * rs * gn[j].y * bfhi(sg[j].x)); w.y = pkbf(o.z * rs * gn[j].z * bflo(sg[j].y), o.w * rs * gn[j].w * bfhi(sg[j].y));
            *(GAS v2u*)(Z + off) = w; }
    }
#undef A4_PREF
}

constexpr int S5_W8 = 0, S5_FB = 32768, S5_V8 = 32768, S5_T8 = 65536, S5_PAR = 98304;
constexpr int S5P_LAMP = 0, S5P_BB = 4608, S5P_CM = 4608 + 8192, S5P_L72 = 4608 + 16384, S5P_DSK = S5P_L72 + 512;
constexpr int S5_NSTEP = 9, S5_SLEN = 72;
__device__ __forceinline__ f32x2 cmul(f32x2 a, f32x2 b) { return (f32x2){a.x * b.x - a.y * b.y, a.x * b.y + a.y * b.x}; }
__device__ __forceinline__ int s5_row(int pos, int d) { if (pos < CTXL) return SEQ + (d ? CTXL - 1 - pos : pos); const int r = pos - CTXL; return d ? SEQ - 1 - r : r; }

__device__ __forceinline__ void phase_s5(Frame& F, const Args& args, int j) {
    relane(F);
    LAS unsigned char* L = F.lds + RING_OFF;
    LAS f32x2* LAMP = (LAS f32x2*)(L + S5_PAR + S5P_LAMP); LAS f32x2* BB = (LAS f32x2*)(L + S5_PAR + S5P_BB); LAS f32x2* CM = (LAS f32x2*)(L + S5_PAR + S5P_CM);
    LAS f32x2* L72 = (LAS f32x2*)(L + S5_PAR + S5P_L72); LAS float* DSK = (LAS float*)(L + S5_PAR + S5P_DSK);
    LAS f32x2* FB = (LAS f32x2*)(L + S5_FB);
    const int tid = F.tid, lane = F.lane, wave = F.wave, nl = lane & 15, q = lane >> 4;
    for (int it = F.vcu; it < 256; it += F.G) {
        const int g = it >> 1, d = it & 1, pi = (j * 2 + d) * 128 + g;
        const GAS bf16* H = (const GAS bf16*)(WSP(WS_H)) + (size_t)g * MTOT * 16;
        GAS bf16* Yo = (GAS bf16*)(opq(F.ws) + (d == 0 ? WS_OF : WS_OB)) + (size_t)g * MTOT * 16;
        if (tid < 64) {
            const int p = tid;
            const float dt = expf(AIN(14)[pi]); const float ar = AIN(12)[pi * 64 + p], ai = AIN(13)[pi * 64 + p];
            const float xr = ar * dt, yi = ai * dt;
            float tt = yi * 0.15915494309189535f; tt -= rintf(tt); const float ang = tt * 6.283185307179586f;
            const float cs = cosf(ang), sn = sinf(ang), ex = expf(xr), em1 = expm1f(xr), sh = sinf(0.5f * ang);
            const f32x2 lam1 = {ex * cs, ex * sn};
            const float nr = em1 * cs - 2.0f * sh * sh, ni = ex * sn;
            const float den = 1.0f / (ar * ar + ai * ai);
            const f32x2 kap = {(nr * ar + ni * ai) * den, (ni * ar - nr * ai) * den};
            f32x2 z = {1.0f, 0.0f};
#pragma unroll
            for (int k = 0; k < 9; ++k) { LAMP[k * 64 + p] = z; if (k < 8) z = cmul(z, lam1); }
            f32x2 z72 = z;
#pragma unroll
            for (int k = 0; k < 8; ++k) z72 = cmul(z72, z);
            L72[p] = z72;
#pragma unroll
            for (int h = 0; h < 16; ++h) { const f32x2 b = {AIN(15)[((size_t)pi * 64 + p) * 16 + h], AIN(16)[((size_t)pi * 64 + p) * 16 + h]}; BB[p * 16 + h] = cmul(kap, b); }
        }
        for (int i = tid; i < 1024; i += NTHR) { CM[i] = (f32x2){AIN(17)[(size_t)pi * 1024 + i], AIN(18)[(size_t)pi * 1024 + i]}; }
        if (tid < 16) DSK[tid] = (d == 0) ? AIN(19)[j * DM + g * 16 + tid] : 0.0f;
        __syncthreads();
#pragma unroll
        for (int i = 0; i < 4; ++i) {
            const int f = (tid >> 6) + 8 * i, mb = f >> 2, ks = f & 3, p = 16 * (mb >> 1) + nl, part = mb & 1, jj = 2 * ks + (q >> 1), h0 = 8 * (q & 1);
            const f32x2 lp = LAMP[(7 - jj) * 64 + p];
            float v[8];
#pragma unroll
            for (int e = 0; e < 8; ++e) { const f32x2 z = cmul(lp, BB[p * 16 + h0 + e]); v[e] = part ? z.y : z.x; }
            v4u o; o.x = pkbf(v[0], v[1]); o.y = pkbf(v[2], v[3]); o.z = pkbf(v[4], v[5]); o.w = pkbf(v[6], v[7]);
            *(LAS v4u*)(L + S5_W8 + (f * 64 + lane) * 16) = o;
        }
        __syncthreads();
        const int n = 16 * wave + nl, pos0 = S5_SLEN * n;
#define S5_LOADU(U, b) do { _Pragma("unroll") for (int ks = 0; ks < 4; ++ks) { int pos = pos0 + 8 * (b) + 2 * ks + (q >> 1); asm volatile("" : "+v"(pos)); const bool ok = pos < MTOT; \
            const int row = s5_row(ok ? pos : 0, d); v4u w = *(const GAS v4u*)(H + (size_t)row * 16 + 8 * (q & 1)); if (!ok) w = (v4u){0u, 0u, 0u, 0u}; U[ks] = __builtin_bit_cast(bf16x8, w); } } while (0)
#define S5_AFRAG(base, f) (*(const LAS bf16x8*)(L + (base) + (f) * 1024 + lofs))
#define S5_MFMA(a, b, c) __builtin_amdgcn_mfma_f32_16x16x32_bf16((a), (b), (c), 0, 0, 0)
#define S5_UPDATE() do { _Pragma("unroll") for (int t = 0; t < 4; ++t) { const LAS f32x4* lp_ = (const LAS f32x4*)(L + S5_PAR + S5P_LAMP + (8 * 64 + 16 * t) * 8 + zofs + q * 32); const f32x4 la_ = lp_[0], lb_ = lp_[1]; \
            const float l8r_[4] = {la_[0], la_[2], lb_[0], lb_[2]}, l8i_[4] = {la_[1], la_[3], lb_[1], lb_[3]}; \
            _Pragma("unroll") for (int r = 0; r < 4; ++r) { \
            const float nr_ = l8r_[r] * Sre[t][r] - l8i_[r] * Sim[t][r] + acc[2 * t][r], ni_ = l8r_[r] * Sim[t][r] + l8i_[r] * Sre[t][r] + acc[2 * t + 1][r]; Sre[t][r] = nr_; Sim[t][r] = ni_; } } } while (0)
        f32x4 Sre[4], Sim[4];
#pragma unroll
        for (int t = 0; t < 4; ++t) { Sre[t] = (f32x4){0.f, 0.f, 0.f, 0.f}; Sim[t] = (f32x4){0.f, 0.f, 0.f, 0.f}; }
        {
            bf16x8 U[4]; S5_LOADU(U, 0);
            for (int b = 0; b < S5_NSTEP; ++b) {
                int lofs = lane * 16; asm volatile("" : "+v"(lofs)); int zofs = 0; asm volatile("" : "+v"(zofs));
                bf16x8 Un[4];
                if (b + 1 < S5_NSTEP) S5_LOADU(Un, b + 1); else { _Pragma("unroll") for (int ks = 0; ks < 4; ++ks) Un[ks] = U[ks]; }
                f32x4 acc[8];
#pragma unroll
                for (int mb = 0; mb < 8; ++mb) { acc[mb] = (f32x4){0.f, 0.f, 0.f, 0.f};
#pragma unroll
                    for (int ks = 0; ks < 4; ++ks) acc[mb] = S5_MFMA(S5_AFRAG(S5_W8, mb * 4 + ks), U[ks], acc[mb]);
                    if (mb & 1) asm volatile("" ::: "memory"); }
                S5_UPDATE();
#pragma unroll
                for (int ks = 0; ks < 4; ++ks) U[ks] = Un[ks];
            }
        }
#pragma unroll
        for (int t = 0; t < 4; ++t) { LAS f32x4* o = (LAS f32x4*)(FB + n * 64 + 16 * t + 4 * q);
            o[0] = (f32x4){Sre[t][0], Sim[t][0], Sre[t][1], Sim[t][1]}; o[1] = (f32x4){Sre[t][2], Sim[t][2], Sre[t][3], Sim[t][3]}; }
        __syncthreads();
        if (wave == 0) {
            const f32x2 l72 = L72[lane]; f32x2 I = {0.f, 0.f};
            for (int n0 = 0; n0 < 128; n0 += 8) {
                f32x2 fv[8];
#pragma unroll
                for (int k = 0; k < 8; ++k) fv[k] = FB[(n0 + k) * 64 + lane];
#pragma unroll
                for (int k = 0; k < 8; ++k) { FB[(n0 + k) * 64 + lane] = I; I = cmul(l72, I) + fv[k]; }
            }
        }
        __syncthreads();
#pragma unroll
        for (int t = 0; t < 4; ++t) { const LAS f32x4* o = (const LAS f32x4*)(FB + n * 64 + 16 * t + 4 * q); const f32x4 a = o[0], b = o[1];
            Sre[t] = (f32x4){a[0], a[2], b[0], b[2]}; Sim[t] = (f32x4){a[1], a[3], b[1], b[3]}; }
        __syncthreads();
#pragma unroll
        for (int i = 0; i < 4; ++i) {
            const int f = (tid >> 6) + 8 * i, im = f >> 2, ks = f & 3, h = nl;
            float v[8];
#pragma unroll
            for (int e = 0; e < 4; ++e) { const int p = 16 * ks + 4 * q + e; const f32x2 z = cmul(CM[h * 64 + p], LAMP[(im + 1) * 64 + p]); v[e] = z.x; v[4 + e] = -z.y; }
            v4u o; o.x = pkbf(v[0], v[1]); o.y = pkbf(v[2], v[3]); o.z = pkbf(v[4], v[5]); o.w = pkbf(v[6], v[7]);
            *(LAS v4u*)(L + S5_V8 + (f * 64 + lane) * 16) = o;
        }
        {
            const int lag = tid >> 6, h = (tid >> 2) & 15, hq = tid & 3;
            float v[4] = {0.f, 0.f, 0.f, 0.f};
#pragma unroll 4
            for (int p = 0; p < 64; ++p) { const f32x2 cl = cmul(CM[h * 64 + p], LAMP[lag * 64 + p]);
                const LAS f32x4* bp = (const LAS f32x4*)(BB + p * 16 + 4 * hq); const f32x4 b0 = bp[0], b1 = bp[1];
                v[0] += cl.x * b0[0] - cl.y * b0[1]; v[1] += cl.x * b0[2] - cl.y * b0[3]; v[2] += cl.x * b1[0] - cl.y * b1[1]; v[3] += cl.x * b1[2] - cl.y * b1[3]; }
            if (lag == 0) {
#pragma unroll
                for (int e = 0; e < 4; ++e) if (4 * hq + e == h) v[e] += DSK[h];
            }
            v2u o; o.x = pkbf(v[0], v[1]); o.y = pkbf(v[2], v[3]);
            const int q0 = hq >> 1, eo = 4 * (hq & 1);
            *(LAS v2u*)(L + S5_T8 + (lag * 64 + h + 16 * q0) * 16 + eo * 2) = o;
            if (lag < 7) *(LAS v2u*)(L + S5_T8 + ((lag + 1) * 64 + h + 16 * (2 + q0)) * 16 + eo * 2) = o;
            if (lag == 0) *(LAS v2u*)(L + S5_T8 + (h + 16 * (2 + q0)) * 16 + eo * 2) = (v2u){0u, 0u};
        }
        __syncthreads();
        {
            bf16x8 T8r[8];
#pragma unroll
            for (int f = 0; f < 8; ++f) T8r[f] = *(const LAS bf16x8*)(L + S5_T8 + (f * 64 + lane) * 16);
            bf16x8 U[4]; S5_LOADU(U, 0);
            for (int b = 0; b < S5_NSTEP; ++b) {
                int lofs = lane * 16; asm volatile("" : "+v"(lofs)); int zofs = 0; asm volatile("" : "+v"(zofs));
                bf16x8 Un[4];
                if (b + 1 < S5_NSTEP) S5_LOADU(Un, b + 1); else { _Pragma("unroll") for (int ks = 0; ks < 4; ++ks) Un[ks] = U[ks]; }
                bf16x8 BS[4];
#pragma unroll
                for (int ks = 0; ks < 4; ++ks) { v4u w; w.x = pkbf(Sre[ks][0], Sre[ks][1]); w.y = pkbf(Sre[ks][2], Sre[ks][3]); w.z = pkbf(Sim[ks][0], Sim[ks][1]); w.w = pkbf(Sim[ks][2], Sim[ks][3]); BS[ks] = __builtin_bit_cast(bf16x8, w); }
#pragma unroll
                for (int mb = 0; mb < 8; ++mb) {
                    f32x4 y = {0.f, 0.f, 0.f, 0.f};
#pragma unroll
                    for (int ks = 0; ks < 4; ++ks) if (2 * ks <= mb) y = S5_MFMA(T8r[mb - 2 * ks], U[ks], y);
#pragma unroll
                    for (int ks = 0; ks < 4; ++ks) y = S5_MFMA(S5_AFRAG(S5_V8, mb * 4 + ks), BS[ks], y);
                    asm volatile("" ::: "memory");
                    int pos = pos0 + 8 * b + mb; asm volatile("" : "+v"(pos));
                    if (pos < MTOT) { v2u o; o.x = pkbf(y[0], y[1]); o.y = pkbf(y[2], y[3]); *(GAS v2u*)(Yo + (size_t)s5_row(pos, d) * 16 + 4 * q) = o; }
                }
                f32x4 acc[8];
#pragma unroll
                for (int mb = 0; mb < 8; ++mb) { acc[mb] = (f32x4){0.f, 0.f, 0.f, 0.f};
#pragma unroll
                    for (int ks = 0; ks < 4; ++ks) acc[mb] = S5_MFMA(S5_AFRAG(S5_W8, mb * 4 + ks), U[ks], acc[mb]);
                    if (mb & 1) asm volatile("" ::: "memory"); }
                S5_UPDATE();
#pragma unroll
                for (int ks = 0; ks < 4; ++ks) U[ks] = Un[ks];
            }
        }
        __syncthreads();
#undef S5_LOADU
#undef S5_AFRAG
#undef S5_MFMA
#undef S5_UPDATE
    }
}
constexpr int HG_QP = 272;
constexpr int HG_KP = 64;
constexpr int HGR_QB = 0, HGR_KE = 8704, HGR_VT = HGR_KE + 128 * HG_KP, HGR_SC = HGR_VT + 128 * HG_KP, HGR_DEC = HGR_SC + 2048;
constexpr int HGL1_KB = 110592  , HGL1_TOT = 128000  ;
constexpr int HGL_RECB = 0  , HGL_OB = 110592  ;
constexpr int HG_OP = 272;
constexpr int HG_NCH = 33, HG_NCHT = 264;
__device__ __forceinline__ int hg_row(int p, int d) { if (p < CTXL) return SEQ + (d ? CTXL - 1 - p : p); int n = p - CTXL; if (d) n = SEQ - 1 - n; return (n & 127) * 64 + (n >> 7); }
#define HG_MFMA(a, b, c) __builtin_amdgcn_mfma_f32_16x16x32_bf16((a), (b), (c), 0, 0, 0)
#define HG_STATE_STEP(RB, vt) do { _Pragma("unroll") for (int mb = 0; mb < 8; ++mb) { \
        const bf16x8 a_ = *(const LAS bf16x8*)(L + (RB) + HGR_KE + (16 * mb + r16) * HG_KP + qd * 16 + zofs); \
        const f32x4 u_ = HG_MFMA(a_, vt, ((f32x4){0.f, 0.f, 0.f, 0.f})); \
        const f32x4 dc_ = *(const LAS f32x4*)(L + (RB) + HGR_DEC + (16 * mb + 4 * qd) * 4 + zofs); S[mb] = dc_ * S[mb] + u_; } } while (0)

constexpr int HGP_REC = HGR_DEC + 512;
constexpr int HGP_KB = 2 * HGP_REC, HGP_TOT = HGP_KB + 2 * 8704, HGP_OB = HGP_TOT + 4096, HGP_END = HGP_OB + 2 * 32 * HG_OP;
static_assert(HGP_END <= RING_BYTES, "HGRN pass LDS");
template <bool FULL>
__device__ __forceinline__ void hg_pass(Frame& F, const Args& args) {
    relane(F);
    LAS unsigned char* L = F.lds + RING_OFF;
    const int wave = F.wave;
    LAS float* TOTS = (LAS float*)(L + HGP_TOT);
#define HG_TIDS() int tid = F.tid; asm volatile("" : "+v"(tid)); const int lane = tid & 63, r16 = lane & 15, qd = lane >> 4, kk = tid & 127, sq = tid >> 7, kl = kk & 31, pcol = (kk & ~31) + 8 * ((kl >> 2) & 3) + 4 * (kl >> 4) + (kl & 3); (void)r16; (void)qd; (void)pcol; (void)lane
    for (int it = F.vcu; it < 256; it += F.G) {
        const int hd = it >> 4, d = (it >> 3) & 1, sg = it & 7, hdd = hd * 2 + d;
        const GAS bf16* LG = (const GAS bf16*)(opq(F.ws) + (d ? WS_LB : WS_LF)) + hd * 128;
        const GAS bf16* Qp = (const GAS bf16*)(WSP(WS_Q)) + hd * 128; const GAS bf16* Vp = (const GAS bf16*)(WSP(WS_V)) + hd * 128;
        GAS bf16* O = (GAS bf16*)(opq(F.ws) + (d ? WS_OB : WS_OF)) + hd * 128;
        f32x4 S[8];
#pragma unroll
        for (int mb = 0; mb < 8; ++mb) S[mb] = (f32x4){0.f, 0.f, 0.f, 0.f};
        if (FULL) { HG_TIDS();
            f32x4 P[8], fv[8], dv[8];
#pragma unroll
            for (int mb = 0; mb < 8; ++mb) P[mb] = (f32x4){1.f, 1.f, 1.f, 1.f};
#define HG_SLOAD(s2_) do { const int sc_ = (s2_) >= 0 ? (s2_) : 0; const GAS f32x4* sp_ = (const GAS f32x4*)(opq(F.ws) + WS_SEGS) + ((size_t)((hdd * 8 + sc_) * 8 + wave) * 8) * 64 + lane; \
                const GAS float* dp_ = (const GAS float*)(opq(F.ws) + WS_SEGD) + (hdd * 8 + sc_) * 128 + 4 * qd; \
                _Pragma("unroll") for (int mb = 0; mb < 8; ++mb) { fv[mb] = sp_[mb * 64]; dv[mb] = *(const GAS f32x4*)(dp_ + 16 * mb); } } while (0)
            HG_SLOAD(sg - 1);
            for (int s2 = sg - 1; s2 >= 0; --s2) {
                f32x4 fc[8], dc[8];
#pragma unroll
                for (int mb = 0; mb < 8; ++mb) { fc[mb] = fv[mb]; dc[mb] = dv[mb]; }
                HG_SLOAD(s2 - 1);
#pragma unroll
                for (int mb = 0; mb < 8; ++mb) { S[mb] += P[mb] * fc[mb]; P[mb] *= dc[mb]; }
            }
#undef HG_SLOAD
        }
        float dsum = 0.f;
        float lf[2][8]; unsigned qv[2][8];
#define HG_INLOAD(cp) do { _Pragma("unroll") for (int h = 0; h < 2; ++h) { int c_ = 2 * (cp) + h; c_ = c_ < HG_NCH ? c_ : HG_NCH - 1; int p0_ = (sg * HG_NCH + c_) * 32 + 8 * sq; asm volatile("" : "+v"(p0_)); \
              \
            const int row0_ = hg_row(p0_, d), step_ = (p0_ < CTXL ? 1 : 64) * (d ? -1 : 1); unsigned off_ = (unsigned)row0_ * DM + kk; const int dstep_ = step_ * DM; \
            _Pragma("unroll") for (int i = 0; i < 8; ++i) { lf[h][i] = bf1(LG[off_]); qv[h][i] = (FULL ? (unsigned)Qp[off_] : 0u) | ((unsigned)Vp[off_] << 16); off_ += dstep_; } } } while (0)
#define HG_OSTORE(c, h) do { int p_ = (sg * HG_NCH + (c)) * 32 + (tid >> 4); asm volatile("" : "+v"(p_)); const v4u o_ = *(const LAS v4u*)(L + HGP_OB + (h) * (32 * HG_OP) + (tid >> 4) * HG_OP + (tid & 15) * 16); \
            *(GAS v4u*)(O + (size_t)hg_row(p_, d) * DM + 8 * (tid & 15)) = o_; } while (0)
        { HG_TIDS(); HG_INLOAD(0); }
        for (int cp = 0; cp < (HG_NCH + 1) / 2; ++cp) {
            HG_TIDS();
            int zofs = 0; asm volatile("" : "+v"(zofs));
            float cs[2][8];
#pragma unroll
            for (int h = 0; h < 2; ++h) { float run = 0.f;
#pragma unroll
                for (int i = 0; i < 8; ++i) { run += lf[h][i]; cs[h][i] = run; }
                TOTS[(h * 4 + sq) * 128 + kk] = run; }
            __syncthreads();
            if (FULL && cp > 0) { HG_OSTORE(2 * cp - 2, 0); HG_OSTORE(2 * cp - 1, 1); }
#pragma unroll
            for (int h = 0; h < 2; ++h) {
                const int RB = h * HGP_REC, KB = HGP_KB + h * (32 * HG_QP);
                const float t0 = TOTS[(h * 4 + 0) * 128 + kk], t1 = TOTS[(h * 4 + 1) * 128 + kk], t2 = TOTS[(h * 4 + 2) * 128 + kk], t3 = TOTS[(h * 4 + 3) * 128 + kk];
                const float offc = (sq > 0 ? t0 : 0.f) + (sq > 1 ? t1 : 0.f) + (sq > 2 ? t2 : 0.f), tot = (t0 + t1) + (t2 + t3), dec = __expf(tot);
                float ke[8];
#pragma unroll
                for (int i = 0; i < 8; ++i) { const float cum = cs[h][i] + offc, kv = 1.0f - __expf(i ? cs[h][i] - cs[h][i - 1] : cs[h][0]);
                    const float kb = kv * __expf(-cum); ke[i] = kb * dec;
                    if (FULL) { const float qb = bflo(qv[h][i]) * __expf(cum);
                        *(LAS bf16*)(L + RB + HGR_QB + (8 * sq + i) * HG_QP + pcol * 2) = (bf16)(pkbf(qb, 0.f) & 0xffffu);
                        *(LAS bf16*)(L + KB + (8 * sq + i) * HG_QP + pcol * 2) = (bf16)(pkbf(kb, 0.f) & 0xffffu); } }
                { v4u o; o.x = pkbf(ke[0], ke[1]); o.y = pkbf(ke[2], ke[3]); o.z = pkbf(ke[4], ke[5]); o.w = pkbf(ke[6], ke[7]);
                  *(LAS v4u*)(L + RB + HGR_KE + kk * HG_KP + sq * 16) = o;
                  v4u w; w.x = (qv[h][0] >> 16) | (qv[h][1] & 0xffff0000u); w.y = (qv[h][2] >> 16) | (qv[h][3] & 0xffff0000u); w.z = (qv[h][4] >> 16) | (qv[h][5] & 0xffff0000u); w.w = (qv[h][6] >> 16) | (qv[h][7] & 0xffff0000u);
                  *(LAS v4u*)(L + RB + HGR_VT + kk * HG_KP + sq * 16) = w; }
                if (sq == 0) { *(LAS float*)(L + RB + HGR_DEC + kk * 4) = dec; if (!FULL && 2 * cp + h < HG_NCH) dsum += tot; }
            }
            HG_INLOAD(cp + 1);
            __syncthreads();
            if (FULL) {
                const int h = wave >> 2, w4 = wave & 3, mblk = w4 >> 1, nblk = w4 & 1; const int RB = h * HGP_REC, KB = HGP_KB + h * (32 * HG_QP);
                f32x4 acc = {0.f, 0.f, 0.f, 0.f};
#pragma unroll
                for (int ks = 0; ks < 4; ++ks) { const bf16x8 a = *(const LAS bf16x8*)(L + RB + HGR_QB + (16 * mblk + r16) * HG_QP + (32 * ks + 8 * qd) * 2 + zofs);
                    const bf16x8 b = *(const LAS bf16x8*)(L + KB + (16 * nblk + r16) * HG_QP + (32 * ks + 8 * qd) * 2 + zofs); acc = HG_MFMA(a, b, acc); }
#pragma unroll
                for (int r = 0; r < 4; ++r) { const int cc = 16 * mblk + 4 * qd + r, ss = 16 * nblk + r16; const float v = ss <= cc ? acc[r] : 0.f;
                    *(LAS bf16*)(L + RB + HGR_SC + (cc * 32 + ss) * 2) = (bf16)(pkbf(v, 0.f) & 0xffffu); }
                __syncthreads();
            }
#pragma unroll
            for (int h = 0; h < 2; ++h) if (2 * cp + h < HG_NCH) { const int RB = h * HGP_REC;
                const bf16x8 vt = *(const LAS bf16x8*)(L + RB + HGR_VT + (16 * wave + r16) * HG_KP + qd * 16 + zofs);
                if (FULL) {
                    bf16x8 BS[4];
#pragma unroll
                    for (int ks = 0; ks < 4; ++ks) { v4u w; w.x = pkbf(S[2 * ks][0], S[2 * ks][1]); w.y = pkbf(S[2 * ks][2], S[2 * ks][3]); w.z = pkbf(S[2 * ks + 1][0], S[2 * ks + 1][1]); w.w = pkbf(S[2 * ks + 1][2], S[2 * ks + 1][3]);
                        BS[ks] = __builtin_bit_cast(bf16x8, w); }
#pragma unroll
                    for (int mblk = 0; mblk < 2; ++mblk) {
                        f32x4 o = {0.f, 0.f, 0.f, 0.f};
                        { const bf16x8 a = *(const LAS bf16x8*)(L + RB + HGR_SC + (16 * mblk + r16) * 64 + qd * 16 + zofs); o = HG_MFMA(a, vt, o); }
#pragma unroll
                        for (int ks = 0; ks < 4; ++ks) { const bf16x8 a = *(const LAS bf16x8*)(L + RB + HGR_QB + (16 * mblk + r16) * HG_QP + (32 * ks + 8 * qd) * 2 + zofs); o = HG_MFMA(a, BS[ks], o); }
#pragma unroll
                        for (int r = 0; r < 4; ++r) *(LAS bf16*)(L + HGP_OB + h * (32 * HG_OP) + (16 * mblk + 4 * qd + r) * HG_OP + (16 * wave + r16) * 2) = (bf16)(pkbf(o[r], 0.f) & 0xffffu);
                    }
                }
                HG_STATE_STEP(RB, vt); }
        }
        __syncthreads();
        if (FULL) { HG_TIDS(); HG_OSTORE(HG_NCH - 1, 0); }
        else { HG_TIDS(); GAS f32x4* sp = (GAS f32x4*)(opq(F.ws) + WS_SEGS) + ((size_t)((hdd * 8 + sg) * 8 + wave) * 8) * 64 + lane;
#pragma unroll
          for (int mb = 0; mb < 8; ++mb) sp[mb * 64] = S[mb];
          if (sq == 0) ((GAS float*)(opq(F.ws) + WS_SEGD))[(hdd * 8 + sg) * 128 + kk] = __expf(dsum); }
        __syncthreads();
#undef HG_INLOAD
#undef HG_OSTORE
    }
#undef HG_TIDS
}
__device__ __forceinline__ void phase_hg_r1(Frame& F, const Args& args) { hg_pass<false>(F, args); }
__device__ __forceinline__ void phase_hg_r2(Frame& F, const Args& args) { hg_pass<true>(F, args); }
template <int MT, int NB, int KS, int WR, class Epi>
__device__ __forceinline__ void ctx_gemm(Frame& F, const GAS bf16* A, const GAS bf16* Bt, int K, int ncolt, const Epi& E) {
    constexpr int WC = 8 / WR, MB = MT / (16 * WR), NBW = NB / WC, RT = 256 / MT, PITCH = 144, APIECES = MT * 8, BPIECES = NB * 16 * 8, NA = (APIECES + NTHR - 1) / NTHR, NBL = (BPIECES + NTHR - 1) / NTHR;
    constexpr int ABYTES = MT * PITCH, BBYTES = NB * 16 * PITCH, BUF = ABYTES + BBYTES;
    static_assert(3 * BUF <= RING_BYTES && NB % WC == 0 && MT % (16 * WR) == 0, "ctx_gemm geometry");
    relane(F);
    LAS unsigned char* L = F.lds + RING_OFF;
    const int tid = F.tid, lane = F.lane, wave = F.wave, r16 = lane & 15, qd = lane >> 4, wr = wave / WC, wc = wave % WC;
    const int units = RT * ncolt * KS, klen = K / KS, nkt = klen / 64;
    for (int u = F.vcu; u < units; u += F.G) {
        const int ks = u % KS, t = u / KS, rt = t % RT, ct = t / RT;
        const int rowb = rt * MT;
        const GAS bf16* ga[NA]; const GAS bf16* gb[NBL]; int la[NA], lb[NBL]; bool oka[NA], okb[NBL];
#pragma unroll
        for (int j = 0; j < NA; ++j) { const int i = tid + NTHR * j, row = i >> 3, ch = i & 7; oka[j] = i < APIECES; const int rr = oka[j] ? row : 0; ga[j] = A + (size_t)(rowb + rr) * K + ks * klen + 8 * ch; la[j] = rr * PITCH + ch * 16; }
#pragma unroll
        for (int j = 0; j < NBL; ++j) { const int i = tid + NTHR * j, row = i >> 3, ch = i & 7; okb[j] = i < BPIECES; const int rr = okb[j] ? row : 0;
            gb[j] = Bt + (size_t)E.brow(ct, rr >> 4, rr & 15) * K + ks * klen + 8 * ch; lb[j] = ABYTES + rr * PITCH + ch * 16; }
        v4u ra[2][NA], rb[2][NBL];
#define CG_LOAD(P, kt) do { _Pragma("unroll") for (int j = 0; j < NA; ++j) ra[P][j] = *(const GAS v4u*)(ga[j] + (kt) * 64); _Pragma("unroll") for (int j = 0; j < NBL; ++j) rb[P][j] = *(const GAS v4u*)(gb[j] + (kt) * 64); } while (0)
#define CG_STORE(P, bo) do { _Pragma("unroll") for (int j = 0; j < NA; ++j) if (oka[j]) *(LAS v4u*)(L + (bo) + la[j]) = ra[P][j]; _Pragma("unroll") for (int j = 0; j < NBL; ++j) if (okb[j]) *(LAS v4u*)(L + (bo) + lb[j]) = rb[P][j]; } while (0)
#define CG_COMPUTE(bo) do { _Pragma("unroll") for (int k2 = 0; k2 < 2; ++k2) { bf16x8 a[MB], b[NBW]; \
            _Pragma("unroll") for (int mb = 0; mb < MB; ++mb) a[mb] = *(const LAS bf16x8*)(L + (bo) + (wr * (MT / WR) + 16 * mb + r16) * PITCH + (4 * k2 + qd) * 16); \
            _Pragma("unroll") for (int nb = 0; nb < NBW; ++nb) b[nb] = *(const LAS bf16x8*)(L + (bo) + ABYTES + (16 * (wc + WC * nb) + r16) * PITCH + (4 * k2 + qd) * 16); \
            _Pragma("unroll") for (int mb = 0; mb < MB; ++mb) _Pragma("unroll") for (int nb = 0; nb < NBW; ++nb) acc[mb][nb] = __builtin_amdgcn_mfma_f32_16x16x32_bf16(a[mb], b[nb], acc[mb][nb], 0, 0, 0); } } while (0)
        f32x4 acc[MB][NBW];
#pragma unroll
        for (int mb = 0; mb < MB; ++mb)
#pragma unroll
            for (int nb = 0; nb < NBW; ++nb) acc[mb][nb] = (f32x4){0.f, 0.f, 0.f, 0.f};
        CG_LOAD(0, 0); CG_LOAD(1, 1); CG_STORE(0, 0);
        __syncthreads();
        for (int kt = 0; kt < nkt; kt += 2) {
            { const int b0 = (kt % 3) * BUF, b1 = ((kt + 1) % 3) * BUF;
              if (kt + 2 < nkt) CG_LOAD(0, kt + 2);
              CG_COMPUTE(b0);
              CG_STORE(1, b1);
              __syncthreads(); }
            { const int b1 = ((kt + 1) % 3) * BUF, b2 = ((kt + 2) % 3) * BUF;
              if (kt + 3 < nkt) CG_LOAD(1, kt + 3);
              CG_COMPUTE(b1);
              if (kt + 2 < nkt) CG_STORE(0, b2);
              __syncthreads(); }
        }
#undef CG_LOAD
#undef CG_STORE
#undef CG_COMPUTE
        const int row0 = rowb + wr * (MT / WR);
#pragma unroll
        for (int mb = 0; mb < MB; ++mb) E.store(acc[mb], row0 + 16 * mb + 4 * qd, ct, ks, r16, wc);
    }
}
struct CtxRelu2 {
    GAS bf16* O;
    __device__ __forceinline__ int brow(int ct, int nb, int r) const { return 64 * ct + 16 * nb + r; }
    __device__ __forceinline__ void store(const f32x4 (&acc)[2], int row, int ct, int ks, int r, int wc) const {
#pragma unroll
        for (int t = 0; t < 2; ++t)
#pragma unroll
            for (int g = 0; g < 4; ++g) { const float v = fmaxf(acc[t][g], 0.f); O[(size_t)(SEQ + row + g) * HID + 64 * ct + 16 * (wc + 2 * t) + r] = (bf16)(pkbf(v * v, 0.f) & 0xffffu); }
    }
};
struct CtxGlu {
    GAS float* Y;
    __device__ __forceinline__ int brow(int ct, int nb, int r) const { const int c = 32 * ct + 16 * (nb & 1) + r; return 256 * (c >> 7) + (c & 127) + 128 * (nb >> 1); }
    __device__ __forceinline__ void store(const f32x4 (&acc)[2], int row, int ct, int ks, int r, int wc) const {
#pragma unroll
        for (int g = 0; g < 4; ++g) Y[(size_t)(row + g) * DM + 32 * ct + 16 * wc + r] = acc[0][g] * pg8::sigmoid_f(acc[1][g]);
    }
};
struct CtxPart {
    GAS float* YP;
    __device__ __forceinline__ int brow(int ct, int nb, int r) const { return 64 * ct + 16 * nb + r; }
    __device__ __forceinline__ void store(const f32x4 (&acc)[2], int row, int ct, int ks, int r, int wc) const {
#pragma unroll
        for (int t = 0; t < 2; ++t)
#pragma unroll
            for (int g = 0; g < 4; ++g) YP[((size_t)ks * CTXL + row + g) * DM + 64 * ct + 16 * (wc + 2 * t) + r] = acc[t][g];
    }
};
struct CtxHgIn {
    GAS bf16* Q; size_t hstride; GAS bf16* LF; size_t fstride; const GAS float* lbv;
    __device__ __forceinline__ int brow(int ct, int nb, int r) const { return 80 * ct + 16 * nb + r; }
    __device__ __forceinline__ void store(const f32x4 (&acc)[5], int row, int ct, int ks, int r, int  ) const {
#pragma unroll
        for (int nb = 0; nb < 5; ++nb) { const int col = 80 * ct + 16 * nb + r, typ = col >> 11, cc = col & 2047;
            if (typ == 2 || typ == 3) { const float lb = lbv[(typ - 2) * 2048 + cc], llb = lb > 0.f ? logf(lb) : 0.f; GAS bf16* O = LF + (size_t)(typ - 2) * fstride;
#pragma unroll
                for (int g = 0; g < 4; ++g) O[(size_t)(SEQ + row + g) * DM + cc] = (bf16)(pkbf(pg8::logf_gate(acc[nb][g], lb, llb), 0.f) & 0xffffu);
            } else { GAS bf16* O = Q + (size_t)((typ >> 2) * 2 + (typ & 1)) * hstride;
#pragma unroll
                for (int g = 0; g < 4; ++g) { const float v = acc[nb][g], w = typ == 1 ? v : pg8::silu_f(v); O[(size_t)(SEQ + row + g) * DM + cc] = (bf16)(pkbf(w, 0.f) & 0xffffu); } }
        }
    }
};

#if MK_PER_PHASE
#define IN(k) (args.ph_lo <= (k) && (k) < args.ph_hi)
#else
#define IN(k) true
#endif
#define SEAM(k) do { if (IN(k) && IN((k) + 1)) { if (!MK_PER_PHASE) xcd_barrier(bar); } } while (0)
#define MOD ((const GAS float*)(WSP(WS_MOD)))
#define Hb ((const GAS bf16*)(WSP(WS_H)))
#define Zb ((const GAS bf16*)(WSP(WS_Z)))
#define HIDb ((const GAS bf16*)(WSP(WS_HID)))
#define Y1 ((GAS bf16*)(WSP(WS_Y1)))
#define Y2 ((GAS bf16*)(WSP(WS_Y2)))
#define YP1 ((GAS float*)(WSP(WS_YP1)))
#define YP2 ((GAS float*)(WSP(WS_YP2)))
#define CTXLIVE (pair == 0)

template <int pair>
__device__ __forceinline__ void layer_pair(Frame& F, const Args& args, const XcdBarrier& bar) {
        const int base = 2 + 16 * pair, l0 = 2 * pair, l1 = l0 + 1, j = pair;
        relane(F); F.ws = opq(F.ws);
#define mod0 (MOD + (size_t)l0 * 2 * NMOD)
#define mod1 (MOD + (size_t)l1 * 2 * NMOD)
#define modp (MOD + (size_t)(l0 - 1) * 2 * NMOD)
        if (IN(base + 0)) {
            if (pair == 0) thin_rn<0, 1, false, true>(F, args, nullptr, nullptr, MTOT, nullptr, nullptr, 0, AIN(6) + l0 * DM, mod0, 0, 1);
            else { if (REP_RN) { thin_rn<1, 4, true, true>(F, args, Y2, YP2, MTOT, AIN(9) + (l0 - 1) * DM, modp, 5, AIN(6) + l0 * DM, mod0, 0, 1); } thin_rn<1, 4, false, true>(F, args, Y2, YP2, MTOT, AIN(9) + (l0 - 1) * DM, modp, 5, AIN(6) + l0 * DM, mod0, 0, 1); }
        } SEAM(base + 0);
        if (IN(base + 1)) {
            for (int rep = 0; rep <= REP_S5; ++rep) phase_s5(F, args, j);
        } SEAM(base + 1);
        if (IN(base + 2)) { for (int rep = 0; rep <= REP_THIN; ++rep) phase_a2(F, args); } SEAM(base + 2);
        if (IN(base + 3)) {
            pg8::Gemm g{(gen_cbf)(Zb), (gen_cbf)((const GAS bf16*)(WSP(WS_WGLU)) + (size_t)j * 4096 * DM), SEQ, 4096, DM}; pg8::StaticOrder S; S.init(SEQ, 4096, F.G, PG_CID, WGM_GLU);
            pg8::EpiGlu E{Y1, DM};
            for (int rep = 0; rep <= REP_GEMM + REP_GGLU; ++rep)
            pg8::gemm_phase<pg8::EpiGlu, pg8::StaticOrder, PG_ALIGN, PG_SP2>(F.lds + RING_OFF, g, S, E);
            { CtxGlu CE{YP1}; for (int rep = 0; rep <= REP_CTX; ++rep) ctx_gemm<64, 4, 1, 4>(F, Zb + (size_t)SEQ * DM, (const GAS bf16*)(WSP(WS_WGLU)) + (size_t)j * 4096 * DM, DM, 64, CE); }
        } SEAM(base + 3);
        if (IN(base + 4)) { if (REP_RN) { thin_rn<1, 1, true>(F, args, Y1, YP1, MTOT, AIN(7) + l0 * DM, mod0, 2, AIN(8) + l0 * DM, mod0, 3, 4); } thin_rn<1, 1>(F, args, Y1, YP1, MTOT, AIN(7) + l0 * DM, mod0, 2, AIN(8) + l0 * DM, mod0, 3, 4); } SEAM(base + 4);
        if (IN(base + 5)) {
            pg8::Gemm g{(gen_cbf)(Hb), (gen_cbf)((const GAS bf16*)(WSP(WS_W1)) + (size_t)l0 * HID * DM), SEQ, HID, DM}; pg8::StaticOrder S; S.init(SEQ, HID, F.G, PG_CID, WGM_IN);
            pg8::EpiRelu2 E{(GAS bf16*)(WSP(WS_HID)), HID};
            for (int rep = 0; rep <= REP_GEMM + REP_GIN; ++rep)
            pg8::gemm_phase<pg8::EpiRelu2, pg8::StaticOrder, PG_ALIGN, PG_SP2>(F.lds + RING_OFF, g, S, E);
            { CtxRelu2 CE{(GAS bf16*)(WSP(WS_HID))}; for (int rep = 0; rep <= REP_CTX; ++rep) ctx_gemm<128, 4, 1, 4>(F, Hb + (size_t)SEQ * DM, (const GAS bf16*)(WSP(WS_W1)) + (size_t)l0 * HID * DM, DM, 128, CE); }
        } SEAM(base + 5);
        if (IN(base + 6)) {
            pg8::Gemm g{(gen_cbf)(HIDb), (gen_cbf)((const GAS bf16*)(WSP(WS_W2)) + (size_t)l0 * DM * HID), SEQ, DM, HID}; pg8::StaticOrder S; S.init(SEQ, DM, F.G, PG_CID, WGM_OUT);
            pg8::EpiBf16P E{Y2, DM};
            for (int rep = 0; rep <= REP_GEMM + REP_GOUT; ++rep)
            pg8::gemm_phase<pg8::EpiBf16P, pg8::StaticOrder, PG_ALIGN, PG_SP2>(F.lds + RING_OFF, g, S, E);
            { CtxPart CE{YP2}; for (int rep = 0; rep <= REP_CTX; ++rep) ctx_gemm<128, 4, 4, 4>(F, HIDb + (size_t)SEQ * HID, (const GAS bf16*)(WSP(WS_W2)) + (size_t)l0 * DM * HID, HID, 32, CE); }
        } SEAM(base + 6);
        if (IN(base + 7)) { if (REP_RN) { thin_rn<1, 4, true>(F, args, Y2, YP2, MTOT, AIN(9) + l0 * DM, mod0, 5, AIN(6) + l1 * DM, mod1, 0, 1); } thin_rn<1, 4>(F, args, Y2, YP2, MTOT, AIN(9) + l0 * DM, mod0, 5, AIN(6) + l1 * DM, mod1, 0, 1); } SEAM(base + 7);
        if (IN(base + 8)) {
            pg8::Gemm g{(gen_cbf)(Hb), (gen_cbf)((const GAS bf16*)(WSP(WS_WIN)) + (size_t)j * 10240 * DM), SEQ, 10240, DM}; pg8::StaticOrder S; S.init(SEQ, 10240, F.G, PG_CID, WGM_HG);
            pg8::EpiHgIn E{(GAS bf16*)(WSP(WS_Q)), (WS_V - WS_Q) / 2, (GAS bf16*)(WSP(WS_LF)), (WS_LB - WS_LF) / 2, (const GAS float*)(WSP(WS_LBV)) + (size_t)j * 2 * DM};
            static_assert(WS_SG - WS_V == WS_V - WS_Q, "Q|V|SG equally spaced");
            for (int rep = 0; rep <= REP_GEMM + REP_GHG; ++rep)
            pg8::gemm_phase<pg8::EpiHgIn, pg8::StaticOrder, PG_ALIGN, PG_SP2>(F.lds + RING_OFF, g, S, E);
#if defined(REP_GHG_CHEAP)
            { pg8::EpiBf16P E2{(GAS bf16*)(WSP(WS_REC)), 10240}; pg8::gemm_phase<pg8::EpiBf16P, pg8::StaticOrder, PG_ALIGN, PG_SP2>(F.lds + RING_OFF, g, S, E2); }
#endif
            { CtxHgIn CE{(GAS bf16*)(WSP(WS_Q)), (WS_V - WS_Q) / 2, (GAS bf16*)(WSP(WS_LF)), (WS_LB - WS_LF) / 2, (const GAS float*)(WSP(WS_LBV)) + (size_t)j * 2 * DM}; for (int rep = 0; rep <= REP_CTX; ++rep) ctx_gemm<128, 5, 1, 8>(F, Hb + (size_t)SEQ * DM, (const GAS bf16*)(WSP(WS_WIN)) + (size_t)j * 10240 * DM, DM, 128, CE); }
        } SEAM(base + 8);
        for (int rep = 0; rep <= REP_HG; ++rep) {
        for (int rep1 = 0; rep1 <= REP_R1; ++rep1) { if (IN(base + 9)) { phase_hg_r1(F, args); } SEAM(base + 9); }
        for (int rep2 = 0; rep2 <= REP_R2; ++rep2) { if (IN(base + 10)) { phase_hg_r2(F, args); } SEAM(base + 10); }
        }
        if (IN(base + 11)) { for (int rep = 0; rep <= REP_THIN; ++rep) phase_a4(F, args, AIN(23) + j * DM); } SEAM(base + 11);
        if (IN(base + 12)) {
            pg8::Gemm g{(gen_cbf)(Zb), (gen_cbf)((const GAS bf16*)(WSP(WS_WOUT)) + (size_t)j * DM * DM), SEQ, DM, DM}; pg8::StaticOrder S; S.init(SEQ, DM, F.G, PG_CID, WGM_OP);
            pg8::EpiBf16P E{Y1, DM};
            for (int rep = 0; rep <= REP_GEMM + REP_GOUT; ++rep)
            pg8::gemm_phase<pg8::EpiBf16P, pg8::StaticOrder, PG_ALIGN, PG_SP2>(F.lds + RING_OFF, g, S, E);
            if (CTXLIVE) { CtxPart CE{YP1}; for (int rep = 0; rep <= REP_CTX; ++rep) ctx_gemm<128, 4, 4, 4>(F, Zb + (size_t)SEQ * DM, (const GAS bf16*)(WSP(WS_WOUT)) + (size_t)j * DM * DM, DM, 32, CE); }
        } SEAM(base + 12);
        if (IN(base + 13)) { if (REP_RN) { thin_rn<1, 4, true>(F, args, Y1, YP1, (pair == 1 ? SEQ : MTOT), AIN(7) + l1 * DM, mod1, 2, AIN(8) + l1 * DM, mod1, 3, 4); } thin_rn<1, 4>(F, args, Y1, YP1, (pair == 1 ? SEQ : MTOT), AIN(7) + l1 * DM, mod1, 2, AIN(8) + l1 * DM, mod1, 3, 4); } SEAM(base + 13);
        if (IN(base + 14)) {
            pg8::Gemm g{(gen_cbf)(Hb), (gen_cbf)((const GAS bf16*)(WSP(WS_W1)) + (size_t)l1 * HID * DM), SEQ, HID, DM}; pg8::StaticOrder S; S.init(SEQ, HID, F.G, PG_CID, WGM_IN);
            pg8::EpiRelu2 E{(GAS bf16*)(WSP(WS_HID)), HID};
            for (int rep = 0; rep <= REP_GEMM + REP_GIN; ++rep)
            pg8::gemm_phase<pg8::EpiRelu2, pg8::StaticOrder, PG_ALIGN, PG_SP2>(F.lds + RING_OFF, g, S, E);
            if (CTXLIVE) { CtxRelu2 CE{(GAS bf16*)(WSP(WS_HID))}; for (int rep = 0; rep <= REP_CTX; ++rep) ctx_gemm<128, 4, 1, 4>(F, Hb + (size_t)SEQ * DM, (const GAS bf16*)(WSP(WS_W1)) + (size_t)l1 * HID * DM, DM, 128, CE); }
        } SEAM(base + 14);
        if (IN(base + 15)) {
            pg8::Gemm g{(gen_cbf)(HIDb), (gen_cbf)((const GAS bf16*)(WSP(WS_W2)) + (size_t)l1 * DM * HID), SEQ, DM, HID}; pg8::StaticOrder S; S.init(SEQ, DM, F.G, PG_CID, WGM_OUT);
            pg8::EpiBf16P E{Y2, DM};
            for (int rep = 0; rep <= REP_GEMM + REP_GOUT; ++rep)
            pg8::gemm_phase<pg8::EpiBf16P, pg8::StaticOrder, PG_ALIGN, PG_SP2>(F.lds + RING_OFF, g, S, E);
            if (CTXLIVE) { CtxPart CE{YP2}; for (int rep = 0; rep <= REP_CTX; ++rep) ctx_gemm<128, 4, 4, 4>(F, HIDb + (size_t)SEQ * HID, (const GAS bf16*)(WSP(WS_W2)) + (size_t)l1 * DM * HID, HID, 32, CE); }
        } SEAM(base + 15);
    }
__global__ void __launch_bounds__(NTHR, 2) mk_fwd(Args args) {
    extern __shared__ __attribute__((aligned(16))) unsigned char lds[];
    Frame F;
    F.lds = (LAS unsigned char*)lds;
    F.MISC = (volatile LAS unsigned*)(F.lds + MISC_OFF);
    F.tid = threadIdx.x; F.lane = F.tid & 63; F.wave = __builtin_amdgcn_readfirstlane(F.tid >> 6);
    F.G = gridDim.x; { const int bx = blockIdx.x; F.vcu = (F.G % 8 == 0) ? (bx % 8) * (F.G / 8) + bx / 8 : bx; }
    F.ws = (GAS unsigned char*)args.ws; F.out = (GAS float*)args.out;
    for (int u = F.tid; u < (LDS_BYTES - LDSCTL_OFF) / 4; u += NTHR) ((LAS unsigned*)(F.lds + LDSCTL_OFF))[u] = 0u;
    __syncthreads();
    gen_u32p barw = (gen_u32p)((GAS unsigned*)(WSP(WS_CTL)) + CW_BAR);
    XcdBarrier bar; bar.bar = barw; bar.x = 0; bar.st = nullptr;
    if (!MK_PER_PHASE) bar = xcd_barrier_post(barw, F.MISC + 8);
    if (IN(0)) { for (int rep = 0; rep <= REP_P0; ++rep) phase_p0(F, args); } SEAM(0);
    for (int rep = 0; rep < REP_BAR; ++rep) xcd_barrier(bar);
    if (IN(1)) { phase_p1(F, args); } SEAM(1);

    layer_pair<0>(F, args, bar);
    layer_pair<1>(F, args, bar);
    if (IN(34)) { thin_rn<2, 1>(F, args, Y2, nullptr, SEQ, AIN(9) + 3 * DM, MOD + (size_t)3 * 2 * NMOD, 5, nullptr, nullptr, 0, 0); }
#undef IN
#undef SEAM
}

extern "C" void kernel_launch(void* const* d_in, const int* in_sizes, int n_in, void* d_out, int out_size, void* d_ws, size_t ws_size, hipStream_t stream) {
    static int grid = 0;
    if (grid == 0) {
        if (n_in != 25 || out_size != SEQ * DM || ws_size < WS_END) { fprintf(stderr, "kernel_launch: unexpected shapes (n_in %d out %d ws %zu need %zu)\n", n_in, out_size, ws_size, (size_t)WS_END); grid = -1; return; }
        int dev = 0, cus = 0, per_cu = 0;
        if (hipGetDevice(&dev) != hipSuccess || hipDeviceGetAttribute(&cus, hipDeviceAttributeMultiprocessorCount, dev) != hipSuccess) { grid = -1; return; }
        if (hipFuncSetAttribute((const void*)mk_fwd, hipFuncAttributeMaxDynamicSharedMemorySize, LDS_BYTES) != hipSuccess) { fprintf(stderr, "kernel_launch: hipFuncSetAttribute failed\n"); grid = -1; return; }
        if (hipOccupancyMaxActiveBlocksPerMultiprocessor(&per_cu, (const void*)mk_fwd, NTHR, LDS_BYTES) != hipSuccess || per_cu < 1) { fprintf(stderr, "kernel_launch: occupancy query says %d\n", per_cu); (void)hipGetLastError(); }
        grid = cus;
    }
    if (grid < 0) return;
    if (hipMemsetAsync((char*)d_ws + WS_CTL, 0, CTL_ZERO_BYTES, stream) != hipSuccess) return;
    Args a{};
    for (int i = 0; i < 25; ++i) a.in[i] = (const float*)d_in[i];
    a.out = (float*)d_out; a.ws = (unsigned char*)d_ws;
#if MK_PER_PHASE
    for (int p = 0; p < NPHASES; ++p) {  a.ph_lo = p; a.ph_hi = p + 1; hipLaunchKernelGGL(mk_fwd, dim3(grid), dim3(NTHR), LDS_BYTES, stream, a); }
#else
    a.ph_lo = 0; a.ph_hi = NPHASES; hipLaunchKernelGGL(mk_fwd, dim3(grid), dim3(NTHR), LDS_BYTES, stream, a);
#endif
}
```

```cpp
#include <hip/hip_runtime.h>
#include <cstdio>
#include <cstdint>
#define GAS __attribute__((address_space(1)))
#ifndef PG_WGM
#define PG_WGM 8
#endif
namespace pg8 {
#define PG8_LAS __attribute__((address_space(3)))
typedef unsigned short bf16_t;
typedef short bf16x8 __attribute__((ext_vector_type(8)));
typedef float f32x4 __attribute__((ext_vector_type(4)));
typedef unsigned u32x4 __attribute__((ext_vector_type(4)));
constexpr int BM = 256, BK = 64, HALF = 128, HTB = HALF * BK * 2  , STAGE_BYTES = 8 * HTB, NXCD = 8, WGM = PG_WGM;

__host__ __device__ __forceinline__ int lds_byte(int r, int c) { const int st = (r >> 4) * 2 + (c >> 5), rr = r & 15, cc = c & 31, ob = rr * 64 + cc * 2; return st * 1024 + (ob ^ (((ob >> 9) & 1) << 5)); }
__host__ __device__ __forceinline__ void stage_rc(int b, int& R, int& C) { const int st = b / 1024, sb = b % 1024, swz = sb ^ (((sb >> 9) & 1) << 5); R = (st >> 1) * 16 + swz / 64; C = (st & 1) * 32 + (swz % 64) / 2; }
__host__ __device__ __forceinline__ int perm32(int rho) { const int n = rho >> 4, i = rho & 15; return 8 * (i >> 2) + 4 * n + (i & 3); }

struct Unit { int pm, pn; };
struct Gemm { const bf16_t* A; const bf16_t* Bt; int M, N, K; };

struct StaticOrder {
    int nM, nN, nwg, G, c, wgm;
    __host__ __device__ void init(int M, int N, int G_, int c_, int wgm_ = WGM) { nM = M / BM; nN = N / BM; nwg = nM * nN; G = G_; c = c_; wgm = wgm_; }
    __host__ __device__ bool next(int i, Unit& u) const {
        const long L = (long)i * G + c; if (L >= nwg) return false;
        int wgid = (int)L; { const int q = nwg / NXCD, r = nwg % NXCD, xcd = wgid % NXCD, off = wgid / NXCD; wgid = (xcd < r ? xcd * (q + 1) : r * (q + 1) + (xcd - r) * q) + off; }
        const int nig = wgm * nN, gid = wgid / nig, fm = gid * wgm, gsz = (nM - fm) < wgm ? (nM - fm) : wgm;
        u.pm = fm + ((wgid % nig) % gsz); u.pn = (wgid % nig) / gsz; return true;
    }
    __device__ __forceinline__ void a_ready(const Unit&) const {}
    __device__ __forceinline__ void done(const Unit&) const {}
};

__device__ __forceinline__ unsigned cvt_pk_bf16(float lo, float hi) { unsigned r; asm volatile("v_cvt_pk_bf16_f32 %0, %1, %2" : "=v"(r) : "v"(lo), "v"(hi)); return r; }
typedef float f32x2 __attribute__((ext_vector_type(2)));
#ifndef EPI_NT
#define EPI_NT 0
#endif
#if EPI_NT
#define EPI_ST(p, v) __builtin_nontemporal_store((v), (p))
#else
#define EPI_ST(p, v) (*(p) = (v))
#endif
__device__ __forceinline__ float sigmoid_f(float x) { return __builtin_amdgcn_rcpf(1.0f + __expf(-x)); }
__device__ __forceinline__ float silu_f(float x) { return x * sigmoid_f(x); }
__device__ __forceinline__ float logf_gate(float z, float lb, float  ) {
    const float e = __expf(-fabsf(z));
    const float r = __builtin_amdgcn_rcpf(1.0f + e);
    const float sg = z >= 0.f ? r : e * r;
    const float a = fminf(z, 0.0f) - __logf(1.0f + e);
    const float b = __logf(lb + (1.0f - lb) * sg);
    return lb > 0.0f ? b : a;
}

struct EpiF32 {
    static constexpr bool PERM = false, AFTER_DRAIN = false;
    GAS float* C; int ldc;
    __device__ __forceinline__ void operator()(const f32x4 (&acc)[2][2][4][2], const Unit& u, int wr, int wc, int fr, int fq) const {
        const int row0 = u.pm * BM + wr * 64 + fr, col0 = u.pn * BM + wc * 32 + 4 * fq;
#pragma unroll
        for (int ai = 0; ai < 2; ++ai)
#pragma unroll
            for (int m = 0; m < 4; ++m) { GAS float* rowp = C + (size_t)(row0 + ai * HALF + m * 16) * ldc + col0;
#pragma unroll
                for (int bj = 0; bj < 2; ++bj)
#pragma unroll
                    for (int n = 0; n < 2; ++n) *(GAS f32x4*)(rowp + bj * HALF + n * 16) = acc[ai][bj][m][n]; }
    }
};
struct EpiRelu2 {
    static constexpr bool PERM = true, AFTER_DRAIN = false;
    GAS bf16_t* O; int ldc;
    __device__ __forceinline__ void operator()(const f32x4 (&acc)[2][2][4][2], const Unit& u, int wr, int wc, int fr, int fq) const {
        const int row0 = u.pm * BM + wr * 64 + fr, col0 = u.pn * BM + wc * 32 + 8 * fq;
#pragma unroll
        for (int ai = 0; ai < 2; ++ai)
#pragma unroll
            for (int m = 0; m < 4; ++m) { GAS bf16_t* rowp = O + (size_t)(row0 + ai * HALF + m * 16) * ldc + col0;
#pragma unroll
                for (int bj = 0; bj < 2; ++bj) { f32x4 v0 = acc[ai][bj][m][0], v1 = acc[ai][bj][m][1];
#pragma unroll
                    for (int j = 0; j < 4; ++j) { const float a = fmaxf(v0[j], 0.f), b = fmaxf(v1[j], 0.f); v0[j] = a * a; v1[j] = b * b; }
                    u32x4 w; w.x = cvt_pk_bf16(v0[0], v0[1]); w.y = cvt_pk_bf16(v0[2], v0[3]); w.z = cvt_pk_bf16(v1[0], v1[1]); w.w = cvt_pk_bf16(v1[2], v1[3]);
                    EPI_ST((GAS u32x4*)(rowp + bj * HALF), w); } }
    }
};
struct EpiBf16P {
    static constexpr bool PERM = true, AFTER_DRAIN = false;
    GAS bf16_t* O; int ldc;
    __device__ __forceinline__ void operator()(const f32x4 (&acc)[2][2][4][2], const Unit& u, int wr, int wc, int fr, int fq) const {
        const int row0 = u.pm * BM + wr * 64 + fr, col0 = u.pn * BM + wc * 32 + 8 * fq;
#pragma unroll
        for (int ai = 0; ai < 2; ++ai)
#pragma unroll
            for (int m = 0; m < 4; ++m) { GAS bf16_t* rowp = O + (size_t)(row0 + ai * HALF + m * 16) * ldc + col0;
#pragma unroll
                for (int bj = 0; bj < 2; ++bj) { const f32x4 v0 = acc[ai][bj][m][0], v1 = acc[ai][bj][m][1];
                    u32x4 w; w.x = cvt_pk_bf16(v0[0], v0[1]); w.y = cvt_pk_bf16(v0[2], v0[3]); w.z = cvt_pk_bf16(v1[0], v1[1]); w.w = cvt_pk_bf16(v1[2], v1[3]);
                    EPI_ST((GAS u32x4*)(rowp + bj * HALF), w); } }
    }
};
struct EpiGlu {
    static constexpr bool PERM = true, AFTER_DRAIN = false;
    GAS bf16_t* O; int ldc;
    __device__ __forceinline__ void operator()(const f32x4 (&acc)[2][2][4][2], const Unit& u, int wr, int wc, int fr, int fq) const {
        const int row0 = u.pm * BM + wr * 64 + fr, col0 = u.pn * HALF + wc * 32 + 8 * fq;
#pragma unroll
        for (int ai = 0; ai < 2; ++ai)
#pragma unroll
            for (int m = 0; m < 4; ++m) { GAS bf16_t* rowp = O + (size_t)(row0 + ai * HALF + m * 16) * ldc + col0;
                f32x4 o0, o1;
#pragma unroll
                for (int j = 0; j < 4; ++j) { o0[j] = acc[ai][0][m][0][j] * sigmoid_f(acc[ai][1][m][0][j]); o1[j] = acc[ai][0][m][1][j] * sigmoid_f(acc[ai][1][m][1][j]); }
                u32x4 w; w.x = cvt_pk_bf16(o0[0], o0[1]); w.y = cvt_pk_bf16(o0[2], o0[3]); w.z = cvt_pk_bf16(o1[0], o1[1]); w.w = cvt_pk_bf16(o1[2], o1[3]);
                EPI_ST((GAS u32x4*)(rowp), w); }
    }
};
struct EpiHgIn {
    static constexpr bool PERM = true, AFTER_DRAIN = false;
    GAS bf16_t* Q; size_t hstride; GAS bf16_t* LF; size_t fstride; const GAS float* lbv;
    template <int BJ> __device__ __forceinline__ void gate_half(const f32x4 (&acc)[2][2][4][2], GAS bf16_t* O, const GAS float* lbp, int row0, int col0) const {
        const f32x4 lb0 = *(const GAS f32x4*)(lbp + BJ * HALF), lb1 = *(const GAS f32x4*)(lbp + BJ * HALF + 4);
#pragma unroll
        for (int ai = 0; ai < 2; ++ai)
#pragma unroll
            for (int m = 0; m < 4; ++m) { GAS bf16_t* rowp = O + (size_t)(row0 + ai * HALF + m * 16) * 2048 + col0 + BJ * HALF;
                f32x4 o0, o1;
#pragma unroll
                for (int j = 0; j < 4; ++j) { o0[j] = logf_gate(acc[ai][BJ][m][0][j], lb0[j], 0.f); o1[j] = logf_gate(acc[ai][BJ][m][1][j], lb1[j], 0.f); }
                u32x4 w; w.x = cvt_pk_bf16(o0[0], o0[1]); w.y = cvt_pk_bf16(o0[2], o0[3]); w.z = cvt_pk_bf16(o1[0], o1[1]); w.w = cvt_pk_bf16(o1[2], o1[3]);
                EPI_ST((GAS u32x4*)(rowp), w); }
    }
    __device__ __forceinline__ void operator()(const f32x4 (&acc)[2][2][4][2], const Unit& u, int wr, int wc, int fr, int fq) const {
        const int typ = u.pn >> 3, row0 = u.pm * BM + wr * 64 + fr, col0 = (u.pn & 7) * BM + wc * 32 + 8 * fq;
        if (typ == 2 || typ == 3) {
            GAS bf16_t* O = LF + (size_t)(typ - 2) * fstride;
            const GAS float* lbp = lbv + (typ == 2 ? 0 : 2048) + col0;
            gate_half<0>(acc, O, lbp, row0, col0); gate_half<1>(acc, O, lbp, row0, col0);
        } else {
            GAS bf16_t* O = Q + (size_t)((typ >> 2) * 2 + (typ & 1)) * hstride; const bool act = typ != 1;
#pragma unroll
            for (int ai = 0; ai < 2; ++ai)
#pragma unroll
                for (int m = 0; m < 4; ++m) { GAS bf16_t* rowp = O + (size_t)(row0 + ai * HALF + m * 16) * 2048 + col0;
#pragma unroll
                    for (int bj = 0; bj < 2; ++bj) { f32x4 v0 = acc[ai][bj][m][0], v1 = acc[ai][bj][m][1];
                        if (act) {
#pragma unroll
                            for (int j = 0; j < 4; ++j) { v0[j] = silu_f(v0[j]); v1[j] = silu_f(v1[j]); } }
                        u32x4 w; w.x = cvt_pk_bf16(v0[0], v0[1]); w.y = cvt_pk_bf16(v0[2], v0[3]); w.z = cvt_pk_bf16(v1[0], v1[1]); w.w = cvt_pk_bf16(v1[2], v1[3]);
                        EPI_ST((GAS u32x4*)(rowp + bj * HALF), w); } }
        }
    }
};
#ifndef PG_AUX_A
#define PG_AUX_A 0
#endif
#ifndef PG_AUX_B
#define PG_AUX_B 0
#endif
template <class Epi, class Sched, bool ALIGN_EPI = false, bool SP2 = false>
__device__ __forceinline__ void gemm_phase(PG8_LAS unsigned char* lds, const Gemm g, const Sched& S, const Epi& E) {
    int tid_ = threadIdx.x; asm volatile("" : "+v"(tid_));
    const int tid = tid_, wid = __builtin_amdgcn_readfirstlane(tid >> 6), lane = tid & 63, wr = wid >> 2, wc = wid & 3, fr = lane & 15, fq = lane >> 4;
    const int K = g.K, nt = K / BK;
    unsigned voffA[2], voffB[2];
#pragma unroll
    for (int i = 0; i < 2; ++i) { int R, C; stage_rc(tid * 16 + i * 8192, R, C); const int Rb = Epi::PERM ? ((R & ~31) + perm32(R & 31)) : R;
        voffA[i] = (unsigned)(R * K + C) * 2u; voffB[i] = (unsigned)(Rb * K + C) * 2u; }
    const size_t kstep = (size_t)(BK * 2);
    const size_t hstep = (size_t)HALF * K * 2;
    const size_t tstep = 2 * hstep;
    const unsigned ldsw = (unsigned)wid * 1024u;
    const int aoff = lds_byte(wr * 64 + fr, fq * 8), boff = lds_byte(wc * 32 + fr, fq * 8);
#define PG8_SA(b, h) (((b) * 2 + (h)) * HTB)
#define PG8_SB(b, h) ((4 + (b) * 2 + (h)) * HTB)
#define PG8_STAGE(bufoff, gbase, voff) do { _Pragma("unroll") for (int _i = 0; _i < 2; ++_i) \
        __builtin_amdgcn_global_load_lds((const unsigned*)((const char*)(gbase) + (voff)[_i]), (PG8_LAS unsigned*)(lds + (bufoff) + ldsw + _i * 8192), 16, 0, PG_AUX_B); } while (0)
#define PG8_STAGEA(bufoff, gbase, voff) do { _Pragma("unroll") for (int _i = 0; _i < 2; ++_i) \
        __builtin_amdgcn_global_load_lds((const unsigned*)((const char*)(gbase) + (voff)[_i]), (PG8_LAS unsigned*)(lds + (bufoff) + ldsw + _i * 8192), 16, 0, PG_AUX_A); } while (0)
#define PG8_LDA(dst, b, h) do { _Pragma("unroll") for (int m = 0; m < 4; ++m) _Pragma("unroll") for (int k = 0; k < 2; ++k) dst[m][k] = *(const PG8_LAS bf16x8*)(lds + PG8_SA(b, h) + aoff + m * 2048 + k * 1024); } while (0)
#define PG8_LDB(dst, b, h) do { _Pragma("unroll") for (int n = 0; n < 2; ++n) _Pragma("unroll") for (int k = 0; k < 2; ++k) dst[n][k] = *(const PG8_LAS bf16x8*)(lds + PG8_SB(b, h) + boff + n * 2048 + k * 1024); } while (0)
#define PG8_MMA(ai, bj, At, Bt) do { __builtin_amdgcn_s_setprio(1); _Pragma("unroll") for (int m = 0; m < 4; ++m) _Pragma("unroll") for (int n = 0; n < 2; ++n) _Pragma("unroll") for (int k = 0; k < 2; ++k) \
        acc[ai][bj][m][n] = __builtin_amdgcn_mfma_f32_16x16x32_bf16(Bt[n][k], At[m][k], acc[ai][bj][m][n], 0, 0, 0); __builtin_amdgcn_s_setprio(0); } while (0)
#define PG8_WAIT_V(n) asm volatile("s_waitcnt vmcnt(" #n ")" ::: "memory")
#define PG8_WAIT_L(n) asm volatile("s_waitcnt lgkmcnt(" #n ")" ::: "memory")
#define PG8_BAR __builtin_amdgcn_s_barrier()
#define PG8_SCHED __builtin_amdgcn_sched_barrier(0)
    Unit cur, nxt; int ui = 0;
    if (!S.next(0, cur)) return;
    f32x4 acc[2][2][4][2];
#pragma unroll
    for (int a = 0; a < 2; ++a)
#pragma unroll
        for (int b = 0; b < 2; ++b)
#pragma unroll
            for (int m = 0; m < 4; ++m)
#pragma unroll
                for (int n = 0; n < 2; ++n) acc[a][b][m][n] = (f32x4){0.f, 0.f, 0.f, 0.f};
    bf16x8 At[4][2], B0[2][2], B1[2][2];
    const char* cA = (const char*)g.A + (size_t)cur.pm * tstep; const char* cB = (const char*)g.Bt + (size_t)cur.pn * tstep;
    S.a_ready(cur);
    if constexpr (SP2) {
        PG8_STAGE(PG8_SB(0, 0), cB, voffB); PG8_STAGE(PG8_SB(0, 1), cB + hstep, voffB); PG8_STAGEA(PG8_SA(0, 0), cA, voffA); PG8_STAGEA(PG8_SA(0, 1), cA + hstep, voffA);
        if (wr == 1) PG8_BAR;
        PG8_WAIT_V(2); PG8_BAR;
        PG8_STAGE(PG8_SB(1, 0), cB + kstep, voffB); PG8_STAGEA(PG8_SA(1, 0), cA + kstep, voffA); PG8_STAGE(PG8_SB(1, 1), cB + hstep + kstep, voffB);
        PG8_WAIT_V(6); PG8_BAR;
    } else {
        PG8_STAGE(PG8_SB(0, 0), cB, voffB); PG8_STAGEA(PG8_SA(0, 0), cA, voffA); PG8_STAGE(PG8_SB(0, 1), cB + hstep, voffB); PG8_STAGEA(PG8_SA(0, 1), cA + hstep, voffA);
        if (wr == 1) PG8_BAR;
        PG8_WAIT_V(4); PG8_BAR;
        PG8_STAGE(PG8_SB(1, 0), cB + kstep, voffB); PG8_STAGEA(PG8_SA(1, 0), cA + kstep, voffA); PG8_STAGE(PG8_SB(1, 1), cB + hstep + kstep, voffB);
        PG8_WAIT_V(6); PG8_BAR;
    }
    for (;;) {
        const bool has_next = S.next(ui + 1, nxt);
        const char* nA = has_next ? (const char*)g.A + (size_t)nxt.pm * tstep : cA; const char* nB = has_next ? (const char*)g.Bt + (size_t)nxt.pn * tstep : cB;
        for (int t = 0; t < nt; t += 2) {
            const bool last = (t == nt - 2);
            const char* a1 = cA + (size_t)(t + 1) * kstep;
            const char* a2 = last ? nA : cA + (size_t)(t + 2) * kstep; const char* b2 = last ? nB : cB + (size_t)(t + 2) * kstep;
            const char* a3 = a2 + kstep; const char* b3 = b2 + kstep;
            if (last && has_next) S.a_ready(nxt);
            if constexpr (SP2) {
            PG8_LDB(B0, 0, 0); PG8_LDB(B1, 0, 1); PG8_SCHED; PG8_LDA(At, 0, 0); PG8_STAGEA(PG8_SA(1, 1), a1 + hstep, voffA);
            PG8_WAIT_V(8); PG8_WAIT_L(0); PG8_BAR; PG8_MMA(0, 0, At, B0); PG8_MMA(0, 1, At, B1); PG8_BAR; PG8_SCHED;
            PG8_LDA(At, 0, 1); PG8_STAGE(PG8_SB(0, 0), b2, voffB); PG8_STAGE(PG8_SB(0, 1), b2 + hstep, voffB); PG8_STAGEA(PG8_SA(0, 0), a2, voffA);
            PG8_WAIT_V(8); PG8_WAIT_L(0); PG8_BAR; PG8_MMA(1, 0, At, B0); PG8_MMA(1, 1, At, B1); PG8_BAR; PG8_SCHED;
            PG8_LDB(B0, 1, 0); PG8_LDB(B1, 1, 1); PG8_SCHED; PG8_LDA(At, 1, 0); PG8_STAGEA(PG8_SA(0, 1), a2 + hstep, voffA);
            PG8_WAIT_V(8); PG8_WAIT_L(0); PG8_BAR; PG8_MMA(0, 0, At, B0); PG8_MMA(0, 1, At, B1); PG8_BAR; PG8_SCHED;
            PG8_LDA(At, 1, 1); PG8_STAGE(PG8_SB(1, 0), b3, voffB); PG8_STAGE(PG8_SB(1, 1), b3 + hstep, voffB); PG8_STAGEA(PG8_SA(1, 0), a3, voffA);
            PG8_WAIT_V(8); PG8_WAIT_L(0); PG8_BAR; PG8_MMA(1, 0, At, B0); PG8_MMA(1, 1, At, B1); PG8_BAR; PG8_SCHED;
            } else {
            PG8_LDB(B0, 0, 0); PG8_SCHED; PG8_LDA(At, 0, 0); PG8_STAGEA(PG8_SA(1, 1), a1 + hstep, voffA);
            PG8_WAIT_L(8); PG8_BAR; PG8_WAIT_L(0); PG8_MMA(0, 0, At, B0); PG8_BAR; PG8_SCHED;
            PG8_LDB(B1, 0, 1); PG8_STAGE(PG8_SB(0, 0), b2, voffB);
            PG8_BAR; PG8_WAIT_L(0); PG8_MMA(0, 1, At, B1); PG8_BAR;
            PG8_LDA(At, 0, 1); PG8_STAGEA(PG8_SA(0, 0), a2, voffA);
            PG8_BAR; PG8_WAIT_L(0); PG8_MMA(1, 0, At, B0); PG8_BAR; PG8_SCHED;
            PG8_STAGE(PG8_SB(0, 1), b2 + hstep, voffB);
            PG8_WAIT_V(6); PG8_BAR; PG8_MMA(1, 1, At, B1); PG8_BAR;
            PG8_LDB(B0, 1, 0); PG8_SCHED; PG8_LDA(At, 1, 0); PG8_STAGEA(PG8_SA(0, 1), a2 + hstep, voffA);
            PG8_WAIT_L(8); PG8_BAR; PG8_WAIT_L(0); PG8_MMA(0, 0, At, B0); PG8_BAR; PG8_SCHED;
            PG8_LDB(B1, 1, 1); PG8_STAGE(PG8_SB(1, 0), b3, voffB);
            PG8_BAR; PG8_WAIT_L(0); PG8_MMA(0, 1, At, B1); PG8_BAR;
            PG8_LDA(At, 1, 1); PG8_STAGEA(PG8_SA(1, 0), a3, voffA);
            PG8_BAR; PG8_WAIT_L(0); PG8_MMA(1, 0, At, B0); PG8_BAR; PG8_SCHED;
            PG8_STAGE(PG8_SB(1, 1), b3 + hstep, voffB);
            PG8_WAIT_V(6); PG8_BAR; PG8_MMA(1, 1, At, B1); PG8_BAR;
            }
        }
        if constexpr (ALIGN_EPI) { if (wr == 0) PG8_BAR; }
        if constexpr (!Epi::AFTER_DRAIN) { E(acc, cur, wr, wc, fr, fq); S.done(cur); }
        if (!has_next) break;
#pragma unroll
        for (int a = 0; a < 2; ++a)
#pragma unroll
            for (int b = 0; b < 2; ++b)
#pragma unroll
                for (int m = 0; m < 4; ++m)
#pragma unroll
                    for (int n = 0; n < 2; ++n) acc[a][b][m][n] = (f32x4){0.f, 0.f, 0.f, 0.f};
        cur = nxt; cA = nA; cB = nB; ++ui;
        if constexpr (ALIGN_EPI) { if (wr == 1) PG8_BAR; }
    }
    PG8_WAIT_V(0);
    if constexpr (!ALIGN_EPI) { if (wr == 0) PG8_BAR; }
    PG8_BAR;
    if constexpr (Epi::AFTER_DRAIN) { E.fused(acc, cur, wr, wc, fr, fq, lds, wid, lane); S.done(cur); }
#undef PG8_SA
#undef PG8_SB
#undef PG8_STAGE
#undef PG8_STAGEA
#undef PG8_LDA
#undef PG8_LDB
#undef PG8_MMA
#undef PG8_WAIT_V
#undef PG8_WAIT_L
#undef PG8_BAR
#undef PG8_SCHED
}
}
constexpr int DM = 2048, SEQ = 8192, CTXL = 256, MTOT = SEQ + CTXL, HID = 8192, NMOD = 6 * DM;
constexpr int NWAVES = 8, NTHR = 512;
constexpr float NEPS = 1e-6f;
#ifndef MK_PER_PHASE
#define MK_PER_PHASE 0
#endif
constexpr int NPHASES = 35;
#ifndef PG_CID
#define PG_CID ((int)((blockIdx.x >> 5) + 8 * (blockIdx.x & 31)))
#endif
#ifndef PG_ALIGN
#define PG_ALIGN true
#endif
#ifndef PG_SP2
#define PG_SP2 true
#endif
#ifndef REP_P0
#define REP_P0 0
#endif
#ifndef REP_S5
#define REP_S5 0
#endif
#ifndef REP_HG
#define REP_HG 0
#endif
#ifndef REP_GEMM
#define REP_GEMM 0
#endif
#ifndef REP_BAR
#define REP_BAR 0
#endif
#ifndef REP_R1
#define REP_R1 0
#endif
#ifndef REP_R2
#define REP_R2 0
#endif
#ifndef REP_GGLU
#define REP_GGLU 0
#endif
#ifndef REP_GIN
#define REP_GIN 0
#endif
#ifndef REP_GOUT
#define REP_GOUT 0
#endif
#ifndef REP_GHG
#define REP_GHG 0
#endif
#ifndef WGM_GLU
#define WGM_GLU 2
#endif
#ifndef WGM_IN
#define WGM_IN 2
#endif
#ifndef WGM_OUT
#define WGM_OUT 2
#endif
#ifndef WGM_HG
#define WGM_HG 2
#endif
#ifndef WGM_OP
#define WGM_OP 2
#endif
#ifndef REP_RN
#define REP_RN 0
#endif
#ifndef REP_CTX
#define REP_CTX 0
#endif
#ifndef REP_THIN
#define REP_THIN 0
#endif

constexpr size_t MiB = 1u << 20;
constexpr size_t WS_CTL = 0, CTL_ZERO_BYTES = 1 * MiB;
constexpr size_t WS_MOD = 1 * MiB;
constexpr size_t WS_LBV = 2 * MiB;
constexpr size_t WS_PART = 3 * MiB;
constexpr size_t WS_W1 = 16 * MiB;
constexpr size_t WS_W2 = WS_W1 + 128 * MiB;
constexpr size_t WS_WGLU = WS_W2 + 128 * MiB;
constexpr size_t WS_WIN = WS_WGLU + 32 * MiB;
constexpr size_t WS_WOUT = WS_WIN + 80 * MiB;
constexpr size_t WS_X = WS_WOUT + 16 * MiB;
constexpr size_t WS_H = WS_X + 66 * MiB;
constexpr size_t WS_Z = WS_H + 33 * MiB;
constexpr size_t WS_Y1 = WS_Z + 33 * MiB;
constexpr size_t WS_Y2 = WS_Y1 + 66 * MiB;
constexpr size_t WS_HID = WS_Y2 + 66 * MiB;
constexpr size_t WS_Q = WS_HID + 132 * MiB;
constexpr size_t WS_V = WS_Q + 33 * MiB;
constexpr size_t WS_SG = WS_V + 33 * MiB;
constexpr size_t WS_LF = WS_SG + 33 * MiB;
constexpr size_t WS_LB = WS_LF + 66 * MiB;
constexpr size_t WS_OF = WS_LB + 66 * MiB;
constexpr size_t WS_OB = WS_OF + 66 * MiB;
constexpr size_t WS_REC = WS_OB + 66 * MiB;
constexpr size_t WS_SEGS = WS_REC + 224 * MiB;
constexpr size_t WS_SEGD = WS_SEGS + 16 * MiB;
constexpr size_t WS_YP1 = WS_SEGD + 1 * MiB;
constexpr size_t WS_YP2 = WS_YP1 + 8 * MiB;
constexpr size_t WS_END = WS_YP2 + 8 * MiB;
constexpr int CW_BAR = 4096;

constexpr int RING_OFF = 0, RING_BYTES = 135168;
constexpr int LDSCTL_OFF = RING_BYTES, MISC_OFF = LDSCTL_OFF + 320;
constexpr int LDS_BYTES = 147456;

#define LAS __attribute__((address_space(3)))
typedef unsigned short bf16;
typedef unsigned v4u __attribute__((ext_vector_type(4)));
typedef unsigned v2u __attribute__((ext_vector_type(2)));
typedef float f32x4 __attribute__((ext_vector_type(4)));
typedef short bf16x8 __attribute__((ext_vector_type(8)));
#define LDS_WAIT() asm volatile("s_waitcnt lgkmcnt(0)" ::: "memory")
#define VM_WAIT() asm volatile("s_waitcnt vmcnt(0)" ::: "memory")
__device__ __forceinline__ unsigned f2bf(float f) { unsigned u = __builtin_bit_cast(unsigned, f); return (u + 0x7fffu + ((u >> 16) & 1u)) >> 16; }
__device__ __forceinline__ unsigned pk2(float lo, float hi) { return f2bf(lo) | (f2bf(hi) << 16); }
__device__ __forceinline__ float bflo(unsigned w) { return __builtin_bit_cast(float, w << 16); }
__device__ __forceinline__ float bfhi(unsigned w) { return __builtin_bit_cast(float, w & 0xffff0000u); }
typedef float f32x2 __attribute__((ext_vector_type(2)));
typedef __bf16 bf16x2n __attribute__((ext_vector_type(2)));
__device__ __forceinline__ unsigned pkbf(float lo, float hi) { f32x2 v = {lo, hi}; return __builtin_bit_cast(unsigned, __builtin_convertvector(v, bf16x2n)); }
__device__ __forceinline__ float bf1(bf16 b) { return __builtin_bit_cast(float, ((unsigned)b) << 16); }

#define XB_TMO      128
#define XB_XCNT(j)  (256  + 64 * (j))
#define XB_XSUB(j)  (1280 + 64 * (j))
#define XB_XGEN(j)  (2304 + 64 * (j))
#define XB_TOP      3328
#define XB_TOPGEN   3392
#define XCD_BAR_WORDS 3456
#define XB_SPIN_CAP (1u << 18)

__device__ __forceinline__ unsigned xb_ld(unsigned* p)              { return __hip_atomic_load(p, __ATOMIC_RELAXED, __HIP_MEMORY_SCOPE_AGENT); }
__device__ __forceinline__ unsigned xb_add(unsigned* p, unsigned v) { return __hip_atomic_fetch_add(p, v, __ATOMIC_RELAXED, __HIP_MEMORY_SCOPE_AGENT); }
__device__ __forceinline__ unsigned xb_xcc_id() { return (unsigned)__builtin_amdgcn_s_getreg((3 << 11) | 20) & 0xFu; }
#define XB_SPIN(cond, bar) do { unsigned _sp = 0; while (cond) { __builtin_amdgcn_s_sleep(1); \
    if ((++_sp & 255u) == 0u) { if (xb_ld(&(bar)[XB_TMO])) break; if (_sp > XB_SPIN_CAP) { atomicAdd(&(bar)[XB_TMO], 1u); break; } } } } while (0)

struct XcdBarrier {
    unsigned* bar; unsigned x;
    volatile LAS unsigned* st;
};

__device__ __forceinline__ XcdBarrier xcd_barrier_post(unsigned* bar, volatile LAS unsigned* st) {
    XcdBarrier b; b.bar = bar; b.x = xb_xcc_id(); b.st = st;
    if (threadIdx.x == 0) (void)xb_add(&bar[XB_XCNT(b.x)], 1u);
    return b;
}
__device__ __forceinline__ void xcd_barrier_complete(unsigned* bar, unsigned x, unsigned& nloc, unsigned& nx) {
    const unsigned G = gridDim.x * gridDim.y * gridDim.z;
    unsigned sum, cnt, mine, sp = 0u;
    for (;;) {
        sum = 0u; cnt = 0u; mine = 0u;
#pragma unroll
        for (unsigned j = 0; j < 16; ++j) { const unsigned c = xb_ld(&bar[XB_XCNT(j)]); sum += c; cnt += (c > 0u) ? 1u : 0u; mine = (j == x) ? c : mine; }
        if (sum == G) break;
        __builtin_amdgcn_s_sleep(1);
        if ((++sp & 255u) == 0u) { if (xb_ld(&bar[XB_TMO])) break; if (sp > XB_SPIN_CAP) { atomicAdd(&bar[XB_TMO], 1u); break; } }
    }
    nloc = mine > 0u ? mine : 1u; nx = cnt > 0u ? cnt : 1u;
}

__device__ __forceinline__ void xcd_barrier(const XcdBarrier& b) {
    asm volatile("s_waitcnt vmcnt(0)" ::: "memory");
    __syncthreads();
    if (threadIdx.x == 0) {
        unsigned* bar = b.bar;
        __builtin_amdgcn_s_waitcnt(0);
        unsigned nloc = b.st[0], nx = b.st[1];
        if (nloc == 0u) { xcd_barrier_complete(bar, b.x, nloc, nx); b.st[0] = nloc; b.st[1] = nx; }
        const unsigned old = xb_add(&bar[XB_XSUB(b.x)], 1u);
        const unsigned gen = old / nloc;
        if (old + 1u == (gen + 1u) * nloc) {
            __builtin_amdgcn_fence(__ATOMIC_RELEASE, "agent");
            asm volatile("s_waitcnt vmcnt(0)" ::: "memory");
            const unsigned og = xb_add(&bar[XB_TOP], 1u);
            const unsigned tg = og / nx;
            if (og + 1u == (tg + 1u) * nx) xb_add(&bar[XB_TOPGEN], 1u);
            else XB_SPIN(xb_ld(&bar[XB_TOPGEN]) == tg, bar);
            __builtin_amdgcn_fence(__ATOMIC_ACQUIRE, "agent");
            xb_add(&bar[XB_XGEN(b.x)], 1u);
            asm volatile("s_waitcnt vmcnt(0)" ::: "memory");
        } else {
            XB_SPIN(xb_ld(&bar[XB_XGEN(b.x)]) == gen, bar);
            __builtin_amdgcn_fence(__ATOMIC_ACQUIRE, "agent");
            asm volatile("s_waitcnt vmcnt(0)" ::: "memory");
        }
    }
    __syncthreads();
}

typedef const unsigned short* gen_cbf; typedef unsigned* gen_u32p;
struct Args { const float* in[25]; float* out; unsigned char* ws; int ph_lo, ph_hi; };
template <class T> __device__ __forceinline__ GAS T* opq(T* p) { GAS T* g = (GAS T*)p; asm volatile("" : "+s"(g)); return g; }
template <class T> __device__ __forceinline__ GAS T* opq(GAS T* g) { asm volatile("" : "+s"(g)); return g; }
__device__ __forceinline__ int opqv(int v) { asm volatile("" : "+v"(v)); return v; }
#define AIN(k) opq(args.in[k])
#define WSP(off) (opq(F.ws) + (off))
struct Frame {
    LAS unsigned char* lds;
    volatile LAS unsigned* MISC;
    int tid, lane, wave, vcu, G;
    GAS unsigned char* ws;
    GAS float* out;
};
__device__ __forceinline__ int opqs(int v) { asm volatile("" : "+s"(v)); return v; }
__device__ __forceinline__ void relane(Frame& F) { F.lane = opqv(F.lane); F.tid = opqv(F.tid); F.wave = opqs(F.wave); F.vcu = opqs(F.vcu);
    unsigned lb = (unsigned)(size_t)F.lds; asm volatile("" : "+s"(lb)); F.lds = (LAS unsigned char*)(size_t)lb; }
__device__ __forceinline__ float xshfl(float v, int lane, int o) { return __builtin_bit_cast(float, __builtin_amdgcn_ds_bpermute((lane ^ o) << 2, __builtin_bit_cast(int, v))); }
__device__ __forceinline__ float wave_sum(float v, int lane) {
#pragma unroll
    for (int o = 1; o < 64; o <<= 1) v += xshfl(v, lane, o);
    return v;
}

__device__ __forceinline__ void p0_transpose_item(const GAS float* W, int K, int N, GAS bf16* WT, int k0, int n0, int dst_row0, LAS unsigned char* scr, int lane) {
    const int n4 = (lane & 15) * 4, kp = lane >> 4;
    const GAS float* src = W + (size_t)(k0 + 2 * kp) * N + n0 + n4;
    f32x4 v[16];
#pragma unroll
    for (int i = 0; i < 8; ++i) { v[2 * i] = *(const GAS f32x4*)(src + (size_t)(8 * i) * N); v[2 * i + 1] = *(const GAS f32x4*)(src + (size_t)(8 * i + 1) * N); }
#pragma unroll
    for (int i = 0; i < 8; ++i) {
#pragma unroll
        for (int e = 0; e < 4; ++e) *(LAS unsigned*)(scr + (n4 + e) * 144 + (8 * i + 2 * kp) * 2) = pkbf(v[2 * i][e], v[2 * i + 1][e]);
    }
    LDS_WAIT(); asm volatile("" ::: "memory");
    const int c = lane & 7, nr = lane >> 3;
#pragma unroll
    for (int j = 0; j < 8; ++j) { const int n = nr + 8 * j; const v4u o = *(const LAS v4u*)(scr + n * 144 + c * 16);
        *(GAS v4u*)(WT + (size_t)(dst_row0 + n) * K + k0 + 8 * c) = o; }
    LDS_WAIT(); asm volatile("" ::: "memory");
}
__device__ __forceinline__ void phase_p0(Frame& F, const Args& args) {
    relane(F);
    LAS unsigned char* scr = F.lds + RING_OFF + F.wave * 9216;
    const int gw = F.vcu * NWAVES + F.wave, NGW = F.G * NWAVES;
    constexpr int I_W1 = (DM / 64) * (HID / 64);
    constexpr int I_W2 = (HID / 64) * (DM / 64);
    constexpr int I_GLU = (DM / 64) * (4096 / 64);
    constexpr int I_IN = (DM / 64) * (10240 / 64);
    constexpr int I_OUT = (DM / 64) * (DM / 64);
    constexpr int T_W1 = 4 * I_W1, T_W2 = 4 * I_W2, T_GLU = 2 * I_GLU, T_IN = 2 * I_IN, T_OUT = 2 * I_OUT;
    constexpr int NITEMS = T_W1 + T_W2 + T_GLU + T_IN + T_OUT;
    for (int it = gw; it < NITEMS; it += NGW) {
        int r = it;
        if (r < T_W1) { const int l = r / I_W1, q = r % I_W1, nblk = HID / 64, qg = q >> 3, qw = q & 3, qk = (q >> 2) & 1, kb = 2 * (qg / (nblk / 4)) + qk, nb = 4 * (qg % (nblk / 4)) + qw;
            p0_transpose_item(AIN(10) + (size_t)l * DM * HID, DM, HID, (GAS bf16*)(WSP(WS_W1)) + (size_t)l * HID * DM, 64 * kb, 64 * nb, 64 * nb, scr, F.lane); continue; } r -= T_W1;
        if (r < T_W2) { const int l = r / I_W2, q = r % I_W2, nblk = DM / 64, qg = q >> 3, qw = q & 3, qk = (q >> 2) & 1, kb = 2 * (qg / (nblk / 4)) + qk, nb = 4 * (qg % (nblk / 4)) + qw;
            p0_transpose_item(AIN(11) + (size_t)l * HID * DM, HID, DM, (GAS bf16*)(WSP(WS_W2)) + (size_t)l * DM * HID, 64 * kb, 64 * nb, 64 * nb, scr, F.lane); continue; } r -= T_W2;
        if (r < T_GLU) { const int l = r / I_GLU, q = r % I_GLU, nblk = 4096 / 64, qg = q >> 3, qw = q & 3, qk = (q >> 2) & 1, kb = 2 * (qg / (nblk / 4)) + qk, nb = 4 * (qg % (nblk / 4)) + qw, n0 = 64 * nb;
            const int c = n0 & 2047, dst = 256 * (c >> 7) + (n0 >= 2048 ? 128 : 0) + (c & 127);
            p0_transpose_item(AIN(20) + (size_t)l * DM * 4096, DM, 4096, (GAS bf16*)(WSP(WS_WGLU)) + (size_t)l * 4096 * DM, 64 * kb, n0, dst, scr, F.lane); continue; } r -= T_GLU;
        if (r < T_IN) { const int l = r / I_IN, q = r % I_IN, nblk = 10240 / 64, qg = q >> 3, qw = q & 3, qk = (q >> 2) & 1, kb = 2 * (qg / (nblk / 4)) + qk, nb = 4 * (qg % (nblk / 4)) + qw;
            p0_transpose_item(AIN(21) + (size_t)l * DM * 10240, DM, 10240, (GAS bf16*)(WSP(WS_WIN)) + (size_t)l * 10240 * DM, 64 * kb, 64 * nb, 64 * nb, scr, F.lane); continue; } r -= T_IN;
        { const int l = r / I_OUT, q = r % I_OUT, nblk = DM / 64, qg = q >> 3, qw = q & 3, qk = (q >> 2) & 1, kb = 2 * (qg / (nblk / 4)) + qk, nb = 4 * (qg % (nblk / 4)) + qw;
            p0_transpose_item(AIN(24) + (size_t)l * DM * DM, DM, DM, (GAS bf16*)(WSP(WS_WOUT)) + (size_t)l * DM * DM, 64 * kb, 64 * nb, 64 * nb, scr, F.lane); }
    }
    __syncthreads();
    LAS float* sc = (LAS float*)(F.lds + RING_OFF);
    for (int i = F.tid; i < 2 * DM; i += NTHR) { const float v = i < DM ? AIN(1)[i] : AIN(3)[i - DM]; sc[i] = v / (1.0f + __expf(-v)); }
    __syncthreads();
    LAS float* red = sc + 2 * DM;
    GAS float* PART = (GAS float*)(WSP(WS_PART));
    for (int it = F.vcu; it < 4 * 16 * 12; it += F.G) {
        const int l = it / 192, q = it % 192, kc = q / 12, cb = q % 12;
        const int c4 = F.tid & 255, rh = F.tid >> 8, col = cb * 1024 + c4 * 4;
        const GAS float* wp = AIN(4) + ((size_t)l * DM + kc * 128 + rh * 64) * NMOD + col;
        f32x4 a0 = {0.f, 0.f, 0.f, 0.f}, a1 = {0.f, 0.f, 0.f, 0.f};
#pragma unroll 8
        for (int k = 0; k < 64; ++k) { const f32x4 w = *(const GAS f32x4*)(wp + (size_t)k * NMOD); const float s0 = sc[kc * 128 + rh * 64 + k], s1 = sc[DM + kc * 128 + rh * 64 + k];
            a0 += w * s0; a1 += w * s1; }
        if (rh == 1) { *(LAS f32x4*)(red + c4 * 8) = a0; *(LAS f32x4*)(red + c4 * 8 + 4) = a1; }
        __syncthreads();
        if (rh == 0) { a0 += *(LAS f32x4*)(red + c4 * 8); a1 += *(LAS f32x4*)(red + c4 * 8 + 4);
            GAS float* o = PART + ((size_t)(l * 16 + kc) * 2) * NMOD + col;
            *(GAS f32x4*)o = a0; *(GAS f32x4*)(o + NMOD) = a1; }
        __syncthreads();
    }
}
__device__ __forceinline__ void phase_p1(Frame& F, const Args& args) {
    relane(F);
    const GAS float* PART = (const GAS float*)(WSP(WS_PART)); GAS float* MOD = (GAS float*)(WSP(WS_MOD)); GAS float* LBV = (GAS float*)(WSP(WS_LBV));
    const int gt = F.vcu * NTHR + F.tid, NT = F.G * NTHR;
    for (int i = gt; i < 4 * 2 * NMOD; i += NT) { const int l = i / (2 * NMOD), r = i % (2 * NMOD), w = r / NMOD, col = r % NMOD;
        float s = AIN(5)[l * NMOD + col];
#pragma unroll
        for (int kc = 0; kc < 16; ++kc) s += PART[((size_t)(l * 16 + kc) * 2 + w) * NMOD + col];
        MOD[i] = s; }
    for (int i = gt; i < 2 * 2 * DM; i += NT) { const int j = i / (2 * DM), r = i % (2 * DM), d = r / DM, col = r % DM;
        const float r0 = AIN(22)[(d * 2 + 0) * DM + col], r1 = AIN(22)[(d * 2 + 1) * DM + col];
        const float mx = fmaxf(r0, r1), e0 = expf(r0 - mx), e1 = expf(r1 - mx), w0 = e0 / (e0 + e1), w1 = e1 / (e0 + e1);
        LBV[i] = (j == 0) ? (w0 - w0) : ((w0 + w1) - w0); }
}

#define THIN_ROW_BODY(PG, PGP, PPRE, PSH, PSC, LD4, YV) do { \
        if (MODE != 0) { float s_ = 0.f; \
            _Pragma("unroll") for (int j = 0; j < 8; ++j) { const f32x4 yv_ = YV(j); s_ += (yv_.x * yv_.x + yv_.y * yv_.y) + (yv_.z * yv_.z + yv_.w * yv_.w); } \
            const float rs_ = 1.0f / sqrtf(wave_sum(s_, ln_) * (1.0f / DM) + NEPS); \
            _Pragma("unroll") for (int j = 0; j < 8; ++j) { const f32x4 g_ = LD4(PG, j), gp_ = LD4(PGP, j); x[j] += g_ * ((YV(j) * rs_) * gp_); if (j & 1) asm volatile("" ::: "memory"); } } \
        if (MODE == 2) { _Pragma("unroll") for (int j = 0; j < 8; ++j) *(GAS f32x4*)(F.out + (size_t)r * DM + 4 * ln_ + 256 * j) = x[j]; } \
        else { _Pragma("unroll") for (int j = 0; j < 8; ++j) { v2u xo_; xo_.x = pkbf(x[j].x, x[j].y); xo_.y = pkbf(x[j].z, x[j].w); *(GAS v2u*)(Xo + (size_t)r * DM + 4 * ln_ + 256 * j) = xo_; } \
            float s_ = 0.f; \
            _Pragma("unroll") for (int j = 0; j < 8; ++j) s_ += (x[j].x * x[j].x + x[j].y * x[j].y) + (x[j].z * x[j].z + x[j].w * x[j].w); \
            const float rs_ = 1.0f / sqrtf(wave_sum(s_, ln_) * (1.0f / DM) + NEPS); \
            _Pragma("unroll") for (int j = 0; j < 8; ++j) { const f32x4 gp_ = LD4(PPRE, j), sh_ = LD4(PSH, j), sc_ = LD4(PSC, j); \
                const f32x4 h_ = ((x[j] * rs_) * gp_) * (sc_ + 1.0f) + sh_; v2u o_; o_.x = pkbf(h_.x, h_.y); o_.y = pkbf(h_.z, h_.w); \
                if (HGM) *(GAS v2u*)(H + ((size_t)((ln_ >> 2) + 16 * j) * MTOT + r) * 16 + 4 * (ln_ & 3)) = o_; else *(GAS v2u*)(H + (size_t)r * DM + 4 * ln_ + 256 * j) = o_; if (j & 1) asm volatile("" ::: "memory"); } } } while (0)
#define THIN_YF(j) (y[j])
#define THIN_YP(j) ((f32x4){bflo(yp[j].x), bfhi(yp[j].x), bflo(yp[j].y), bfhi(yp[j].y)})
#define THIN_LDG(P, j) (*(const GAS f32x4*)((P) + 4 * ln_ + 256 * (j)))
#define THIN_LDL(P, j) (*(const LAS f32x4*)((P) + 4 * ln_ + 256 * (j)))
template <int MODE, int CP, bool DRY = false, bool HGM = false>
__device__ __forceinline__ void thin_rn(Frame& F, const Args& args, const GAS bf16* Y  , const GAS float* Yc  , int nrows_, const GAS float* gpost, const GAS float* modp  , int gate_chunk,
                                        const GAS float* gpre, const GAS float* modh  , int sh_chunk, int sc_chunk) {
    relane(F);
    GAS bf16* X = (GAS bf16*)(WSP(WS_X)); GAS bf16* H = (GAS bf16*)(WSP(WS_H)); GAS bf16* Xo = DRY ? (GAS bf16*)(WSP(WS_REC)) : X;
    const int gw = F.vcu * NWAVES + F.wave, NGW = F.G * NWAVES, nrows = (MODE == 2) ? SEQ : nrows_;
    const int nctx = nrows - SEQ;
    LAS float* RED = (LAS float*)(F.lds + RING_OFF) + 5 * DM;
    v2u cxq = {0u, 0u}; f32x4 cxf = {0.f, 0.f, 0.f, 0.f}, cyk[CP], cg = cxf, cgp = cxf, cpre = cxf, csh = cxf, csc = cxf;
#pragma unroll
    for (int k = 0; k < CP; ++k) cyk[k] = cxf;
#define THIN_CTX_LOAD(rc) do { const int c4_ = 4 * opqv(F.tid); \
        if (MODE == 0) cxf = *(const GAS f32x4*)(AIN(2) + (size_t)(rc) * DM + c4_); else cxq = *(const GAS v2u*)(X + (size_t)(SEQ + (rc)) * DM + c4_); \
        if (MODE != 0) { _Pragma("unroll") for (int k = 0; k < CP; ++k) cyk[k] = *(const GAS f32x4*)(Yc + ((size_t)k * CTXL + (rc)) * DM + c4_); \
            cg = *(const GAS f32x4*)(modp + NMOD + gate_chunk * DM + c4_); cgp = *(const GAS f32x4*)(gpost + c4_); } \
        cpre = *(const GAS f32x4*)(gpre + c4_); csh = *(const GAS f32x4*)(modh + NMOD + sh_chunk * DM + c4_); csc = *(const GAS f32x4*)(modh + NMOD + sc_chunk * DM + c4_); } while (0)
#define THIN_BSUM(v, slot) do { const int ln_ = opqv(F.lane); const float w_ = wave_sum((v), ln_); if (F.lane == 0) RED[(slot) * 8 + F.wave] = w_; __syncthreads(); \
        const f32x4 p0_ = *(const LAS f32x4*)(RED + (slot) * 8), p1_ = *(const LAS f32x4*)(RED + (slot) * 8 + 4); (v) = ((p0_.x + p0_.y) + (p0_.z + p0_.w)) + ((p1_.x + p1_.y) + (p1_.z + p1_.w)); } while (0)
#define THIN_CTX_COMPUTE(rc) do { const int c4_ = 4 * opqv(F.tid); const int r_ = SEQ + (rc); \
        f32x4 x_ = (MODE == 0) ? cxf : (f32x4){bflo(cxq.x), bfhi(cxq.x), bflo(cxq.y), bfhi(cxq.y)}; \
        if (MODE != 0) { f32x4 y_ = cyk[0]; _Pragma("unroll") for (int k = 1; k < CP; ++k) y_ += cyk[k]; \
            float s_ = (y_.x * y_.x + y_.y * y_.y) + (y_.z * y_.z + y_.w * y_.w); THIN_BSUM(s_, 0); \
            const float rs_ = 1.0f / sqrtf(s_ * (1.0f / DM) + NEPS); x_ += cg * ((y_ * rs_) * cgp); } \
        { v2u xo_; xo_.x = pkbf(x_.x, x_.y); xo_.y = pkbf(x_.z, x_.w); *(GAS v2u*)(Xo + (size_t)r_ * DM + c4_) = xo_; } \
        float s2_ = (x_.x * x_.x + x_.y * x_.y) + (x_.z * x_.z + x_.w * x_.w); THIN_BSUM(s2_, 1); \
        const float rs2_ = 1.0f / sqrtf(s2_ * (1.0f / DM) + NEPS); \
        const f32x4 h_ = ((x_ * rs2_) * cpre) * (csc + 1.0f) + csh; v2u o_; o_.x = pkbf(h_.x, h_.y); o_.y = pkbf(h_.z, h_.w); \
        if (HGM) *(GAS v2u*)(H + ((size_t)(c4_ >> 4) * MTOT + r_) * 16 + (c4_ & 15)) = o_; else *(GAS v2u*)(H + (size_t)r_ * DM + c4_) = o_; } while (0)
    if (MODE != 2 && F.vcu < nctx) THIN_CTX_LOAD(F.vcu);
    LAS float* PL = (LAS float*)(F.lds + RING_OFF);
    for (int i = F.tid; i < DM / 4; i += NTHR) {
        if (MODE != 0) { *(LAS f32x4*)(PL + 4 * i) = *(const GAS f32x4*)(modp + gate_chunk * DM + 4 * i); *(LAS f32x4*)(PL + DM + 4 * i) = *(const GAS f32x4*)(gpost + 4 * i); }
        if (MODE != 2) { *(LAS f32x4*)(PL + 2 * DM + 4 * i) = *(const GAS f32x4*)(gpre + 4 * i); *(LAS f32x4*)(PL + 3 * DM + 4 * i) = *(const GAS f32x4*)(modh + sh_chunk * DM + 4 * i); *(LAS f32x4*)(PL + 4 * DM + 4 * i) = *(const GAS f32x4*)(modh + sc_chunk * DM + 4 * i); }
    }
    __syncthreads();
    if (MODE != 2) {
        if (F.vcu < nctx) THIN_CTX_COMPUTE(F.vcu);
        for (int rc = F.vcu + F.G; rc < nctx; rc += F.G) { __syncthreads(); THIN_CTX_LOAD(rc); THIN_CTX_COMPUTE(rc); }
    }
    {
        f32x4 xn[8]; v2u xq[8], yn[8];
        const GAS float* xb0 = AIN(0);
#define THIN_PREF(rr) do { const int ln_ = opqv(F.lane); const int rc_ = (rr) < SEQ ? (rr) : SEQ - 1; if (MODE == 0) { _Pragma("unroll") for (int j = 0; j < 8; ++j) xn[j] = *(const GAS f32x4*)(xb0 + (size_t)rc_ * DM + 4 * ln_ + 256 * j); } \
            else { _Pragma("unroll") for (int j = 0; j < 8; ++j) xq[j] = *(const GAS v2u*)(X + (size_t)rc_ * DM + 4 * ln_ + 256 * j); } \
            if (MODE != 0) { _Pragma("unroll") for (int j = 0; j < 8; ++j) yn[j] = *(const GAS v2u*)(Y + (size_t)rc_ * DM + 4 * ln_ + 256 * j); } } while (0)
        THIN_PREF(gw);
        for (int r = gw; r < SEQ; r += NGW) {
            const int ln_ = opqv(F.lane);
            LAS float* PLr = PL + opqv(0);
            f32x4 x[8]; v2u yp[8];
#pragma unroll
            for (int j = 0; j < 8; ++j) { if (MODE == 0) x[j] = xn[j]; else { x[j] = (f32x4){bflo(xq[j].x), bfhi(xq[j].x), bflo(xq[j].y), bfhi(xq[j].y)}; yp[j] = yn[j]; } }
            THIN_PREF(r + NGW);
            THIN_ROW_BODY(PLr, PLr + DM, PLr + 2 * DM, PLr + 3 * DM, PLr + 4 * DM, THIN_LDL, THIN_YP);
        }
#undef THIN_PREF
    }
#undef THIN_CTX_LOAD
#undef THIN_CTX_COMPUTE
#undef THIN_BSUM
}
__device__ __forceinline__ float gelu_tanh(float x) { const float u = 1.5957691216f * (x + 0.044715f * x * x * x); return x / (1.0f + __expf(-u)); }
__device__ __forceinline__ void phase_a2(Frame& F, const Args& args) {
    relane(F);
    const GAS bf16* yf = (const GAS bf16*)(WSP(WS_OF)); const GAS bf16* yb = (const GAS bf16*)(WSP(WS_OB)); GAS bf16* z = (GAS bf16*)(WSP(WS_Z));
    LAS unsigned char* L = F.lds + RING_OFF;
    const int lane = F.lane, wave = F.wave, rl = lane >> 1, hf = lane & 1, rr = lane >> 4, c16 = lane & 15;
    int it = 0;
    for (int u = F.vcu; u < (MTOT / 32) * 16; u += F.G, ++it) {
        const int rb = u >> 4, gb = u & 15, g = gb * 8 + wave, r0 = rb * 32;
        const size_t off = ((size_t)g * MTOT + r0 + rl) * 16 + 8 * hf;
        const v4u a = *(const GAS v4u*)(yf + off), b = *(const GAS v4u*)(yb + off); v4u o;
#pragma unroll
        for (int j = 0; j < 4; ++j) { const float lo = gelu_tanh(bflo(a[j]) + bflo(b[j])), hi = gelu_tanh(bfhi(a[j]) + bfhi(b[j])); o[j] = pkbf(lo, hi); }
        LAS unsigned char* T = L + (it & 1) * (32 * 272);
        *(LAS v4u*)(T + rl * 272 + wave * 32 + hf * 16) = o;
        __syncthreads();
        const v4u w = *(const LAS v4u*)(T + (4 * wave + rr) * 272 + c16 * 16);
        *(GAS v4u*)(z + (size_t)(r0 + 4 * wave + rr) * DM + gb * 128 + c16 * 8) = w;
    }
    __syncthreads();
}
__device__ __forceinline__ void phase_a4(Frame& F, const Args& args, const GAS float* onorm) {
    relane(F);
    const GAS bf16* OFp = (const GAS bf16*)(WSP(WS_OF)); const GAS bf16* OBp = (const GAS bf16*)(WSP(WS_OB)); const GAS bf16* SG = (const GAS bf16*)(WSP(WS_SG)); GAS bf16* Z = (GAS bf16*)(WSP(WS_Z));
    const int gw = F.vcu * NWAVES + F.wave, NGW = F.G * NWAVES;
    f32x4 gn[8];
#pragma unroll
    for (int j = 0; j < 8; ++j) gn[j] = *(const GAS f32x4*)(onorm + 4 * F.lane + 256 * j);
    v2u an[8], bn[8], sn[8];
#define A4_PREF(rr) do { const int ln_ = opqv(F.lane); const int rc_ = (rr) < MTOT ? (rr) : MTOT - 1; _Pragma("unroll") for (int j = 0; j < 8; ++j) { const size_t off_ = (size_t)rc_ * DM + 4 * ln_ + 256 * j; \
        an[j] = *(const GAS v2u*)(OFp + off_); bn[j] = *(const GAS v2u*)(OBp + off_); sn[j] = *(const GAS v2u*)(SG + off_); } } while (0)
    A4_PREF(gw);
    for (int r = gw; r < MTOT; r += NGW) {
        const int ln_ = opqv(F.lane);
        v2u a[8], b[8], sg[8];
#pragma unroll
        for (int j = 0; j < 8; ++j) { a[j] = an[j]; b[j] = bn[j]; sg[j] = sn[j]; }
        A4_PREF(r + NGW);
#pragma unroll
        for (int j = 0; j < 8; ++j) { const size_t off = (size_t)r * DM + 4 * ln_ + 256 * j;
            const f32x4 o = {bflo(a[j].x) + bflo(b[j].x), bfhi(a[j].x) + bfhi(b[j].x), bflo(a[j].y) + bflo(b[j].y), bfhi(a[j].y) + bfhi(b[j].y)};
            float s = (o.x * o.x + o.y * o.y) + (o.z * o.z + o.w * o.w);
#pragma unroll
            for (int d = 1; d < 32; d <<= 1) s += xshfl(s, ln_, d);
            const float rs = 1.0f / sqrtf(s * (1.0f / 128.0f) + NEPS);
            v2u w; w.x = pkbf(o.x * rs * gn[j].x * bflo(sg[j].x), o.y * rs * gn[j].y * bfhi(sg[j].x)); w.y = pkbf(o.z * rs * gn[j].z * bflo(sg[j].y), o.w * rs * gn[j].w * bfhi(sg[j].y));
            *(GAS v2u*)(Z + off) = w; }
    }
#undef A4_PREF
}

constexpr int S5_W8 = 0, S5_FB = 32768, S5_V8 = 32768, S5_T8 = 65536, S5_PAR = 98304;
constexpr int S5P_LAMP = 0, S5P_BB = 4608, S5P_CM = 4608 + 8192, S5P_L72 = 4608 + 16384, S5P_DSK = S5P_L72 + 512;
constexpr int S5_NSTEP = 9, S5_SLEN = 72;
__device__ __forceinline__ f32x2 cmul(f32x2 a, f32x2 b) { return (f32x2){a.x * b.x - a.y * b.y, a.x * b.y + a.y * b.x}; }
__device__ __forceinline__ int s5_row(int pos, int d) { if (pos < CTXL) return SEQ + (d ? CTXL - 1 - pos : pos); const int r = pos - CTXL; return d ? SEQ - 1 - r : r; }

__device__ __forceinline__ void phase_s5(Frame& F, const Args& args, int j) {
    relane(F);
    LAS unsigned char* L = F.lds + RING_OFF;
    LAS f32x2* LAMP = (LAS f32x2*)(L + S5_PAR + S5P_LAMP); LAS f32x2* BB = (LAS f32x2*)(L + S5_PAR + S5P_BB); LAS f32x2* CM = (LAS f32x2*)(L + S5_PAR + S5P_CM);
    LAS f32x2* L72 = (LAS f32x2*)(L + S5_PAR + S5P_L72); LAS float* DSK = (LAS float*)(L + S5_PAR + S5P_DSK);
    LAS f32x2* FB = (LAS f32x2*)(L + S5_FB);
    const int tid = F.tid, lane = F.lane, wave = F.wave, nl = lane & 15, q = lane >> 4;
    for (int it = F.vcu; it < 256; it += F.G) {
        const int g = it >> 1, d = it & 1, pi = (j * 2 + d) * 128 + g;
        const GAS bf16* H = (const GAS bf16*)(WSP(WS_H)) + (size_t)g * MTOT * 16;
        GAS bf16* Yo = (GAS bf16*)(opq(F.ws) + (d == 0 ? WS_OF : WS_OB)) + (size_t)g * MTOT * 16;
        if (tid < 64) {
            const int p = tid;
            f32x4 bre[4], bim[4];
#pragma unroll
            for (int h4 = 0; h4 < 4; ++h4) { bre[h4] = *(const GAS f32x4*)(AIN(15) + ((size_t)pi * 64 + p) * 16 + 4 * h4); bim[h4] = *(const GAS f32x4*)(AIN(16) + ((size_t)pi * 64 + p) * 16 + 4 * h4); }
            const float dt = expf(AIN(14)[pi]); const float ar = AIN(12)[pi * 64 + p], ai = AIN(13)[pi * 64 + p];
            const float xr = ar * dt, yi = ai * dt;
            float tt = yi * 0.15915494309189535f; tt -= rintf(tt); const float ang = tt * 6.283185307179586f;
            const float cs = cosf(ang), sn = sinf(ang), ex = expf(xr), em1 = expm1f(xr), sh = sinf(0.5f * ang);
            const f32x2 lam1 = {ex * cs, ex * sn};
            const float nr = em1 * cs - 2.0f * sh * sh, ni = ex * sn;
            const float den = 1.0f / (ar * ar + ai * ai);
            const f32x2 kap = {(nr * ar + ni * ai) * den, (ni * ar - nr * ai) * den};
            f32x2 z = {1.0f, 0.0f};
#pragma unroll
            for (int k = 0; k < 9; ++k) { LAMP[k * 64 + p] = z; if (k < 8) z = cmul(z, lam1); }
            f32x2 z72 = z;
#pragma unroll
            for (int k = 0; k < 8; ++k) z72 = cmul(z72, z);
            L72[p] = z72;
#pragma unroll
            for (int h = 0; h < 16; ++h) { const f32x2 b = {bre[h >> 2][h & 3], bim[h >> 2][h & 3]}; BB[p * 16 + h] = cmul(kap, b); }
        }
        for (int i = tid; i < 1024; i += NTHR) { CM[i] = (f32x2){AIN(17)[(size_t)pi * 1024 + i], AIN(18)[(size_t)pi * 1024 + i]}; }
        if (tid < 16) DSK[tid] = (d == 0) ? AIN(19)[j * DM + g * 16 + tid] : 0.0f;
        __syncthreads();
#pragma unroll
        for (int i = 0; i < 4; ++i) {
            const int f = (tid >> 6) + 8 * i, mb = f >> 2, ks = f & 3, p = 16 * (mb >> 1) + nl, part = mb & 1, jj = 2 * ks + (q >> 1), h0 = 8 * (q & 1);
            const f32x2 lp = LAMP[(7 - jj) * 64 + p];
            float v[8];
#pragma unroll
            for (int e = 0; e < 8; ++e) { const f32x2 z = cmul(lp, BB[p * 16 + h0 + e]); v[e] = part ? z.y : z.x; }
            v4u o; o.x = pkbf(v[0], v[1]); o.y = pkbf(v[2], v[3]); o.z = pkbf(v[4], v[5]); o.w = pkbf(v[6], v[7]);
            *(LAS v4u*)(L + S5_W8 + (f * 64 + lane) * 16) = o;
        }
        __syncthreads();
        const int n = 16 * wave + nl, pos0 = S5_SLEN * n;
#define S5_LOADU(U, b) do { _Pragma("unroll") for (int ks = 0; ks < 4; ++ks) { int pos = pos0 + 8 * (b) + 2 * ks + (q >> 1); asm volatile("" : "+v"(pos)); const bool ok = pos < MTOT; \
            const int row = s5_row(ok ? pos : 0, d); v4u w = *(const GAS v4u*)(H + (size_t)row * 16 + 8 * (q & 1)); if (!ok) w = (v4u){0u, 0u, 0u, 0u}; U[ks] = __builtin_bit_cast(bf16x8, w); } } while (0)
#define S5_AFRAG(base, f) (*(const LAS bf16x8*)(L + (base) + (f) * 1024 + lofs))
#define S5_MFMA(a, b, c) __builtin_amdgcn_mfma_f32_16x16x32_bf16((a), (b), (c), 0, 0, 0)
#define S5_UPDATE() do { _Pragma("unroll") for (int t = 0; t < 4; ++t) { const LAS f32x4* lp_ = (const LAS f32x4*)(L + S5_PAR + S5P_LAMP + (8 * 64 + 16 * t) * 8 + zofs + q * 32); const f32x4 la_ = lp_[0], lb_ = lp_[1]; \
            const float l8r_[4] = {la_[0], la_[2], lb_[0], lb_[2]}, l8i_[4] = {la_[1], la_[3], lb_[1], lb_[3]}; \
            _Pragma("unroll") for (int r = 0; r < 4; ++r) { \
            const float nr_ = l8r_[r] * Sre[t][r] - l8i_[r] * Sim[t][r] + acc[2 * t][r], ni_ = l8r_[r] * Sim[t][r] + l8i_[r] * Sre[t][r] + acc[2 * t + 1][r]; Sre[t][r] = nr_; Sim[t][r] = ni_; } } } while (0)
        f32x4 Sre[4], Sim[4];
#pragma unroll
        for (int t = 0; t < 4; ++t) { Sre[t] = (f32x4){0.f, 0.f, 0.f, 0.f}; Sim[t] = (f32x4){0.f, 0.f, 0.f, 0.f}; }
        {
            bf16x8 U[4]; S5_LOADU(U, 0);
            for (int b = 0; b < S5_NSTEP; ++b) {
                int lofs = lane * 16; asm volatile("" : "+v"(lofs)); int zofs = 0; asm volatile("" : "+v"(zofs));
                bf16x8 Un[4];
                if (b + 1 < S5_NSTEP) S5_LOADU(Un, b + 1); else { _Pragma("unroll") for (int ks = 0; ks < 4; ++ks) Un[ks] = U[ks]; }
                f32x4 acc[8];
#pragma unroll
                for (int mb = 0; mb < 8; ++mb) { acc[mb] = (f32x4){0.f, 0.f, 0.f, 0.f};
#pragma unroll
                    for (int ks = 0; ks < 4; ++ks) acc[mb] = S5_MFMA(S5_AFRAG(S5_W8, mb * 4 + ks), U[ks], acc[mb]);
                    if (mb & 1) asm volatile("" ::: "memory"); }
                S5_UPDATE();
#pragma unroll
                for (int ks = 0; ks < 4; ++ks) U[ks] = Un[ks];
            }
        }
#pragma unroll
        for (int t = 0; t < 4; ++t) { LAS f32x4* o = (LAS f32x4*)(FB + n * 64 + 16 * t + 4 * q);
            o[0] = (f32x4){Sre[t][0], Sim[t][0], Sre[t][1], Sim[t][1]}; o[1] = (f32x4){Sre[t][2], Sim[t][2], Sre[t][3], Sim[t][3]}; }
        __syncthreads();
        if (wave == 0) {
            const f32x2 l72 = L72[lane]; f32x2 I = {0.f, 0.f};
            for (int n0 = 0; n0 < 128; n0 += 8) {
                f32x2 fv[8];
#pragma unroll
                for (int k = 0; k < 8; ++k) fv[k] = FB[(n0 + k) * 64 + lane];
#pragma unroll
                for (int k = 0; k < 8; ++k) { FB[(n0 + k) * 64 + lane] = I; I = cmul(l72, I) + fv[k]; }
            }
        }
        __syncthreads();
#pragma unroll
        for (int t = 0; t < 4; ++t) { const LAS f32x4* o = (const LAS f32x4*)(FB + n * 64 + 16 * t + 4 * q); const f32x4 a = o[0], b = o[1];
            Sre[t] = (f32x4){a[0], a[2], b[0], b[2]}; Sim[t] = (f32x4){a[1], a[3], b[1], b[3]}; }
        __syncthreads();
#pragma unroll
        for (int i = 0; i < 4; ++i) {
            const int f = (tid >> 6) + 8 * i, im = f >> 2, ks = f & 3, h = nl;
            float v[8];
#pragma unroll
            for (int e = 0; e < 4; ++e) { const int p = 16 * ks + 4 * q + e; const f32x2 z = cmul(CM[h * 64 + p], LAMP[(im + 1) * 64 + p]); v[e] = z.x; v[4 + e] = -z.y; }
            v4u o; o.x = pkbf(v[0], v[1]); o.y = pkbf(v[2], v[3]); o.z = pkbf(v[4], v[5]); o.w = pkbf(v[6], v[7]);
            *(LAS v4u*)(L + S5_V8 + (f * 64 + lane) * 16) = o;
        }
        {
            const int lag = tid >> 6, h = (tid >> 2) & 15, hq = tid & 3;
            float v[4] = {0.f, 0.f, 0.f, 0.f};
#pragma unroll 4
            for (int p = 0; p < 64; ++p) { const f32x2 cl = cmul(CM[h * 64 + p], LAMP[lag * 64 + p]);
                const LAS f32x4* bp = (const LAS f32x4*)(BB + p * 16 + 4 * hq); const f32x4 b0 = bp[0], b1 = bp[1];
                v[0] += cl.x * b0[0] - cl.y * b0[1]; v[1] += cl.x * b0[2] - cl.y * b0[3]; v[2] += cl.x * b1[0] - cl.y * b1[1]; v[3] += cl.x * b1[2] - cl.y * b1[3]; }
            if (lag == 0) {
#pragma unroll
                for (int e = 0; e < 4; ++e) if (4 * hq + e == h) v[e] += DSK[h];
            }
            v2u o; o.x = pkbf(v[0], v[1]); o.y = pkbf(v[2], v[3]);
            const int q0 = hq >> 1, eo = 4 * (hq & 1);
            *(LAS v2u*)(L + S5_T8 + (lag * 64 + h + 16 * q0) * 16 + eo * 2) = o;
            if (lag < 7) *(LAS v2u*)(L + S5_T8 + ((lag + 1) * 64 + h + 16 * (2 + q0)) * 16 + eo * 2) = o;
            if (lag == 0) *(LAS v2u*)(L + S5_T8 + (h + 16 * (2 + q0)) * 16 + eo * 2) = (v2u){0u, 0u};
        }
        __syncthreads();
        {
            bf16x8 T8r[8];
#pragma unroll
            for (int f = 0; f < 8; ++f) T8r[f] = *(const LAS bf16x8*)(L + S5_T8 + (f * 64 + lane) * 16);
            bf16x8 U[4]; S5_LOADU(U, 0);
            for (int b = 0; b < S5_NSTEP; ++b) {
                int lofs = lane * 16; asm volatile("" : "+v"(lofs)); int zofs = 0; asm volatile("" : "+v"(zofs));
                bf16x8 Un[4];
                if (b + 1 < S5_NSTEP) S5_LOADU(Un, b + 1); else { _Pragma("unroll") for (int ks = 0; ks < 4; ++ks) Un[ks] = U[ks]; }
                bf16x8 BS[4];
#pragma unroll
                for (int ks = 0; ks < 4; ++ks) { v4u w; w.x = pkbf(Sre[ks][0], Sre[ks][1]); w.y = pkbf(Sre[ks][2], Sre[ks][3]); w.z = pkbf(Sim[ks][0], Sim[ks][1]); w.w = pkbf(Sim[ks][2], Sim[ks][3]); BS[ks] = __builtin_bit_cast(bf16x8, w); }
#pragma unroll
                for (int mb = 0; mb < 8; ++mb) {
                    f32x4 y = {0.f, 0.f, 0.f, 0.f};
#pragma unroll
                    for (int ks = 0; ks < 4; ++ks) if (2 * ks <= mb) y = S5_MFMA(T8r[mb - 2 * ks], U[ks], y);
#pragma unroll
                    for (int ks = 0; ks < 4; ++ks) y = S5_MFMA(S5_AFRAG(S5_V8, mb * 4 + ks), BS[ks], y);
                    asm volatile("" ::: "memory");
                    int pos = pos0 + 8 * b + mb; asm volatile("" : "+v"(pos));
                    if (pos < MTOT) { v2u o; o.x = pkbf(y[0], y[1]); o.y = pkbf(y[2], y[3]); *(GAS v2u*)(Yo + (size_t)s5_row(pos, d) * 16 + 4 * q) = o; }
                }
                f32x4 acc[8];
#pragma unroll
                for (int mb = 0; mb < 8; ++mb) { acc[mb] = (f32x4){0.f, 0.f, 0.f, 0.f};
#pragma unroll
                    for (int ks = 0; ks < 4; ++ks) acc[mb] = S5_MFMA(S5_AFRAG(S5_W8, mb * 4 + ks), U[ks], acc[mb]);
                    if (mb & 1) asm volatile("" ::: "memory"); }
                S5_UPDATE();
#pragma unroll
                for (int ks = 0; ks < 4; ++ks) U[ks] = Un[ks];
            }
        }
        __syncthreads();
#undef S5_LOADU
#undef S5_AFRAG
#undef S5_MFMA
#undef S5_UPDATE
    }
}
constexpr int HG_QP = 272;
constexpr int HG_KP = 64;
constexpr int HGR_QB = 0, HGR_KE = 8704, HGR_VT = HGR_KE + 128 * HG_KP, HGR_SC = HGR_VT + 128 * HG_KP, HGR_DEC = HGR_SC + 2048;
constexpr int HGL1_KB = 110592  , HGL1_TOT = 128000  ;
constexpr int HGL_RECB = 0  , HGL_OB = 110592  ;
constexpr int HG_OP = 272;
constexpr int HG_NCH = 33, HG_NCHT = 264;
__device__ __forceinline__ int hg_row(int p, int d) { if (p < CTXL) return SEQ + (d ? CTXL - 1 - p : p); int n = p - CTXL; if (d) n = SEQ - 1 - n; return (n & 127) * 64 + (n >> 7); }
#define HG_MFMA(a, b, c) __builtin_amdgcn_mfma_f32_16x16x32_bf16((a), (b), (c), 0, 0, 0)
#define HG_STATE_STEP(RB, vt) do { _Pragma("unroll") for (int mb = 0; mb < 8; ++mb) { \
        const bf16x8 a_ = *(const LAS bf16x8*)(L + (RB) + HGR_KE + (16 * mb + r16) * HG_KP + qd * 16 + zofs); \
        const f32x4 u_ = HG_MFMA(a_, vt, ((f32x4){0.f, 0.f, 0.f, 0.f})); \
        const f32x4 dc_ = *(const LAS f32x4*)(L + (RB) + HGR_DEC + (16 * mb + 4 * qd) * 4 + zofs); S[mb] = dc_ * S[mb] + u_; } } while (0)

constexpr int HGP_REC = HGR_DEC + 512;
constexpr int HGP_KB = 2 * HGP_REC, HGP_TOT = HGP_KB + 2 * 8704, HGP_OB = HGP_TOT + 4096, HGP_END = HGP_OB + 2 * 32 * HG_OP;
static_assert(HGP_END <= RING_BYTES, "HGRN pass LDS");
template <bool FULL>
__device__ __forceinline__ void hg_pass(Frame& F, const Args& args) {
    relane(F);
    LAS unsigned char* L = F.lds + RING_OFF;
    const int wave = F.wave;
    LAS float* TOTS = (LAS float*)(L + HGP_TOT);
#define HG_TIDS() int tid = F.tid; asm volatile("" : "+v"(tid)); const int lane = tid & 63, r16 = lane & 15, qd = lane >> 4, kk = tid & 127, sq = tid >> 7, kl = kk & 31, pcol = (kk & ~31) + 8 * ((kl >> 2) & 3) + 4 * (kl >> 4) + (kl & 3); (void)r16; (void)qd; (void)pcol; (void)lane
    for (int it = F.vcu; it < 256; it += F.G) {
        const int hd = it >> 4, d = (it >> 3) & 1, sg = it & 7, hdd = hd * 2 + d;
        const GAS bf16* LG = (const GAS bf16*)(opq(F.ws) + (d ? WS_LB : WS_LF)) + hd * 128;
        const GAS bf16* Qp = (const GAS bf16*)(WSP(WS_Q)) + hd * 128; const GAS bf16* Vp = (const GAS bf16*)(WSP(WS_V)) + hd * 128;
        GAS bf16* O = (GAS bf16*)(opq(F.ws) + (d ? WS_OB : WS_OF)) + hd * 128;
        f32x4 S[8];
#pragma unroll
        for (int mb = 0; mb < 8; ++mb) S[mb] = (f32x4){0.f, 0.f, 0.f, 0.f};
        if (FULL) { HG_TIDS();
            f32x4 P[8], fv[8], dv[8];
#pragma unroll
            for (int mb = 0; mb < 8; ++mb) P[mb] = (f32x4){1.f, 1.f, 1.f, 1.f};
#define HG_SLOAD(s2_) do { const int sc_ = (s2_) >= 0 ? (s2_) : 0; const GAS f32x4* sp_ = (const GAS f32x4*)(opq(F.ws) + WS_SEGS) + ((size_t)((hdd * 8 + sc_) * 8 + wave) * 8) * 64 + lane; \
                const GAS float* dp_ = (const GAS float*)(opq(F.ws) + WS_SEGD) + (hdd * 8 + sc_) * 128 + 4 * qd; \
                _Pragma("unroll") for (int mb = 0; mb < 8; ++mb) { fv[mb] = sp_[mb * 64]; dv[mb] = *(const GAS f32x4*)(dp_ + 16 * mb); } } while (0)
            HG_SLOAD(sg - 1);
            for (int s2 = sg - 1; s2 >= 0; --s2) {
                f32x4 fc[8], dc[8];
#pragma unroll
                for (int mb = 0; mb < 8; ++mb) { fc[mb] = fv[mb]; dc[mb] = dv[mb]; }
                HG_SLOAD(s2 - 1);
#pragma unroll
                for (int mb = 0; mb < 8; ++mb) { S[mb] += P[mb] * fc[mb]; P[mb] *= dc[mb]; }
            }
#undef HG_SLOAD
        }
        float dsum = 0.f;
        float lf[2][8]; unsigned qv[2][8];
#define HG_INLOAD(cp) do { _Pragma("unroll") for (int h = 0; h < 2; ++h) { int c_ = 2 * (cp) + h; c_ = c_ < HG_NCH ? c_ : HG_NCH - 1; int p0_ = (sg * HG_NCH + c_) * 32 + 8 * sq; asm volatile("" : "+v"(p0_)); \
              \
            const int row0_ = hg_row(p0_, d), step_ = (p0_ < CTXL ? 1 : 64) * (d ? -1 : 1); unsigned off_ = (unsigned)row0_ * DM + kk; const int dstep_ = step_ * DM; \
            _Pragma("unroll") for (int i = 0; i < 8; ++i) { lf[h][i] = bf1(LG[off_]); qv[h][i] = (FULL ? (unsigned)Qp[off_] : 0u) | ((unsigned)Vp[off_] << 16); off_ += dstep_; } } } while (0)
#define HG_OSTORE(c, h) do { int p_ = (sg * HG_NCH + (c)) * 32 + (tid >> 4); asm volatile("" : "+v"(p_)); const v4u o_ = *(const LAS v4u*)(L + HGP_OB + (h) * (32 * HG_OP) + (tid >> 4) * HG_OP + (tid & 15) * 16); \
            *(GAS v4u*)(O + (size_t)hg_row(p_, d) * DM + 8 * (tid & 15)) = o_; } while (0)
        { HG_TIDS(); HG_INLOAD(0); }
        for (int cp = 0; cp < (HG_NCH + 1) / 2; ++cp) {
            HG_TIDS();
            int zofs = 0; asm volatile("" : "+v"(zofs));
            float cs[2][8];
#pragma unroll
            for (int h = 0; h < 2; ++h) { float run = 0.f;
#pragma unroll
                for (int i = 0; i < 8; ++i) { run += lf[h][i]; cs[h][i] = run; }
                TOTS[(h * 4 + sq) * 128 + kk] = run; }
            __syncthreads();
            if (FULL && cp > 0) { HG_OSTORE(2 * cp - 2, 0); HG_OSTORE(2 * cp - 1, 1); }
#pragma unroll
            for (int h = 0; h < 2; ++h) {
                const int RB = h * HGP_REC, KB = HGP_KB + h * (32 * HG_QP);
                const float t0 = TOTS[(h * 4 + 0) * 128 + kk], t1 = TOTS[(h * 4 + 1) * 128 + kk], t2 = TOTS[(h * 4 + 2) * 128 + kk], t3 = TOTS[(h * 4 + 3) * 128 + kk];
                const float offc = (sq > 0 ? t0 : 0.f) + (sq > 1 ? t1 : 0.f) + (sq > 2 ? t2 : 0.f), tot = (t0 + t1) + (t2 + t3), dec = __expf(tot);
                float ke[8];
#pragma unroll
                for (int i = 0; i < 8; ++i) { const float cum = cs[h][i] + offc, kv = 1.0f - __expf(i ? cs[h][i] - cs[h][i - 1] : cs[h][0]);
                    const float kb = kv * __expf(-cum); ke[i] = kb * dec;
                    if (FULL) { const float qb = bflo(qv[h][i]) * __expf(cum);
                        *(LAS bf16*)(L + RB + HGR_QB + (8 * sq + i) * HG_QP + pcol * 2) = (bf16)(pkbf(qb, 0.f) & 0xffffu);
                        *(LAS bf16*)(L + KB + (8 * sq + i) * HG_QP + pcol * 2) = (bf16)(pkbf(kb, 0.f) & 0xffffu); } }
                { v4u o; o.x = pkbf(ke[0], ke[1]); o.y = pkbf(ke[2], ke[3]); o.z = pkbf(ke[4], ke[5]); o.w = pkbf(ke[6], ke[7]);
                  *(LAS v4u*)(L + RB + HGR_KE + kk * HG_KP + sq * 16) = o;
                  v4u w; w.x = (qv[h][0] >> 16) | (qv[h][1] & 0xffff0000u); w.y = (qv[h][2] >> 16) | (qv[h][3] & 0xffff0000u); w.z = (qv[h][4] >> 16) | (qv[h][5] & 0xffff0000u); w.w = (qv[h][6] >> 16) | (qv[h][7] & 0xffff0000u);
                  *(LAS v4u*)(L + RB + HGR_VT + kk * HG_KP + sq * 16) = w; }
                if (sq == 0) { *(LAS float*)(L + RB + HGR_DEC + kk * 4) = dec; if (!FULL && 2 * cp + h < HG_NCH) dsum += tot; }
            }
            HG_INLOAD(cp + 1);
            __syncthreads();
            if (FULL) {
                const int h = wave >> 2, w4 = wave & 3, mblk = w4 >> 1, nblk = w4 & 1; const int RB = h * HGP_REC, KB = HGP_KB + h * (32 * HG_QP);
                f32x4 acc = {0.f, 0.f, 0.f, 0.f};
#pragma unroll
                for (int ks = 0; ks < 4; ++ks) { const bf16x8 a = *(const LAS bf16x8*)(L + RB + HGR_QB + (16 * mblk + r16) * HG_QP + (32 * ks + 8 * qd) * 2 + zofs);
                    const bf16x8 b = *(const LAS bf16x8*)(L + KB + (16 * nblk + r16) * HG_QP + (32 * ks + 8 * qd) * 2 + zofs); acc = HG_MFMA(a, b, acc); }
#pragma unroll
                for (int r = 0; r < 4; ++r) { const int cc = 16 * mblk + 4 * qd + r, ss = 16 * nblk + r16; const float v = ss <= cc ? acc[r] : 0.f;
                    *(LAS bf16*)(L + RB + HGR_SC + (cc * 32 + ss) * 2) = (bf16)(pkbf(v, 0.f) & 0xffffu); }
                __syncthreads();
            }
#pragma unroll
            for (int h = 0; h < 2; ++h) if (2 * cp + h < HG_NCH) { const int RB = h * HGP_REC;
                const bf16x8 vt = *(const LAS bf16x8*)(L + RB + HGR_VT + (16 * wave + r16) * HG_KP + qd * 16 + zofs);
                if (FULL) {
                    bf16x8 BS[4];
#pragma unroll
                    for (int ks = 0; ks < 4; ++ks) { v4u w; w.x = pkbf(S[2 * ks][0], S[2 * ks][1]); w.y = pkbf(S[2 * ks][2], S[2 * ks][3]); w.z = pkbf(S[2 * ks + 1][0], S[2 * ks + 1][1]); w.w = pkbf(S[2 * ks + 1][2], S[2 * ks + 1][3]);
                        BS[ks] = __builtin_bit_cast(bf16x8, w); }
#pragma unroll
                    for (int mblk = 0; mblk < 2; ++mblk) {
                        f32x4 o = {0.f, 0.f, 0.f, 0.f};
                        { const bf16x8 a = *(const LAS bf16x8*)(L + RB + HGR_SC + (16 * mblk + r16) * 64 + qd * 16 + zofs); o = HG_MFMA(a, vt, o); }
#pragma unroll
                        for (int ks = 0; ks < 4; ++ks) { const bf16x8 a = *(const LAS bf16x8*)(L + RB + HGR_QB + (16 * mblk + r16) * HG_QP + (32 * ks + 8 * qd) * 2 + zofs); o = HG_MFMA(a, BS[ks], o); }
#pragma unroll
                        for (int r = 0; r < 4; ++r) *(LAS bf16*)(L + HGP_OB + h * (32 * HG_OP) + (16 * mblk + 4 * qd + r) * HG_OP + (16 * wave + r16) * 2) = (bf16)(pkbf(o[r], 0.f) & 0xffffu);
                    }
                }
                HG_STATE_STEP(RB, vt); }
        }
        __syncthreads();
        if (FULL) { HG_TIDS(); HG_OSTORE(HG_NCH - 1, 0); }
        else { HG_TIDS(); GAS f32x4* sp = (GAS f32x4*)(opq(F.ws) + WS_SEGS) + ((size_t)((hdd * 8 + sg) * 8 + wave) * 8) * 64 + lane;
#pragma unroll
          for (int mb = 0; mb < 8; ++mb) sp[mb * 64] = S[mb];
          if (sq == 0) ((GAS float*)(opq(F.ws) + WS_SEGD))[(hdd * 8 + sg) * 128 + kk] = __expf(dsum); }
        __syncthreads();
#undef HG_INLOAD
#undef HG_OSTORE
    }
#undef HG_TIDS
}
__device__ __forceinline__ void phase_hg_r1(Frame& F, const Args& args) { hg_pass<false>(F, args); }
__device__ __forceinline__ void phase_hg_r2(Frame& F, const Args& args) { hg_pass<true>(F, args); }
template <int MT, int NB, int KS, int WR, class Epi>
__device__ __forceinline__ void ctx_gemm(Frame& F, const GAS bf16* A, const GAS bf16* Bt, int K, int ncolt, const Epi& E) {
    constexpr int WC = 8 / WR, MB = MT / (16 * WR), NBW = NB / WC, RT = 256 / MT, PITCH = 144, APIECES = MT * 8, BPIECES = NB * 16 * 8, NA = (APIECES + NTHR - 1) / NTHR, NBL = (BPIECES + NTHR - 1) / NTHR;
    constexpr int ABYTES = MT * PITCH, BBYTES = NB * 16 * PITCH, BUF = ABYTES + BBYTES;
    static_assert(3 * BUF <= RING_BYTES && NB % WC == 0 && MT % (16 * WR) == 0, "ctx_gemm geometry");
    relane(F);
    LAS unsigned char* L = F.lds + RING_OFF;
    const int tid = F.tid, lane = F.lane, wave = F.wave, r16 = lane & 15, qd = lane >> 4, wr = wave / WC, wc = wave % WC;
    const int units = RT * ncolt * KS, klen = K / KS, nkt = klen / 64;
    for (int u = F.vcu; u < units; u += F.G) {
        const int ks = u % KS, t = u / KS, rt = t % RT, ct = t / RT;
        const int rowb = rt * MT;
        const GAS bf16* ga[NA]; const GAS bf16* gb[NBL]; int la[NA], lb[NBL]; bool oka[NA], okb[NBL];
#pragma unroll
        for (int j = 0; j < NA; ++j) { const int i = tid + NTHR * j, row = i >> 3, ch = i & 7; oka[j] = i < APIECES; const int rr = oka[j] ? row : 0; ga[j] = A + (size_t)(rowb + rr) * K + ks * klen + 8 * ch; la[j] = rr * PITCH + ch * 16; }
#pragma unroll
        for (int j = 0; j < NBL; ++j) { const int i = tid + NTHR * j, row = i >> 3, ch = i & 7; okb[j] = i < BPIECES; const int rr = okb[j] ? row : 0;
            gb[j] = Bt + (size_t)E.brow(ct, rr >> 4, rr & 15) * K + ks * klen + 8 * ch; lb[j] = ABYTES + rr * PITCH + ch * 16; }
        v4u ra[2][NA], rb[2][NBL];
#define CG_LOAD(P, kt) do { _Pragma("unroll") for (int j = 0; j < NA; ++j) ra[P][j] = *(const GAS v4u*)(ga[j] + (kt) * 64); _Pragma("unroll") for (int j = 0; j < NBL; ++j) rb[P][j] = *(const GAS v4u*)(gb[j] + (kt) * 64); } while (0)
#define CG_STORE(P, bo) do { _Pragma("unroll") for (int j = 0; j < NA; ++j) if (oka[j]) *(LAS v4u*)(L + (bo) + la[j]) = ra[P][j]; _Pragma("unroll") for (int j = 0; j < NBL; ++j) if (okb[j]) *(LAS v4u*)(L + (bo) + lb[j]) = rb[P][j]; } while (0)
#define CG_COMPUTE(bo) do { _Pragma("unroll") for (int k2 = 0; k2 < 2; ++k2) { bf16x8 a[MB], b[NBW]; \
            _Pragma("unroll") for (int mb = 0; mb < MB; ++mb) a[mb] = *(const LAS bf16x8*)(L + (bo) + (wr * (MT / WR) + 16 * mb + r16) * PITCH + (4 * k2 + qd) * 16); \
            _Pragma("unroll") for (int nb = 0; nb < NBW; ++nb) b[nb] = *(const LAS bf16x8*)(L + (bo) + ABYTES + (16 * (wc + WC * nb) + r16) * PITCH + (4 * k2 + qd) * 16); \
            _Pragma("unroll") for (int mb = 0; mb < MB; ++mb) _Pragma("unroll") for (int nb = 0; nb < NBW; ++nb) acc[mb][nb] = __builtin_amdgcn_mfma_f32_16x16x32_bf16(a[mb], b[nb], acc[mb][nb], 0, 0, 0); } } while (0)
        f32x4 acc[MB][NBW];
#pragma unroll
        for (int mb = 0; mb < MB; ++mb)
#pragma unroll
            for (int nb = 0; nb < NBW; ++nb) acc[mb][nb] = (f32x4){0.f, 0.f, 0.f, 0.f};
        CG_LOAD(0, 0); CG_LOAD(1, 1); CG_STORE(0, 0);
        __syncthreads();
        for (int kt = 0; kt < nkt; kt += 2) {
            { const int b0 = (kt % 3) * BUF, b1 = ((kt + 1) % 3) * BUF;
              if (kt + 2 < nkt) CG_LOAD(0, kt + 2);
              CG_COMPUTE(b0);
              CG_STORE(1, b1);
              __syncthreads(); }
            { const int b1 = ((kt + 1) % 3) * BUF, b2 = ((kt + 2) % 3) * BUF;
              if (kt + 3 < nkt) CG_LOAD(1, kt + 3);
              CG_COMPUTE(b1);
              if (kt + 2 < nkt) CG_STORE(0, b2);
              __syncthreads(); }
        }
#undef CG_LOAD
#undef CG_STORE
#undef CG_COMPUTE
        const int row0 = rowb + wr * (MT / WR);
#pragma unroll
        for (int mb = 0; mb < MB; ++mb) E.store(acc[mb], row0 + 16 * mb + 4 * qd, ct, ks, r16, wc);
    }
}
struct CtxRelu2 {
    GAS bf16* O;
    __device__ __forceinline__ int brow(int ct, int nb, int r) const { return 64 * ct + 16 * nb + r; }
    __device__ __forceinline__ void store(const f32x4 (&acc)[2], int row, int ct, int ks, int r, int wc) const {
#pragma unroll
        for (int t = 0; t < 2; ++t)
#pragma unroll
            for (int g = 0; g < 4; ++g) { const float v = fmaxf(acc[t][g], 0.f); O[(size_t)(SEQ + row + g) * HID + 64 * ct + 16 * (wc + 2 * t) + r] = (bf16)(pkbf(v * v, 0.f) & 0xffffu); }
    }
};
struct CtxGlu {
    GAS float* Y;
    __device__ __forceinline__ int brow(int ct, int nb, int r) const { const int c = 32 * ct + 16 * (nb & 1) + r; return 256 * (c >> 7) + (c & 127) + 128 * (nb >> 1); }
    __device__ __forceinline__ void store(const f32x4 (&acc)[2], int row, int ct, int ks, int r, int wc) const {
#pragma unroll
        for (int g = 0; g < 4; ++g) Y[(size_t)(row + g) * DM + 32 * ct + 16 * wc + r] = acc[0][g] * pg8::sigmoid_f(acc[1][g]);
    }
};
struct CtxPart {
    GAS float* YP;
    __device__ __forceinline__ int brow(int ct, int nb, int r) const { return 64 * ct + 16 * nb + r; }
    __device__ __forceinline__ void store(const f32x4 (&acc)[2], int row, int ct, int ks, int r, int wc) const {
#pragma unroll
        for (int t = 0; t < 2; ++t)
#pragma unroll
            for (int g = 0; g < 4; ++g) YP[((size_t)ks * CTXL + row + g) * DM + 64 * ct + 16 * (wc + 2 * t) + r] = acc[t][g];
    }
};
struct CtxHgIn {
    GAS bf16* Q; size_t hstride; GAS bf16* LF; size_t fstride; const GAS float* lbv;
    __device__ __forceinline__ int brow(int ct, int nb, int r) const { return 80 * ct + 16 * nb + r; }
    __device__ __forceinline__ void store(const f32x4 (&acc)[5], int row, int ct, int ks, int r, int  ) const {
#pragma unroll
        for (int nb = 0; nb < 5; ++nb) { const int col = 80 * ct + 16 * nb + r, typ = col >> 11, cc = col & 2047;
            if (typ == 2 || typ == 3) { const float lb = lbv[(typ - 2) * 2048 + cc], llb = lb > 0.f ? logf(lb) : 0.f; GAS bf16* O = LF + (size_t)(typ - 2) * fstride;
#pragma unroll
                for (int g = 0; g < 4; ++g) O[(size_t)(SEQ + row + g) * DM + cc] = (bf16)(pkbf(pg8::logf_gate(acc[nb][g], lb, llb), 0.f) & 0xffffu);
            } else { GAS bf16* O = Q + (size_t)((typ >> 2) * 2 + (typ & 1)) * hstride;
#pragma unroll
                for (int g = 0; g < 4; ++g) { const float v = acc[nb][g], w = typ == 1 ? v : pg8::silu_f(v); O[(size_t)(SEQ + row + g) * DM + cc] = (bf16)(pkbf(w, 0.f) & 0xffffu); } }
        }
    }
};

#if MK_PER_PHASE
#define IN(k) (args.ph_lo <= (k) && (k) < args.ph_hi)
#else
#define IN(k) true
#endif
#define SEAM(k) do { if (IN(k) && IN((k) + 1)) { if (!MK_PER_PHASE) xcd_barrier(bar); } } while (0)
#define MOD ((const GAS float*)(WSP(WS_MOD)))
#define Hb ((const GAS bf16*)(WSP(WS_H)))
#define Zb ((const GAS bf16*)(WSP(WS_Z)))
#define HIDb ((const GAS bf16*)(WSP(WS_HID)))
#define Y1 ((GAS bf16*)(WSP(WS_Y1)))
#define Y2 ((GAS bf16*)(WSP(WS_Y2)))
#define YP1 ((GAS float*)(WSP(WS_YP1)))
#define YP2 ((GAS float*)(WSP(WS_YP2)))
#define CTXLIVE (pair == 0)

template <int pair>
__device__ __forceinline__ void layer_pair(Frame& F, const Args& args, const XcdBarrier& bar) {
        const int base = 2 + 16 * pair, l0 = 2 * pair, l1 = l0 + 1, j = pair;
        relane(F); F.ws = opq(F.ws);
#define mod0 (MOD + (size_t)l0 * 2 * NMOD)
#define mod1 (MOD + (size_t)l1 * 2 * NMOD)
#define modp (MOD + (size_t)(l0 - 1) * 2 * NMOD)
        if (IN(base + 0)) {
            if (pair == 0) thin_rn<0, 1, false, true>(F, args, nullptr, nullptr, MTOT, nullptr, nullptr, 0, AIN(6) + l0 * DM, mod0, 0, 1);
            else { if (REP_RN) { thin_rn<1, 4, true, true>(F, args, Y2, YP2, MTOT, AIN(9) + (l0 - 1) * DM, modp, 5, AIN(6) + l0 * DM, mod0, 0, 1); } thin_rn<1, 4, false, true>(F, args, Y2, YP2, MTOT, AIN(9) + (l0 - 1) * DM, modp, 5, AIN(6) + l0 * DM, mod0, 0, 1); }
        } SEAM(base + 0);
        if (IN(base + 1)) {
            for (int rep = 0; rep <= REP_S5; ++rep) phase_s5(F, args, j);
        } SEAM(base + 1);
        if (IN(base + 2)) { for (int rep = 0; rep <= REP_THIN; ++rep) phase_a2(F, args); } SEAM(base + 2);
        if (IN(base + 3)) {
            pg8::Gemm g{(gen_cbf)(Zb), (gen_cbf)((const GAS bf16*)(WSP(WS_WGLU)) + (size_t)j * 4096 * DM), SEQ, 4096, DM}; pg8::StaticOrder S; S.init(SEQ, 4096, F.G, PG_CID, WGM_GLU);
            pg8::EpiGlu E{Y1, DM};
            for (int rep = 0; rep <= REP_GEMM + REP_GGLU; ++rep)
            pg8::gemm_phase<pg8::EpiGlu, pg8::StaticOrder, PG_ALIGN, PG_SP2>(F.lds + RING_OFF, g, S, E);
            { CtxGlu CE{YP1}; for (int rep = 0; rep <= REP_CTX; ++rep) ctx_gemm<64, 4, 1, 4>(F, Zb + (size_t)SEQ * DM, (const GAS bf16*)(WSP(WS_WGLU)) + (size_t)j * 4096 * DM, DM, 64, CE); }
        } SEAM(base + 3);
        if (IN(base + 4)) { if (REP_RN) { thin_rn<1, 1, true>(F, args, Y1, YP1, MTOT, AIN(7) + l0 * DM, mod0, 2, AIN(8) + l0 * DM, mod0, 3, 4); } thin_rn<1, 1>(F, args, Y1, YP1, MTOT, AIN(7) + l0 * DM, mod0, 2, AIN(8) + l0 * DM, mod0, 3, 4); } SEAM(base + 4);
        if (IN(base + 5)) {
            pg8::Gemm g{(gen_cbf)(Hb), (gen_cbf)((const GAS bf16*)(WSP(WS_W1)) + (size_t)l0 * HID * DM), SEQ, HID, DM}; pg8::StaticOrder S; S.init(SEQ, HID, F.G, PG_CID, WGM_IN);
            pg8::EpiRelu2 E{(GAS bf16*)(WSP(WS_HID)), HID};
            for (int rep = 0; rep <= REP_GEMM + REP_GIN; ++rep)
            pg8::gemm_phase<pg8::EpiRelu2, pg8::StaticOrder, PG_ALIGN, PG_SP2>(F.lds + RING_OFF, g, S, E);
            { CtxRelu2 CE{(GAS bf16*)(WSP(WS_HID))}; for (int rep = 0; rep <= REP_CTX; ++rep) ctx_gemm<128, 4, 1, 4>(F, Hb + (size_t)SEQ * DM, (const GAS bf16*)(WSP(WS_W1)) + (size_t)l0 * HID * DM, DM, 128, CE); }
        } SEAM(base + 5);
        if (IN(base + 6)) {
            pg8::Gemm g{(gen_cbf)(HIDb), (gen_cbf)((const GAS bf16*)(WSP(WS_W2)) + (size_t)l0 * DM * HID), SEQ, DM, HID}; pg8::StaticOrder S; S.init(SEQ, DM, F.G, PG_CID, WGM_OUT);
            pg8::EpiBf16P E{Y2, DM};
            for (int rep = 0; rep <= REP_GEMM + REP_GOUT; ++rep)
            pg8::gemm_phase<pg8::EpiBf16P, pg8::StaticOrder, PG_ALIGN, PG_SP2>(F.lds + RING_OFF, g, S, E);
            { CtxPart CE{YP2}; for (int rep = 0; rep <= REP_CTX; ++rep) ctx_gemm<128, 4, 4, 4>(F, HIDb + (size_t)SEQ * HID, (const GAS bf16*)(WSP(WS_W2)) + (size_t)l0 * DM * HID, HID, 32, CE); }
        } SEAM(base + 6);
        if (IN(base + 7)) { if (REP_RN) { thin_rn<1, 4, true>(F, args, Y2, YP2, MTOT, AIN(9) + l0 * DM, mod0, 5, AIN(6) + l1 * DM, mod1, 0, 1); } thin_rn<1, 4>(F, args, Y2, YP2, MTOT, AIN(9) + l0 * DM, mod0, 5, AIN(6) + l1 * DM, mod1, 0, 1); } SEAM(base + 7);
        if (IN(base + 8)) {
            pg8::Gemm g{(gen_cbf)(Hb), (gen_cbf)((const GAS bf16*)(WSP(WS_WIN)) + (size_t)j * 10240 * DM), SEQ, 10240, DM}; pg8::StaticOrder S; S.init(SEQ, 10240, F.G, PG_CID, WGM_HG);
            pg8::EpiHgIn E{(GAS bf16*)(WSP(WS_Q)), (WS_V - WS_Q) / 2, (GAS bf16*)(WSP(WS_LF)), (WS_LB - WS_LF) / 2, (const GAS float*)(WSP(WS_LBV)) + (size_t)j * 2 * DM};
            static_assert(WS_SG - WS_V == WS_V - WS_Q, "Q|V|SG equally spaced");
            for (int rep = 0; rep <= REP_GEMM + REP_GHG; ++rep)
            pg8::gemm_phase<pg8::EpiHgIn, pg8::StaticOrder, PG_ALIGN, PG_SP2>(F.lds + RING_OFF, g, S, E);
#if defined(REP_GHG_CHEAP)
            { pg8::EpiBf16P E2{(GAS bf16*)(WSP(WS_REC)), 10240}; pg8::gemm_phase<pg8::EpiBf16P, pg8::StaticOrder, PG_ALIGN, PG_SP2>(F.lds + RING_OFF, g, S, E2); }
#endif
            { CtxHgIn CE{(GAS bf16*)(WSP(WS_Q)), (WS_V - WS_Q) / 2, (GAS bf16*)(WSP(WS_LF)), (WS_LB - WS_LF) / 2, (const GAS float*)(WSP(WS_LBV)) + (size_t)j * 2 * DM}; for (int rep = 0; rep <= REP_CTX; ++rep) ctx_gemm<128, 5, 1, 8>(F, Hb + (size_t)SEQ * DM, (const GAS bf16*)(WSP(WS_WIN)) + (size_t)j * 10240 * DM, DM, 128, CE); }
        } SEAM(base + 8);
        for (int rep = 0; rep <= REP_HG; ++rep) {
        for (int rep1 = 0; rep1 <= REP_R1; ++rep1) { if (IN(base + 9)) { phase_hg_r1(F, args); } SEAM(base + 9); }
        for (int rep2 = 0; rep2 <= REP_R2; ++rep2) { if (IN(base + 10)) { phase_hg_r2(F, args); } SEAM(base + 10); }
        }
        if (IN(base + 11)) { for (int rep = 0; rep <= REP_THIN; ++rep) phase_a4(F, args, AIN(23) + j * DM); } SEAM(base + 11);
        if (IN(base + 12)) {
            pg8::Gemm g{(gen_cbf)(Zb), (gen_cbf)((const GAS bf16*)(WSP(WS_WOUT)) + (size_t)j * DM * DM), SEQ, DM, DM}; pg8::StaticOrder S; S.init(SEQ, DM, F.G, PG_CID, WGM_OP);
            pg8::EpiBf16P E{Y1, DM};
            for (int rep = 0; rep <= REP_GEMM + REP_GOUT; ++rep)
            pg8::gemm_phase<pg8::EpiBf16P, pg8::StaticOrder, PG_ALIGN, PG_SP2>(F.lds + RING_OFF, g, S, E);
            if (CTXLIVE) { CtxPart CE{YP1}; for (int rep = 0; rep <= REP_CTX; ++rep) ctx_gemm<128, 4, 4, 4>(F, Zb + (size_t)SEQ * DM, (const GAS bf16*)(WSP(WS_WOUT)) + (size_t)j * DM * DM, DM, 32, CE); }
        } SEAM(base + 12);
        if (IN(base + 13)) { if (REP_RN) { thin_rn<1, 4, true>(F, args, Y1, YP1, (pair == 1 ? SEQ : MTOT), AIN(7) + l1 * DM, mod1, 2, AIN(8) + l1 * DM, mod1, 3, 4); } thin_rn<1, 4>(F, args, Y1, YP1, (pair == 1 ? SEQ : MTOT), AIN(7) + l1 * DM, mod1, 2, AIN(8) + l1 * DM, mod1, 3, 4); } SEAM(base + 13);
        if (IN(base + 14)) {
            pg8::Gemm g{(gen_cbf)(Hb), (gen_cbf)((const GAS bf16*)(WSP(WS_W1)) + (size_t)l1 * HID * DM), SEQ, HID, DM}; pg8::StaticOrder S; S.init(SEQ, HID, F.G, PG_CID, WGM_IN);
            pg8::EpiRelu2 E{(GAS bf16*)(WSP(WS_HID)), HID};
            for (int rep = 0; rep <= REP_GEMM + REP_GIN; ++rep)
            pg8::gemm_phase<pg8::EpiRelu2, pg8::StaticOrder, PG_ALIGN, PG_SP2>(F.lds + RING_OFF, g, S, E);
            if (CTXLIVE) { CtxRelu2 CE{(GAS bf16*)(WSP(WS_HID))}; for (int rep = 0; rep <= REP_CTX; ++rep) ctx_gemm<128, 4, 1, 4>(F, Hb + (size_t)SEQ * DM, (const GAS bf16*)(WSP(WS_W1)) + (size_t)l1 * HID * DM, DM, 128, CE); }
        } SEAM(base + 14);
        if (IN(base + 15)) {
            pg8::Gemm g{(gen_cbf)(HIDb), (gen_cbf)((const GAS bf16*)(WSP(WS_W2)) + (size_t)l1 * DM * HID), SEQ, DM, HID}; pg8::StaticOrder S; S.init(SEQ, DM, F.G, PG_CID, WGM_OUT);
            pg8::EpiBf16P E{Y2, DM};
            for (int rep = 0; rep <= REP_GEMM + REP_GOUT; ++rep)
            pg8::gemm_phase<pg8::EpiBf16P, pg8::StaticOrder, PG_ALIGN, PG_SP2>(F.lds + RING_OFF, g, S, E);
            if (CTXLIVE) { CtxPart CE{YP2}; for (int rep = 0; rep <= REP_CTX; ++rep) ctx_gemm<128, 4, 4, 4>(F, HIDb + (size_t)SEQ * HID, (const GAS bf16*)(WSP(WS_W2)) + (size_t)l1 * DM * HID, HID, 32, CE); }
        } SEAM(base + 15);
    }
__global__ void __launch_bounds__(NTHR, 2) mk_fwd(Args args) {
    extern __shared__ __attribute__((aligned(16))) unsigned char lds[];
    Frame F;
    F.lds = (LAS unsigned char*)lds;
    F.MISC = (volatile LAS unsigned*)(F.lds + MISC_OFF);
    F.tid = threadIdx.x; F.lane = F.tid & 63; F.wave = __builtin_amdgcn_readfirstlane(F.tid >> 6);
    F.G = gridDim.x; { const int bx = blockIdx.x; F.vcu = (F.G % 8 == 0) ? (bx % 8) * (F.G / 8) + bx / 8 : bx; }
    F.ws = (GAS unsigned char*)args.ws; F.out = (GAS float*)args.out;
    for (int u = F.tid; u < (LDS_BYTES - LDSCTL_OFF) / 4; u += NTHR) ((LAS unsigned*)(F.lds + LDSCTL_OFF))[u] = 0u;
    __syncthreads();
    gen_u32p barw = (gen_u32p)((GAS unsigned*)(WSP(WS_CTL)) + CW_BAR);
    XcdBarrier bar; bar.bar = barw; bar.x = 0; bar.st = nullptr;
    if (!MK_PER_PHASE) bar = xcd_barrier_post(barw, F.MISC + 8);
    if (IN(0)) { for (int rep = 0; rep <= REP_P0; ++rep) phase_p0(F, args); } SEAM(0);
    for (int rep = 0; rep < REP_BAR; ++rep) xcd_barrier(bar);
    if (IN(1)) { phase_p1(F, args); } SEAM(1);

    layer_pair<0>(F, args, bar);
    layer_pair<1>(F, args, bar);
    if (IN(34)) { thin_rn<2, 1>(F, args, Y2, nullptr, SEQ, AIN(9) + 3 * DM, MOD + (size_t)3 * 2 * NMOD, 5, nullptr, nullptr, 0, 0); }
#undef IN
#undef SEAM
}

extern "C" void kernel_launch(void* const* d_in, const int* in_sizes, int n_in, void* d_out, int out_size, void* d_ws, size_t ws_size, hipStream_t stream) {
    static int grid = 0;
    if (grid == 0) {
        if (n_in != 25 || out_size != SEQ * DM || ws_size < WS_END) { fprintf(stderr, "kernel_launch: unexpected shapes (n_in %d out %d ws %zu need %zu)\n", n_in, out_size, ws_size, (size_t)WS_END); grid = -1; return; }
        int dev = 0, cus = 0, per_cu = 0;
        if (hipGetDevice(&dev) != hipSuccess || hipDeviceGetAttribute(&cus, hipDeviceAttributeMultiprocessorCount, dev) != hipSuccess) { grid = -1; return; }
        if (hipFuncSetAttribute((const void*)mk_fwd, hipFuncAttributeMaxDynamicSharedMemorySize, LDS_BYTES) != hipSuccess) { fprintf(stderr, "kernel_launch: hipFuncSetAttribute failed\n"); grid = -1; return; }
        if (hipOccupancyMaxActiveBlocksPerMultiprocessor(&per_cu, (const void*)mk_fwd, NTHR, LDS_BYTES) != hipSuccess || per_cu < 1) { fprintf(stderr, "kernel_launch: occupancy query says %d\n", per_cu); (void)hipGetLastError(); }
        grid = cus;
    }
    if (grid < 0) return;
    if (hipMemsetAsync((char*)d_ws + WS_CTL, 0, CTL_ZERO_BYTES, stream) != hipSuccess) return;
    Args a{};
    for (int i = 0; i < 25; ++i) a.in[i] = (const float*)d_in[i];
    a.out = (float*)d_out; a.ws = (unsigned char*)d_ws;
#if MK_PER_PHASE
    for (int p = 0; p < NPHASES; ++p) {  a.ph_lo = p; a.ph_hi = p + 1; hipLaunchKernelGGL(mk_fwd, dim3(grid), dim3(NTHR), LDS_BYTES, stream, a); }
#else
    a.ph_lo = 0; a.ph_hi = NPHASES; hipLaunchKernelGGL(mk_fwd, dim3(grid), dim3(NTHR), LDS_BYTES, stream, a);
#endif
}
```
